# Optimizing an MI355X kernel written in HIP

```python
import math
import jax, jax.numpy as jnp
from jax import lax
import numpy as np

D_MODEL = 1024
BATCH = 2
SEQ = 8192
DEPTH = 1

MIX_WIDTH = D_MODEL
RG_WIDTH = MIX_WIDTH // 2
RG_BLOCKS = 8
RG_BLOCK = RG_WIDTH // RG_BLOCKS
CONV_WIDTH = 4
C_RG = 8.0
GLA_HEADS = 4
GLA_VAL = MIX_WIDTH - RG_WIDTH
GLA_KEY = GLA_VAL // 2
GLA_DK = GLA_KEY // GLA_HEADS
GLA_DV = GLA_VAL // GLA_HEADS
GATE_RANK = 16
GATE_NORM = 16.0
CHUNK = 64
IN_WIDTH = 2 * RG_WIDTH + 2 * GLA_KEY + 2 * GLA_VAL + GATE_RANK
N_GROUPS = 4
EXPERTS_PER_GROUP = 8
N_EXPERTS = N_GROUPS * EXPERTS_PER_GROUP
TOP_K = 2
D_EXPERT = D_MODEL
EXPERT_BLOCK = 128
EPS = 1e-6

kernel_name = "hymba_rglru_gla_hmoe_layer"


def rmsnorm(x, g):
    xf = x.astype(jnp.float32)
    y = xf * lax.rsqrt(jnp.mean(xf * xf, axis=-1, keepdims=True) + EPS)
    return (y * g.astype(jnp.float32)).astype(x.dtype)


def causal_depthwise_conv(x, w, b):
    c = x.shape[-1]
    y = lax.conv_general_dilated(
        x, w[:, None, :].astype(x.dtype), window_strides=(1,),
        padding=[(CONV_WIDTH - 1, 0)], dimension_numbers=("NWC", "WIO", "NWC"),
        feature_group_count=c)
    return y + b.astype(x.dtype)


def rg_lru(xc, w_a, b_a, w_x, b_x, lam):
    bsz, s, _ = xc.shape
    xf = xc.astype(jnp.float32)
    xh = xf.reshape(bsz, s, RG_BLOCKS, RG_BLOCK)
    r = jax.nn.sigmoid(jnp.einsum('bshi,hij->bshj', xh, w_a.astype(jnp.float32)) + b_a.astype(jnp.float32))
    i = jax.nn.sigmoid(jnp.einsum('bshi,hij->bshj', xh, w_x.astype(jnp.float32)) + b_x.astype(jnp.float32))
    r = r.reshape(bsz, s, RG_WIDTH)
    i = i.reshape(bsz, s, RG_WIDTH)
    log_a = -C_RG * r * jax.nn.softplus(-lam.astype(jnp.float32))
    a = jnp.exp(log_a)
    u = jnp.sqrt(-jnp.expm1(2.0 * log_a)) * (i * xf)

    def combine(e1, e2):
        a1, b1 = e1
        a2, b2 = e2
        return a1 * a2, a2 * b1 + b2

    _, h = lax.associative_scan(combine, (a, u), axis=1)
    return h


def gla_chunked(q, k, v, log_alpha):
    bsz, s, h, dk = q.shape
    dv = v.shape[-1]
    n = s // CHUNK

    def to_chunks(t):
        return t.reshape(bsz, n, CHUNK, h, t.shape[-1]).transpose(1, 0, 3, 2, 4)

    q, k, v, la = to_chunks(q * (dk ** -0.5)), to_chunks(k), to_chunks(v), to_chunks(log_alpha)
    b = jnp.cumsum(la, axis=3)
    b_last = b[:, :, :, -1:, :]
    q_s = q * jnp.exp(b)
    k_s = k * jnp.exp(-b)
    k_end = k * jnp.exp(b_last - b)
    decay = jnp.exp(b_last[:, :, :, 0, :])

    mask = jnp.tril(jnp.ones((CHUNK, CHUNK), dtype=bool))
    att = jnp.einsum('nbhid,nbhjd->nbhij', q_s, k_s)
    att = jnp.where(mask, att, 0.0)
    o_intra = jnp.einsum('nbhij,nbhje->nbhie', att, v)

    def step(state, inp):
        qc, kc, vc, dc = inp
        o = jnp.einsum('bhcd,bhde->bhce', qc, state)
        state = dc[..., None] * state + jnp.einsum('bhcd,bhce->bhde', kc, vc)
        return state, o

    s0 = jnp.zeros((bsz, h, dk, dv), jnp.float32)
    _, o_inter = lax.scan(step, s0, (q_s, k_end, v, decay))
    o = o_intra + o_inter
    return o.transpose(1, 0, 3, 2, 4).reshape(bsz, s, h, dv)


def mixer(hn, w_in, conv_w, conv_b, w_rg_a, b_rg_a, w_rg_x, b_rg_x, rg_lambda, rg_norm,
          w_alpha_up, b_alpha, gla_norm, w_out):
    bsz, s, _ = hn.shape
    proj = hn @ w_in.astype(hn.dtype)
    cuts = np.cumsum([RG_WIDTH, RG_WIDTH, GLA_KEY, GLA_KEY, GLA_VAL, GLA_VAL]).tolist()
    xr, yr, q, k, v, g, a_low = jnp.split(proj, cuts, axis=-1)

    xc = causal_depthwise_conv(xr, conv_w, conv_b)
    h_rg = rg_lru(xc, w_rg_a, b_rg_a, w_rg_x, b_rg_x, rg_lambda)
    y_rg = h_rg * jax.nn.gelu(yr.astype(jnp.float32))
    y_rg = rmsnorm(y_rg, rg_norm)

    gate_logits = a_low.astype(jnp.float32) @ w_alpha_up.astype(jnp.float32) + b_alpha.astype(jnp.float32)
    log_alpha = jax.nn.log_sigmoid(gate_logits) / GATE_NORM
    qh = q.astype(jnp.float32).reshape(bsz, s, GLA_HEADS, GLA_DK)
    kh = k.astype(jnp.float32).reshape(bsz, s, GLA_HEADS, GLA_DK)
    vh = v.astype(jnp.float32).reshape(bsz, s, GLA_HEADS, GLA_DV)
    lah = log_alpha.reshape(bsz, s, GLA_HEADS, GLA_DK)
    o = gla_chunked(qh, kh, vh, lah)
    o = rmsnorm(o, gla_norm) * jax.nn.silu(g.astype(jnp.float32).reshape(bsz, s, GLA_HEADS, GLA_DV))
    y_gla = o.reshape(bsz, s, GLA_VAL)

    y = jnp.concatenate([y_rg, y_gla], axis=-1).astype(hn.dtype)
    return y @ w_out.astype(hn.dtype)


def hierarchical_moe(hn, w_router_group, b_router_group, w_router_expert, b_router_expert,
                     w_exp_gate, w_exp_up, w_exp_down):
    bsz, s, d = hn.shape
    t = bsz * s
    xt = hn.reshape(t, d)
    pg = jax.nn.softmax((xt @ w_router_group.astype(xt.dtype)).astype(jnp.float32)
                        + b_router_group.astype(jnp.float32), axis=-1)
    g_idx = jnp.argmax(pg, axis=-1)
    g_w = jnp.max(pg, axis=-1)
    le = ((xt @ w_router_expert.astype(xt.dtype)).astype(jnp.float32)
          + b_router_expert.astype(jnp.float32)).reshape(t, N_GROUPS, EXPERTS_PER_GROUP)
    le = jnp.take_along_axis(le, g_idx[:, None, None], axis=1)[:, 0]
    pe = jax.nn.softmax(le, axis=-1)
    top_p, top_i = lax.top_k(pe, TOP_K)
    top_p = top_p / jnp.sum(top_p, axis=-1, keepdims=True)
    weights = g_w[:, None] * top_p
    experts = g_idx[:, None] * EXPERTS_PER_GROUP + top_i

    n_assign = t * TOP_K
    e_flat = experts.reshape(n_assign).astype(jnp.int32)
    w_flat = weights.reshape(n_assign)
    tok_flat = jnp.repeat(jnp.arange(t, dtype=jnp.int32), TOP_K)
    order = jnp.argsort(e_flat, stable=True)
    sorted_e = e_flat[order]
    counts = jnp.bincount(e_flat, length=N_EXPERTS).astype(jnp.int32)
    starts = jnp.cumsum(counts) - counts
    padded = ((counts + EXPERT_BLOCK - 1) // EXPERT_BLOCK) * EXPERT_BLOCK
    pends = jnp.cumsum(padded)
    pstarts = pends - padded
    rank = jnp.arange(n_assign, dtype=jnp.int32) - starts[sorted_e]
    dest = pstarts[sorted_e] + rank
    n_blocks = (n_assign + N_EXPERTS * (EXPERT_BLOCK - 1) + EXPERT_BLOCK - 1) // EXPERT_BLOCK
    cap = n_blocks * EXPERT_BLOCK
    slot_tok = jnp.zeros((cap,), jnp.int32).at[dest].set(tok_flat[order])
    slot_w = jnp.zeros((cap,), jnp.float32).at[dest].set(w_flat[order])
    block_start = jnp.arange(n_blocks, dtype=jnp.int32) * EXPERT_BLOCK
    block_e = jnp.clip(jnp.searchsorted(pends, block_start, side='right'), 0, N_EXPERTS - 1)

    xb = xt[slot_tok].reshape(n_blocks, EXPERT_BLOCK, d)

    def expert_block(args):
        xblk, e = args
        wg = w_exp_gate[e].astype(xblk.dtype)
        wu = w_exp_up[e].astype(xblk.dtype)
        wd = w_exp_down[e].astype(xblk.dtype)
        return (jax.nn.gelu(xblk @ wg) * (xblk @ wu)) @ wd

    yb = lax.map(expert_block, (xb, block_e)).reshape(cap, d)
    out = jnp.zeros((t, d), jnp.float32).at[slot_tok].add(yb.astype(jnp.float32) * slot_w[:, None])
    return out.astype(hn.dtype).reshape(bsz, s, d)


def setup_inputs(seed: int = 0) -> dict:
    key = jax.random.key(seed)
    ks = jax.random.split(key, 24)
    f32 = jnp.float32
    nrm = lambda k, shape, scale: jax.random.normal(k, shape, f32) * scale
    u = jax.random.uniform(ks[9], (DEPTH, RG_WIDTH), f32, minval=0.9, maxval=0.999)
    a0 = u ** (1.0 / C_RG)
    rg_lambda = jnp.log(a0) - jnp.log1p(-a0)
    return {
        "x": jax.random.normal(ks[0], (BATCH, SEQ, D_MODEL), f32),
        "norm_mix": 1.0 + nrm(ks[1], (DEPTH, D_MODEL), 0.02),
        "w_in": nrm(ks[2], (DEPTH, D_MODEL, IN_WIDTH), D_MODEL ** -0.5),
        "conv_w": nrm(ks[3], (DEPTH, CONV_WIDTH, RG_WIDTH), CONV_WIDTH ** -0.5),
        "conv_b": nrm(ks[4], (DEPTH, RG_WIDTH), 0.01),
        "w_rg_a": nrm(ks[5], (DEPTH, RG_BLOCKS, RG_BLOCK, RG_BLOCK), RG_BLOCK ** -0.5),
        "b_rg_a": nrm(ks[6], (DEPTH, RG_BLOCKS, RG_BLOCK), 0.01),
        "w_rg_x": nrm(ks[7], (DEPTH, RG_BLOCKS, RG_BLOCK, RG_BLOCK), RG_BLOCK ** -0.5),
        "b_rg_x": nrm(ks[8], (DEPTH, RG_BLOCKS, RG_BLOCK), 0.01),
        "rg_lambda": rg_lambda,
        "rg_norm": 1.0 + nrm(ks[10], (DEPTH, RG_WIDTH), 0.02),
        "w_alpha_up": nrm(ks[11], (DEPTH, GATE_RANK, GLA_KEY), GATE_RANK ** -0.5),
        "b_alpha": nrm(ks[12], (DEPTH, GLA_KEY), 0.01),
        "gla_norm": 1.0 + nrm(ks[13], (DEPTH, GLA_DV), 0.02),
        "w_out": nrm(ks[14], (DEPTH, MIX_WIDTH, D_MODEL), MIX_WIDTH ** -0.5),
        "norm_ffn": 1.0 + nrm(ks[15], (DEPTH, D_MODEL), 0.02),
        "w_router_group": nrm(ks[16], (DEPTH, D_MODEL, N_GROUPS), D_MODEL ** -0.5),
        "b_router_group": nrm(ks[17], (DEPTH, N_GROUPS), 0.01),
        "w_router_expert": nrm(ks[18], (DEPTH, D_MODEL, N_EXPERTS), D_MODEL ** -0.5),
        "b_router_expert": nrm(ks[19], (DEPTH, N_EXPERTS), 0.01),
        "w_exp_gate": nrm(ks[20], (DEPTH, N_EXPERTS, D_MODEL, D_EXPERT), D_MODEL ** -0.5),
        "w_exp_up": nrm(ks[21], (DEPTH, N_EXPERTS, D_MODEL, D_EXPERT), D_MODEL ** -0.5),
        "w_exp_down": nrm(ks[22], (DEPTH, N_EXPERTS, D_EXPERT, D_MODEL), D_EXPERT ** -0.5),
        "norm_final": 1.0 + nrm(ks[23], (D_MODEL,), 0.02),
    }


def reference(x, norm_mix, w_in, conv_w, conv_b, w_rg_a, b_rg_a, w_rg_x, b_rg_x, rg_lambda,
              rg_norm, w_alpha_up, b_alpha, gla_norm, w_out, norm_ffn, w_router_group,
              b_router_group, w_router_expert, b_router_expert, w_exp_gate, w_exp_up,
              w_exp_down, norm_final):
    h = x
    for l in range(DEPTH):
        hn = rmsnorm(h, norm_mix[l])
        h = h + mixer(hn, w_in[l], conv_w[l], conv_b[l], w_rg_a[l], b_rg_a[l], w_rg_x[l],
                      b_rg_x[l], rg_lambda[l], rg_norm[l], w_alpha_up[l], b_alpha[l],
                      gla_norm[l], w_out[l])
        hn = rmsnorm(h, norm_ffn[l])
        h = h + hierarchical_moe(hn, w_router_group[l], b_router_group[l], w_router_expert[l],
                                 b_router_expert[l], w_exp_gate[l], w_exp_up[l], w_exp_down[l])
    return rmsnorm(h, norm_final)
```

```cpp
#include <hip/hip_runtime.h>
#include <cstdio>
#include <cstdint>

#define LAS __attribute__((address_space(3)))
#define GAS __attribute__((address_space(1)))
typedef unsigned short bf16_t;
typedef short bf16x8 __attribute__((ext_vector_type(8)));
typedef float f32x4 __attribute__((ext_vector_type(4)));
typedef float f32x2 __attribute__((ext_vector_type(2)));
typedef unsigned u32x4 __attribute__((ext_vector_type(4)));
typedef unsigned u32x2 __attribute__((ext_vector_type(2)));

constexpr int NTOK = 16384, SEQ = 8192, DM = 1024;
constexpr int RGW = 512, NPROJ = 2576, LDP = 2816;
constexpr int C_XR = 0, C_YR = 512, C_Q = 1024, C_K = 1280, C_V = 1536, C_G = 2048, C_AL = 2560;
constexpr int NEXP = 32, CAP = 16384;
constexpr float EPS = 1e-6f;
constexpr int NWAVES = 8, NTHR = 512;
constexpr int NPHASE = 10;

constexpr size_t MiB = 1u << 20;
constexpr size_t WS_CTL = 0, CTL_ZERO_BYTES = 1 * MiB;
constexpr size_t WS_WRT = 1 * MiB;
constexpr size_t WS_WIN = 2 * MiB;
constexpr size_t WS_WOUT = 8 * MiB;
constexpr size_t WS_WGU = 16 * MiB;
constexpr size_t WS_WD = 144 * MiB;
constexpr size_t WS_HN = 208 * MiB;
constexpr size_t WS_PROJ = 240 * MiB;
constexpr size_t WS_A = 328 * MiB, WS_U = 360 * MiB, WS_ALPHA = 392 * MiB, WS_HRG = 408 * MiB, WS_O = 440 * MiB;
constexpr size_t WS_H = 240 * MiB;
constexpr size_t WS_YB = 320 * MiB;
constexpr size_t WS_STOK = 480 * MiB, WS_SW = 482 * MiB, WS_TIDX = 484 * MiB;
constexpr size_t WS_END = 512 * MiB;
constexpr int CW_GCNT = 8192;

constexpr int RING_BYTES = 131072;
constexpr int L_MISC = RING_BYTES;
constexpr int L_CNT = RING_BYTES + 128;
constexpr int L_TST = RING_BYTES + 256;
constexpr int L_UTAB = RING_BYTES + 512;
constexpr int L_ROWT = RING_BYTES + 1024;
constexpr int L_WT = RING_BYTES + 6144;
constexpr int LDS_BYTES = 147456;
static_assert(L_WT + 5 * 1024 <= LDS_BYTES, "LDS map");

__device__ __forceinline__ unsigned f2bf(float f) { unsigned u = __builtin_bit_cast(unsigned, f); return (u + 0x7fffu + ((u >> 16) & 1u)) >> 16; }
__device__ __forceinline__ unsigned pk2(float lo, float hi) { return f2bf(lo) | (f2bf(hi) << 16); }
__device__ __forceinline__ float bf2f(unsigned b) { return __builtin_bit_cast(float, b << 16); }
__device__ __forceinline__ float wave_sum(float v) {
#pragma unroll
    for (int o = 1; o < 64; o <<= 1) v += __shfl_xor(v, o);
    return v;
}
__device__ __forceinline__ float sigmoidf_(float x) { return 1.f / (1.f + __expf(-x)); }
__device__ __forceinline__ float gelu_tanh(float x) { const float z = 0.7978845608028654f * (x + 0.044715f * x * x * x); const float e = __expf(2.f * z); return 0.5f * x * (2.f - 2.f / (e + 1.f)); }

namespace pg8 {
constexpr int BM = 256, BK = 64, HALF = 128, HTB = HALF * BK * 2, NXCD = 8, WGM = 8;
__host__ __device__ __forceinline__ int lds_byte(int r, int c) { const int st = (r >> 4) * 2 + (c >> 5), rr = r & 15, cc = c & 31, ob = rr * 64 + cc * 2; return st * 1024 + (ob ^ (((ob >> 9) & 1) << 5)); }
__host__ __device__ __forceinline__ void stage_rc(int b, int& R, int& C) { const int st = b / 1024, sb = b % 1024, swz = sb ^ (((sb >> 9) & 1) << 5); R = (st >> 1) * 16 + swz / 64; C = (st & 1) * 32 + (swz % 64) / 2; }
__host__ __device__ __forceinline__ int perm32(int rho) { const int n = rho >> 4, i = rho & 15; return 8 * (i >> 2) + 4 * n + (i & 3); }

struct Unit { int pm, pn, bt, ui, e, rows; };

struct StaticOrder {
    int nM, nN, nwg, G, c;
    __device__ void init(int M, int N, int G_, int c_) { nM = M / BM; nN = N / BM; nwg = nM * nN; G = G_; c = c_; }
    __device__ bool next(int i, Unit& u) const {
        const long L = (long)i * G + c; if (L >= nwg) return false;
        int wgid = (int)L; { const int q = nwg / NXCD, r = nwg % NXCD, xcd = wgid % NXCD, off = wgid / NXCD; wgid = (xcd < r ? xcd * (q + 1) : r * (q + 1) + (xcd - r) * q) + off; }
        const int nig = WGM * nN, gid = wgid / nig, fm = gid * WGM, gsz = (nM - fm) < WGM ? (nM - fm) : WGM;
        u.pm = fm + ((wgid % nig) % gsz); u.pn = (wgid % nig) / gsz; u.bt = u.pn; u.ui = i; u.e = 0; u.rows = 256; return true;
    }
    __device__ __forceinline__ unsigned row_byte(const Unit&, int) const { return 0u; }
};

struct MoeOrder {
    const LAS int* utab; const LAS unsigned* rowt; int nu, ncol;
    __device__ bool next(int i, Unit& u) const {
        if (i >= nu) return false;
        u.pm = utab[i * 4 + 0]; u.pn = utab[i * 4 + 1]; u.e = utab[i * 4 + 2]; u.rows = utab[i * 4 + 3]; u.ui = i; u.bt = u.e * ncol + u.pn; return true;
    }
    __device__ __forceinline__ unsigned row_byte(const Unit& u, int r) const { return rowt[u.ui * 256 + r]; }
};

__device__ __forceinline__ unsigned cvt_pk_bf16(float lo, float hi) { unsigned r; asm volatile("v_cvt_pk_bf16_f32 %0, %1, %2" : "=v"(r) : "v"(lo), "v"(hi)); return r; }

struct EpiBf16 {
    static constexpr bool PERM = true;
    bf16_t* O; int ldc;
    __device__ __forceinline__ void operator()(const f32x4 (&acc)[2][2][4][2], const Unit& u, int wr, int wc, int fr, int fq, const LAS unsigned char*) const {
        const int row0 = u.pm * BM + wr * 64 + fr, col0 = u.pn * BM + wc * 32 + 8 * fq;
#pragma unroll
        for (int ai = 0; ai < 2; ++ai)
#pragma unroll
            for (int m = 0; m < 4; ++m) { bf16_t* rowp = O + (size_t)(row0 + ai * HALF + m * 16) * ldc + col0;
#pragma unroll
                for (int bj = 0; bj < 2; ++bj) { const f32x4 v0 = acc[ai][bj][m][0], v1 = acc[ai][bj][m][1];
                    u32x4 w; w.x = cvt_pk_bf16(v0[0], v0[1]); w.y = cvt_pk_bf16(v0[2], v0[3]); w.z = cvt_pk_bf16(v1[0], v1[1]); w.w = cvt_pk_bf16(v1[2], v1[3]);
                    *(u32x4*)(rowp + bj * HALF) = w; } }
    }
};
struct EpiResF32 {
    static constexpr bool PERM = false;
    const float* base; float* out; int ldc;
    __device__ __forceinline__ void operator()(const f32x4 (&acc)[2][2][4][2], const Unit& u, int wr, int wc, int fr, int fq, const LAS unsigned char*) const {
        const int col0 = u.pn * BM + wc * 32 + 4 * fq;
#pragma unroll
        for (int ai = 0; ai < 2; ++ai)
#pragma unroll
            for (int m = 0; m < 4; ++m) { const size_t off = (size_t)(u.pm * BM + ai * HALF + wr * 64 + m * 16 + fr) * ldc + col0;
#pragma unroll
                for (int bj = 0; bj < 2; ++bj)
#pragma unroll
                    for (int n = 0; n < 2; ++n) { const f32x4 bs = *(const f32x4*)(base + off + bj * HALF + n * 16); *(f32x4*)(out + off + bj * HALF + n * 16) = bs + acc[ai][bj][m][n]; } }
    }
};
struct EpiGeglu {
    static constexpr bool PERM = true;
    bf16_t* H;
    __device__ __forceinline__ void operator()(const f32x4 (&acc)[2][2][4][2], const Unit& u, int wr, int wc, int fr, int fq, const LAS unsigned char*) const {
        const int col0 = u.pn * HALF + wc * 32 + 8 * fq;
#pragma unroll
        for (int ai = 0; ai < 2; ++ai)
#pragma unroll
            for (int m = 0; m < 4; ++m) { const int r = ai * HALF + wr * 64 + m * 16 + fr;
                if (r < u.rows) {
                    const f32x4 g0 = acc[ai][0][m][0], g1 = acc[ai][0][m][1], u0 = acc[ai][1][m][0], u1 = acc[ai][1][m][1];
                    u32x4 w;
                    w.x = cvt_pk_bf16(gelu_tanh(g0[0]) * u0[0], gelu_tanh(g0[1]) * u0[1]); w.y = cvt_pk_bf16(gelu_tanh(g0[2]) * u0[2], gelu_tanh(g0[3]) * u0[3]);
                    w.z = cvt_pk_bf16(gelu_tanh(g1[0]) * u1[0], gelu_tanh(g1[1]) * u1[1]); w.w = cvt_pk_bf16(gelu_tanh(g1[2]) * u1[2], gelu_tanh(g1[3]) * u1[3]);
                    *(u32x4*)(H + (size_t)(u.pm * BM + r) * 1024 + col0) = w; } }
    }
};
struct EpiScaleBf16 {
    static constexpr bool PERM = true;
    bf16_t* Y;
    __device__ __forceinline__ void operator()(const f32x4 (&acc)[2][2][4][2], const Unit& u, int wr, int wc, int fr, int fq, const LAS unsigned char* lds) const {
        const int col0 = u.pn * BM + wc * 32 + 8 * fq; const LAS float* wt = (const LAS float*)(lds + L_WT) + u.ui * 256;
#pragma unroll
        for (int ai = 0; ai < 2; ++ai)
#pragma unroll
            for (int m = 0; m < 4; ++m) { const int r = ai * HALF + wr * 64 + m * 16 + fr;
                if (r < u.rows) { const float s = wt[r]; bf16_t* rowp = Y + (size_t)(u.pm * BM + r) * 1024 + col0;
#pragma unroll
                    for (int bj = 0; bj < 2; ++bj) { const f32x4 v0 = acc[ai][bj][m][0] * s, v1 = acc[ai][bj][m][1] * s;
                        u32x4 w; w.x = cvt_pk_bf16(v0[0], v0[1]); w.y = cvt_pk_bf16(v0[2], v0[3]); w.z = cvt_pk_bf16(v1[0], v1[1]); w.w = cvt_pk_bf16(v1[2], v1[3]);
                        *(u32x4*)(rowp + bj * HALF) = w; } } }
    }
};

template <class Epi, class Sched, bool ALIGN_EPI, bool GATHER>
__device__ __forceinline__ void gemm_phase(LAS unsigned char* lds, const bf16_t* Ab, const bf16_t* Bb, const int K, const Sched& S, const Epi& E) {
    const int tid = threadIdx.x, wid = __builtin_amdgcn_readfirstlane(tid >> 6), lane = tid & 63, wr = wid >> 2, wc = wid & 3, fr = lane & 15, fq = lane >> 4;
    const int nt = K / BK;
    int Rr[2], Cc[2]; unsigned voffB[2];
#pragma unroll
    for (int i = 0; i < 2; ++i) { int R, C; stage_rc(tid * 16 + i * 8192, R, C); Rr[i] = R; Cc[i] = C; const int Rb = Epi::PERM ? ((R & ~31) + perm32(R & 31)) : R; voffB[i] = (unsigned)(Rb * K + C) * 2u; }
    const size_t kstep = (size_t)(BK * 2);
    const size_t hstep = (size_t)HALF * K * 2;
    const size_t tstep = 2 * hstep;
    const unsigned ldsw = (unsigned)wid * 1024u;
    const int aoff = lds_byte(wr * 64 + fr, fq * 8), boff = lds_byte(wc * 32 + fr, fq * 8);
#define PG8_SA(b, h) (((b) * 2 + (h)) * HTB)
#define PG8_SB(b, h) ((4 + (b) * 2 + (h)) * HTB)
#define PG8_STAGE2(bufoff, gbase, o0, o1) do { \
        __builtin_amdgcn_global_load_lds((const unsigned*)((const char*)(gbase) + (o0)), (LAS unsigned*)(lds + (bufoff) + ldsw), 16, 0, 0); \
        __builtin_amdgcn_global_load_lds((const unsigned*)((const char*)(gbase) + (o1)), (LAS unsigned*)(lds + (bufoff) + ldsw + 8192), 16, 0, 0); } while (0)
#define PG8_STAGEB(bufoff, gbase) PG8_STAGE2(bufoff, gbase, voffB[0], voffB[1])
#define PG8_LDA(dst, b, h) do { _Pragma("unroll") for (int m = 0; m < 4; ++m) _Pragma("unroll") for (int k = 0; k < 2; ++k) dst[m][k] = *(const LAS bf16x8*)(lds + PG8_SA(b, h) + aoff + m * 2048 + k * 1024); } while (0)
#define PG8_LDB(dst, b, h) do { _Pragma("unroll") for (int n = 0; n < 2; ++n) _Pragma("unroll") for (int k = 0; k < 2; ++k) dst[n][k] = *(const LAS bf16x8*)(lds + PG8_SB(b, h) + boff + n * 2048 + k * 1024); } while (0)
#define PG8_MMA(ai, bj, At, Bt) do { __builtin_amdgcn_s_setprio(1); _Pragma("unroll") for (int m = 0; m < 4; ++m) _Pragma("unroll") for (int n = 0; n < 2; ++n) _Pragma("unroll") for (int k = 0; k < 2; ++k) \
        acc[ai][bj][m][n] = __builtin_amdgcn_mfma_f32_16x16x32_bf16(Bt[n][k], At[m][k], acc[ai][bj][m][n], 0, 0, 0); __builtin_amdgcn_s_setprio(0); } while (0)
#define PG8_WAIT_V(n) asm volatile("s_waitcnt vmcnt(" #n ")" ::: "memory")
#define PG8_WAIT_L(n) asm volatile("s_waitcnt lgkmcnt(" #n ")" ::: "memory")
#define PG8_BAR __builtin_amdgcn_s_barrier()
#define PG8_SCHED __builtin_amdgcn_sched_barrier(0)
    Unit cur, nxt; int ui = 0;
    if (!S.next(0, cur)) return;
    f32x4 acc[2][2][4][2];
#pragma unroll
    for (int a = 0; a < 2; ++a)
#pragma unroll
        for (int b = 0; b < 2; ++b)
#pragma unroll
            for (int m = 0; m < 4; ++m)
#pragma unroll
                for (int n = 0; n < 2; ++n) acc[a][b][m][n] = (f32x4){0.f, 0.f, 0.f, 0.f};
    bf16x8 At[4][2], B0[2][2], B1[2][2];
    unsigned vC[2][2], vN[2][2];
#pragma unroll
    for (int h = 0; h < 2; ++h)
#pragma unroll
        for (int i = 0; i < 2; ++i) { vC[h][i] = GATHER ? (S.row_byte(cur, h * HALF + Rr[i]) + (unsigned)Cc[i] * 2u) : (unsigned)((h * HALF + Rr[i]) * K + Cc[i]) * 2u; vN[h][i] = vC[h][i]; }
    const char* cA = GATHER ? (const char*)Ab : (const char*)Ab + (size_t)cur.pm * tstep; const char* cB = (const char*)Bb + (size_t)cur.bt * tstep;
    PG8_STAGEB(PG8_SB(0, 0), cB); PG8_STAGEB(PG8_SB(0, 1), cB + hstep); PG8_STAGE2(PG8_SA(0, 0), cA, vC[0][0], vC[0][1]); PG8_STAGE2(PG8_SA(0, 1), cA, vC[1][0], vC[1][1]);
    if (wr == 1) PG8_BAR;
    PG8_WAIT_V(2); PG8_BAR;
    PG8_STAGEB(PG8_SB(1, 0), cB + kstep); PG8_STAGE2(PG8_SA(1, 0), cA + kstep, vC[0][0], vC[0][1]); PG8_STAGEB(PG8_SB(1, 1), cB + hstep + kstep);
    PG8_WAIT_V(6); PG8_BAR;
    for (;;) {
        const bool has_next = S.next(ui + 1, nxt);
        const char* nA = has_next ? (GATHER ? (const char*)Ab : (const char*)Ab + (size_t)nxt.pm * tstep) : cA; const char* nB = has_next ? (const char*)Bb + (size_t)nxt.bt * tstep : cB;
        if constexpr (GATHER) {
            if (has_next) {
#pragma unroll
                for (int h = 0; h < 2; ++h)
#pragma unroll
                    for (int i = 0; i < 2; ++i) vN[h][i] = S.row_byte(nxt, h * HALF + Rr[i]) + (unsigned)Cc[i] * 2u;
            }
        }
        for (int t = 0; t < nt; t += 2) {
            const bool last = (t == nt - 2);
            const char* a1 = cA + (size_t)(t + 1) * kstep;
            const char* a2 = last ? nA : cA + (size_t)(t + 2) * kstep; const char* b2 = last ? nB : cB + (size_t)(t + 2) * kstep;
            const char* a3 = a2 + kstep; const char* b3 = b2 + kstep;
            unsigned w00, w01, w10, w11;
            if constexpr (GATHER) { w00 = last ? vN[0][0] : vC[0][0]; w01 = last ? vN[0][1] : vC[0][1]; w10 = last ? vN[1][0] : vC[1][0]; w11 = last ? vN[1][1] : vC[1][1]; }
            else { w00 = vC[0][0]; w01 = vC[0][1]; w10 = vC[1][0]; w11 = vC[1][1]; }
            PG8_LDB(B0, 0, 0); PG8_LDB(B1, 0, 1); PG8_SCHED; PG8_LDA(At, 0, 0); PG8_STAGE2(PG8_SA(1, 1), a1, vC[1][0], vC[1][1]);
            PG8_WAIT_V(8); PG8_WAIT_L(0); PG8_BAR; PG8_MMA(0, 0, At, B0); PG8_MMA(0, 1, At, B1); PG8_BAR; PG8_SCHED;
            PG8_LDA(At, 0, 1); PG8_STAGEB(PG8_SB(0, 0), b2); PG8_STAGEB(PG8_SB(0, 1), b2 + hstep); PG8_STAGE2(PG8_SA(0, 0), a2, w00, w01);
            PG8_WAIT_V(8); PG8_WAIT_L(0); PG8_BAR; PG8_MMA(1, 0, At, B0); PG8_MMA(1, 1, At, B1); PG8_BAR; PG8_SCHED;
            PG8_LDB(B0, 1, 0); PG8_LDB(B1, 1, 1); PG8_SCHED; PG8_LDA(At, 1, 0); PG8_STAGE2(PG8_SA(0, 1), a2, w10, w11);
            PG8_WAIT_V(8); PG8_WAIT_L(0); PG8_BAR; PG8_MMA(0, 0, At, B0); PG8_MMA(0, 1, At, B1); PG8_BAR; PG8_SCHED;
            PG8_LDA(At, 1, 1); PG8_STAGEB(PG8_SB(1, 0), b3); PG8_STAGEB(PG8_SB(1, 1), b3 + hstep); PG8_STAGE2(PG8_SA(1, 0), a3, w00, w01);
            PG8_WAIT_V(8); PG8_WAIT_L(0); PG8_BAR; PG8_MMA(1, 0, At, B0); PG8_MMA(1, 1, At, B1); PG8_BAR; PG8_SCHED;
        }
        if constexpr (ALIGN_EPI) { if (wr == 0) PG8_BAR; }
        E(acc, cur, wr, wc, fr, fq, lds);
        if (!has_next) break;
#pragma unroll
        for (int a = 0; a < 2; ++a)
#pragma unroll
            for (int b = 0; b < 2; ++b)
#pragma unroll
                for (int m = 0; m < 4; ++m)
#pragma unroll
                    for (int n = 0; n < 2; ++n) acc[a][b][m][n] = (f32x4){0.f, 0.f, 0.f, 0.f};
        cur = nxt; cA = nA; cB = nB; ++ui;
        if constexpr (GATHER) {
#pragma unroll
            for (int h = 0; h < 2; ++h)
#pragma unroll
                for (int i = 0; i < 2; ++i) vC[h][i] = vN[h][i];
        }
        if constexpr (ALIGN_EPI) { if (wr == 1) PG8_BAR; }
    }
    PG8_WAIT_V(0);
    if constexpr (!ALIGN_EPI) { if (wr == 0) PG8_BAR; }
    PG8_BAR;
#undef PG8_SA
#undef PG8_SB
#undef PG8_STAGE2
#undef PG8_STAGEB
#undef PG8_LDA
#undef PG8_LDB
#undef PG8_MMA
#undef PG8_WAIT_V
#undef PG8_WAIT_L
#undef PG8_BAR
#undef PG8_SCHED
}
}

struct Args { const float* in[24]; float* out; unsigned char* ws; int ph_lo, ph_hi; };

struct Frame {
    LAS unsigned char* lds;
    unsigned* ctl;
    int tid, lane, wave, vcu, G;
    unsigned char* ws; float* out;
};

__device__ __forceinline__ void transpose_item(const float* W, int K, int Nsrc, bf16_t* WT, int k0, int n0, int orow0, LAS float* scr, int lane) {
    const int nn = n0 + (lane & 31); const bool ok = nn < Nsrc;
#pragma unroll 8
    for (int i = 0; i < 32; ++i) { const int kk = 2 * i + (lane >> 5); scr[kk * 33 + (lane & 31)] = ok ? W[(size_t)(k0 + kk) * Nsrc + nn] : 0.f; }
    asm volatile("s_waitcnt lgkmcnt(0)" ::: "memory");
    const int c = lane & 7;
#pragma unroll
    for (int j = 0; j < 4; ++j) { const int n = (lane >> 3) + 8 * j; const LAS float* s = scr + (8 * c) * 33 + n;
        u32x4 o; o.x = pk2(s[0 * 33], s[1 * 33]); o.y = pk2(s[2 * 33], s[3 * 33]); o.z = pk2(s[4 * 33], s[5 * 33]); o.w = pk2(s[6 * 33], s[7 * 33]);
        *(u32x4*)(WT + (size_t)(orow0 + n) * K + k0 + 8 * c) = o; }
    asm volatile("s_waitcnt lgkmcnt(0)" ::: "memory");
}
__device__ __forceinline__ void rms_row_to_bf16(const float* xrow, const float* gain, bf16_t* orow, int lane) {
    const f32x4* xr = (const f32x4*)xrow + lane; const f32x4* gr = (const f32x4*)gain + lane;
    f32x4 v[4]; float s = 0.f;
#pragma unroll
    for (int j = 0; j < 4; ++j) { v[j] = xr[64 * j]; s += (v[j].x * v[j].x + v[j].y * v[j].y) + (v[j].z * v[j].z + v[j].w * v[j].w); }
    const float rs = 1.f / sqrtf(wave_sum(s) * (1.f / DM) + EPS);
    unsigned long long* o8 = (unsigned long long*)orow + lane;
#pragma unroll
    for (int j = 0; j < 4; ++j) { const f32x4 g = gr[64 * j]; o8[64 * j] = (unsigned long long)pk2(v[j].x * rs * g.x, v[j].y * rs * g.y) | ((unsigned long long)pk2(v[j].z * rs * g.z, v[j].w * rs * g.w) << 32); }
}

__device__ __forceinline__ void p0_prologue(Frame& F, const Args& a) {
    LAS float* scr = (LAS float*)(F.lds + F.wave * 16384);
    const int gw = F.vcu * NWAVES + F.wave, NGW = F.G * NWAVES;
    bf16_t* WIN = (bf16_t*)(F.ws + WS_WIN); bf16_t* WOUT = (bf16_t*)(F.ws + WS_WOUT); bf16_t* WGU = (bf16_t*)(F.ws + WS_WGU); bf16_t* WD = (bf16_t*)(F.ws + WS_WD);
    constexpr int I_IN = 16 * 88, I_OUT = 16 * 32, I_E = 16 * 32;
    constexpr int NITEMS = I_IN + I_OUT + NEXP * 3 * I_E;
    for (int it = gw; it < NITEMS; it += NGW) {
        int r = it;
        if (r < I_IN) { const int kb = r / 88, nb = r % 88; transpose_item(a.in[2], DM, NPROJ, WIN, 64 * kb, 32 * nb, 32 * nb, scr, F.lane); continue; } r -= I_IN;
        if (r < I_OUT) { const int kb = r / 32, nb = r % 32; transpose_item(a.in[14], DM, DM, WOUT, 64 * kb, 32 * nb, 32 * nb, scr, F.lane); continue; } r -= I_OUT;
        const int e = r / (3 * I_E), w = (r / I_E) % 3, q = r % I_E, kb = q / 32, nb = q % 32, n0 = 32 * nb;
        if (w == 0) transpose_item(a.in[20] + (size_t)e * DM * DM, DM, DM, WGU + (size_t)e * 2048 * DM, 64 * kb, n0, (n0 >> 7) * 256 + (n0 & 127), scr, F.lane);
        else if (w == 1) transpose_item(a.in[21] + (size_t)e * DM * DM, DM, DM, WGU + (size_t)e * 2048 * DM, 64 * kb, n0, (n0 >> 7) * 256 + 128 + (n0 & 127), scr, F.lane);
        else transpose_item(a.in[22] + (size_t)e * DM * DM, DM, DM, WD + (size_t)e * DM * DM, 64 * kb, n0, n0, scr, F.lane);
    }
    float* WRT = (float*)(F.ws + WS_WRT);
    for (int idx = blockIdx.x * NTHR + F.tid; idx < 36 * DM; idx += F.G * NTHR) { const int j = idx / DM, k = idx % DM; WRT[idx] = j < 4 ? a.in[16][k * 4 + j] : a.in[18][k * 32 + (j - 4)]; }
    bf16_t* HN = (bf16_t*)(F.ws + WS_HN);
    for (int m = gw; m < NTOK; m += NGW) rms_row_to_bf16(a.in[0] + (size_t)m * DM, a.in[1], HN + (size_t)m * DM, F.lane);
}

__device__ __forceinline__ void p2_naive(Frame& F, const Args& a) {
    const bf16_t* PROJ = (const bf16_t*)(F.ws + WS_PROJ); float* A_ = (float*)(F.ws + WS_A); float* U_ = (float*)(F.ws + WS_U); float* AL = (float*)(F.ws + WS_ALPHA);
    LAS float* lxc = (LAS float*)F.lds; LAS float* lal = lxc + 512;
    const float* conv_w = a.in[3]; const float* conv_b = a.in[4]; const float* w_a = a.in[5]; const float* b_a = a.in[6]; const float* w_x = a.in[7]; const float* b_x = a.in[8];
    const float* lam = a.in[9]; const float* w_up = a.in[11]; const float* b_al = a.in[12];
    const int c = F.tid;
    for (int t = blockIdx.x; t < NTOK; t += F.G) {
        const int tl = t % SEQ;
        float xc = conv_b[c];
#pragma unroll
        for (int j = 0; j < 4; ++j) { const int tt = tl - 3 + j; if (tt >= 0) xc += conv_w[j * RGW + c] * bf2f(PROJ[(size_t)(t - 3 + j) * LDP + C_XR + c]); }
        lxc[c] = xc;
        if (c < 16) lal[c] = bf2f(PROJ[(size_t)t * LDP + C_AL + c]);
        __syncthreads();
        const int h = c >> 6, j = c & 63;
        float ar = b_a[c], ai = b_x[c];
#pragma unroll 8
        for (int i = 0; i < 64; ++i) { const float x = lxc[h * 64 + i]; ar += x * w_a[(h * 64 + i) * 64 + j]; ai += x * w_x[(h * 64 + i) * 64 + j]; }
        const float r = sigmoidf_(ar), ig = sigmoidf_(ai);
        const float sp = log1pf(expf(-lam[c]));
        const float log_a = -8.f * r * sp;
        A_[(size_t)t * RGW + c] = expf(log_a);
        U_[(size_t)t * RGW + c] = sqrtf(-expm1f(2.f * log_a)) * (ig * xc);
        if (c < 256) { float g = b_al[c];
#pragma unroll
            for (int r2 = 0; r2 < 16; ++r2) g += lal[r2] * w_up[r2 * 256 + c];
            const float ls = fminf(g, 0.f) - log1pf(expf(-fabsf(g)));
            AL[(size_t)t * 256 + c] = expf(ls * (1.f / 16.f)); }
        __syncthreads();
    }
}

__device__ __forceinline__ void p3_naive(Frame& F, const Args& a) {
    const bf16_t* PROJ = (const bf16_t*)(F.ws + WS_PROJ); const float* A_ = (const float*)(F.ws + WS_A); const float* U_ = (const float*)(F.ws + WS_U); const float* AL = (const float*)(F.ws + WS_ALPHA);
    float* HRG = (float*)(F.ws + WS_HRG); float* O_ = (float*)(F.ws + WS_O);
    const int bx = blockIdx.x;
    if (bx < 8) {
        const int b = bx >> 2, h = bx & 3, e = F.tid & 127, dq = F.tid >> 7;
        LAS float* lq = (LAS float*)F.lds; LAS float* lk = lq + 1024; LAS float* la = lk + 1024; LAS float* lv = la + 1024; LAS float* lo = lv + 2048;
        float S[16];
#pragma unroll
        for (int d = 0; d < 16; ++d) S[d] = 0.f;
        for (int t0 = 0; t0 < SEQ; t0 += 16) {
            const size_t row0 = (size_t)b * SEQ + t0;
#pragma unroll
            for (int q = 0; q < 2; ++q) { const int idx = F.tid + 512 * q, s = idx >> 6, d = idx & 63; const size_t rr = row0 + s;
                lq[idx] = bf2f(PROJ[rr * LDP + C_Q + h * 64 + d]); lk[idx] = bf2f(PROJ[rr * LDP + C_K + h * 64 + d]); la[idx] = AL[rr * 256 + h * 64 + d]; }
#pragma unroll
            for (int q = 0; q < 4; ++q) { const int idx = F.tid + 512 * q, s = idx >> 7, ee = idx & 127; lv[idx] = bf2f(PROJ[(row0 + s) * LDP + C_V + h * 128 + ee]); }
            __syncthreads();
            for (int s = 0; s < 16; ++s) { const float vv = lv[s * 128 + e]; float o = 0.f;
#pragma unroll
                for (int dd = 0; dd < 16; ++dd) { const int d = dq * 16 + dd; S[dd] = la[s * 64 + d] * S[dd] + lk[s * 64 + d] * vv; o += lq[s * 64 + d] * S[dd]; }
                lo[(s * 4 + dq) * 128 + e] = o; }
            __syncthreads();
#pragma unroll
            for (int q = 0; q < 4; ++q) { const int idx = F.tid + 512 * q, s = idx >> 7, ee = idx & 127;
                const float o = (lo[(s * 4 + 0) * 128 + ee] + lo[(s * 4 + 1) * 128 + ee]) + (lo[(s * 4 + 2) * 128 + ee] + lo[(s * 4 + 3) * 128 + ee]);
                O_[(row0 + s) * 512 + h * 128 + ee] = o * 0.125f; }
            __syncthreads();
        }
    } else if (bx < 10) {
        const int id = (bx - 8) * 512 + F.tid, b = id >> 9, c = id & 511;
        float hcur = 0.f; const size_t base = (size_t)b * SEQ * RGW + c;
        for (int t = 0; t < SEQ; t += 8) {
            float av[8], uv[8];
#pragma unroll
            for (int q = 0; q < 8; ++q) { av[q] = A_[base + (size_t)(t + q) * RGW]; uv[q] = U_[base + (size_t)(t + q) * RGW]; }
#pragma unroll
            for (int q = 0; q < 8; ++q) { hcur = av[q] * hcur + uv[q]; HRG[base + (size_t)(t + q) * RGW] = hcur; }
        }
    }
}

__device__ __forceinline__ void p4_naive(Frame& F, const Args& a) {
    const bf16_t* PROJ = (const bf16_t*)(F.ws + WS_PROJ); const float* HRG = (const float*)(F.ws + WS_HRG); const float* O_ = (const float*)(F.ws + WS_O);
    bf16_t* Y = (bf16_t*)(F.ws + WS_HN);
    const float* rg_norm = a.in[10]; const float* gla_norm = a.in[13];
    LAS float* red = (LAS float*)F.lds;
    const int c = F.tid;
    for (int t = blockIdx.x; t < NTOK; t += F.G) {
        const float yr = bf2f(PROJ[(size_t)t * LDP + C_YR + c]);
        const float v1 = HRG[(size_t)t * RGW + c] * gelu_tanh(yr);
        const float o = O_[(size_t)t * 512 + c];
        const float s1 = wave_sum(v1 * v1), s2 = wave_sum(o * o);
        if (F.lane == 0) { red[F.wave] = s1; red[8 + F.wave] = s2; }
        __syncthreads();
        float tot = 0.f;
#pragma unroll
        for (int w = 0; w < 8; ++w) tot += red[w];
        const float rs1 = 1.f / sqrtf(tot * (1.f / 512.f) + EPS);
        const int h = c >> 7;
        const float rs2 = 1.f / sqrtf((red[8 + 2 * h] + red[8 + 2 * h + 1]) * (1.f / 128.f) + EPS);
        const float g = bf2f(PROJ[(size_t)t * LDP + C_G + c]);
        Y[(size_t)t * DM + c] = (bf16_t)f2bf(v1 * rs1 * rg_norm[c]);
        Y[(size_t)t * DM + 512 + c] = (bf16_t)f2bf(o * rs2 * gla_norm[c & 127] * (g * sigmoidf_(g)));
        __syncthreads();
    }
}

__device__ __forceinline__ void p6_router(Frame& F, const Args& a) {
    const float* Hf = F.out; bf16_t* HN2 = (bf16_t*)(F.ws + WS_HN); const float* WRT = (const float*)(F.ws + WS_WRT);
    const float* gain = a.in[15]; const float* bg = a.in[17]; const float* be = a.in[19];
    int* STOK = (int*)(F.ws + WS_STOK); float* SW = (float*)(F.ws + WS_SW); int* TIDX = (int*)(F.ws + WS_TIDX);
    unsigned* gcnt = F.ctl + CW_GCNT;
    LAS int* lcnt = (LAS int*)F.lds; LAS int* lbase = lcnt + 32; LAS int* rec_e = lbase + 32; LAS int* rec_l = rec_e + 128; LAS float* rec_w = (LAS float*)(rec_l + 128);
    for (int grp = blockIdx.x; grp < NTOK / 64; grp += F.G) {
        if (F.tid < 32) lcnt[F.tid] = 0;
        __syncthreads();
        for (int j = 0; j < 8; ++j) {
            const int tl = F.wave * 8 + j, t = grp * 64 + tl;
            const f32x4* xr = (const f32x4*)(Hf + (size_t)t * DM) + F.lane; const f32x4* gr = (const f32x4*)gain + F.lane;
            f32x4 v[4]; float s = 0.f;
#pragma unroll
            for (int q = 0; q < 4; ++q) { v[q] = xr[64 * q]; s += (v[q].x * v[q].x + v[q].y * v[q].y) + (v[q].z * v[q].z + v[q].w * v[q].w); }
            const float rs = 1.f / sqrtf(wave_sum(s) * (1.f / DM) + EPS);
            unsigned long long* o8 = (unsigned long long*)(HN2 + (size_t)t * DM) + F.lane;
#pragma unroll
            for (int q = 0; q < 4; ++q) { const f32x4 g = gr[64 * q]; v[q] = v[q] * rs * g; o8[64 * q] = (unsigned long long)pk2(v[q].x, v[q].y) | ((unsigned long long)pk2(v[q].z, v[q].w) << 32); }
            LAS float* llg = (LAS float*)(F.lds + 4096) + F.wave * 64;
#pragma unroll 1
            for (int ob = 0; ob < 36; ob += 4) {
                float p4[4];
#pragma unroll
                for (int oo = 0; oo < 4; ++oo) { const f32x4* wr = (const f32x4*)(WRT + (ob + oo) * DM) + F.lane; float p = 0.f;
#pragma unroll
                    for (int q = 0; q < 4; ++q) { const f32x4 w = wr[64 * q]; p += (v[q].x * w.x + v[q].y * w.y) + (v[q].z * w.z + v[q].w * w.w); }
                    p4[oo] = wave_sum(p); }
                if (F.lane == 0) { llg[ob] = p4[0]; llg[ob + 1] = p4[1]; llg[ob + 2] = p4[2]; llg[ob + 3] = p4[3]; }
            }
            asm volatile("s_waitcnt lgkmcnt(0)" ::: "memory");
            float lg[36];
#pragma unroll
            for (int o = 0; o < 36; ++o) lg[o] = llg[o];
            float gl[4];
#pragma unroll
            for (int q = 0; q < 4; ++q) gl[q] = lg[q] + bg[q];
            int gi = 0; float gm = gl[0];
#pragma unroll
            for (int q = 1; q < 4; ++q) if (gl[q] > gm) { gm = gl[q]; gi = q; }
            float gs = 0.f;
#pragma unroll
            for (int q = 0; q < 4; ++q) gs += expf(gl[q] - gm);
            const float gw = 1.f / gs;
            float le[8];
#pragma unroll
            for (int q = 0; q < 8; ++q) { float x = lg[4 + q] + be[q];
#pragma unroll
                for (int g2 = 1; g2 < 4; ++g2) x = (gi == g2) ? (lg[4 + g2 * 8 + q] + be[g2 * 8 + q]) : x;
                le[q] = x; }
            int i1 = 0; float m1 = le[0];
#pragma unroll
            for (int q = 1; q < 8; ++q) if (le[q] > m1) { m1 = le[q]; i1 = q; }
            int i2 = -1; float m2 = -3.0e38f;
#pragma unroll
            for (int q = 0; q < 8; ++q) if (q != i1 && le[q] > m2) { m2 = le[q]; i2 = q; }
            const float e2 = expf(m2 - m1), inv = 1.f / (1.f + e2);
            const float w1 = gw * inv, w2 = gw * e2 * inv;
            if (F.lane == 0) {
                const int ea = gi * 8 + i1, eb = gi * 8 + i2;
                const int la_ = __hip_atomic_fetch_add(lcnt + ea, 1, __ATOMIC_RELAXED, __HIP_MEMORY_SCOPE_WORKGROUP), lb_ = __hip_atomic_fetch_add(lcnt + eb, 1, __ATOMIC_RELAXED, __HIP_MEMORY_SCOPE_WORKGROUP);
                rec_e[tl * 2] = ea; rec_l[tl * 2] = la_; rec_w[tl * 2] = w1; rec_e[tl * 2 + 1] = eb; rec_l[tl * 2 + 1] = lb_; rec_w[tl * 2 + 1] = w2;
            }
        }
        __syncthreads();
        if (F.tid < 32) { const int cnum = lcnt[F.tid]; lbase[F.tid] = cnum ? (int)__hip_atomic_fetch_add(gcnt + F.tid, (unsigned)cnum, __ATOMIC_RELAXED, __HIP_MEMORY_SCOPE_AGENT) : 0; }
        __syncthreads();
        if (F.tid < 128) { const int e = rec_e[F.tid], idx = e * CAP + lbase[e] + rec_l[F.tid], t = grp * 64 + (F.tid >> 1);
            STOK[idx] = t; SW[idx] = rec_w[F.tid]; TIDX[t * 2 + (F.tid & 1)] = idx; }
        __syncthreads();
    }
}

__device__ __forceinline__ int moe_setup(Frame& F, int ncol_log2, bool tables) {
    const unsigned* gcnt = F.ctl + CW_GCNT;
    LAS int* lcnt = (LAS int*)(F.lds + L_CNT); LAS int* tst = (LAS int*)(F.lds + L_TST); LAS int* utab = (LAS int*)(F.lds + L_UTAB);
    LAS unsigned* rowt = (LAS unsigned*)(F.lds + L_ROWT); LAS float* wt = (LAS float*)(F.lds + L_WT);
    const int* STOK = (const int*)(F.ws + WS_STOK); const float* SW = (const float*)(F.ws + WS_SW);
    if (F.tid < 32) lcnt[F.tid] = (int)__hip_atomic_load(gcnt + F.tid, __ATOMIC_RELAXED, __HIP_MEMORY_SCOPE_AGENT);
    __syncthreads();
    if (F.tid == 0) { int s = 0; for (int e = 0; e < 32; ++e) { tst[e] = s; s += (lcnt[e] + 255) >> 8; } tst[32] = s; }
    __syncthreads();
    if (!tables) return 0;
    const int total = tst[32] << ncol_log2; int nu = 0;
    for (int ui = 0; ui < 5; ++ui) {
        const int L = ui * F.G + F.vcu; if (L >= total) break;
        const int rb = L >> ncol_log2, pn = L & ((1 << ncol_log2) - 1);
        int e = 0;
        for (int j = 1; j < 32; ++j) e += (tst[j] <= rb) ? 1 : 0;
        const int r0 = (rb - tst[e]) * 256; int rows = lcnt[e] - r0; rows = rows > 256 ? 256 : rows;
        if (F.tid < 256) { const bool ok = F.tid < rows; const int idx = e * CAP + r0 + F.tid;
            rowt[ui * 256 + F.tid] = ok ? (unsigned)STOK[idx] * (unsigned)(DM * 2) : 0u; wt[ui * 256 + F.tid] = ok ? SW[idx] : 0.f; }
        if (F.tid == 0) { utab[ui * 4 + 0] = rb; utab[ui * 4 + 1] = pn; utab[ui * 4 + 2] = e; utab[ui * 4 + 3] = rows; }
        ++nu;
    }
    __syncthreads();
    return nu;
}

__device__ __forceinline__ void p9_final(Frame& F, const Args& a) {
    const LAS int* tst = (const LAS int*)(F.lds + L_TST);
    const int* TIDX = (const int*)(F.ws + WS_TIDX); const bf16_t* YB = (const bf16_t*)(F.ws + WS_YB); const float* gain = a.in[23];
    const int gw = F.vcu * NWAVES + F.wave, NGW = F.G * NWAVES;
    for (int t = gw; t < NTOK; t += NGW) {
        const int i1 = TIDX[t * 2], i2 = TIDX[t * 2 + 1];
        const size_t s1 = (size_t)tst[i1 >> 14] * 256 + (i1 & (CAP - 1)), s2 = (size_t)tst[i2 >> 14] * 256 + (i2 & (CAP - 1));
        f32x4* xr = (f32x4*)(F.out + (size_t)t * DM) + F.lane; const f32x4* gr = (const f32x4*)gain + F.lane;
        const u32x2* y1 = (const u32x2*)(YB + s1 * DM) + F.lane; const u32x2* y2 = (const u32x2*)(YB + s2 * DM) + F.lane;
        f32x4 v[4]; float s = 0.f;
#pragma unroll
        for (int q = 0; q < 4; ++q) { v[q] = xr[64 * q]; const u32x2 p = y1[64 * q], r = y2[64 * q];
            v[q].x += bf2f(p.x & 0xffffu) + bf2f(r.x & 0xffffu); v[q].y += bf2f(p.x >> 16) + bf2f(r.x >> 16); v[q].z += bf2f(p.y & 0xffffu) + bf2f(r.y & 0xffffu); v[q].w += bf2f(p.y >> 16) + bf2f(r.y >> 16);
            s += (v[q].x * v[q].x + v[q].y * v[q].y) + (v[q].z * v[q].z + v[q].w * v[q].w); }
        const float rs = 1.f / sqrtf(wave_sum(s) * (1.f / DM) + EPS);
#pragma unroll
        for (int q = 0; q < 4; ++q) { const f32x4 g = gr[64 * q]; xr[64 * q] = v[q] * rs * g; }
    }
}

__global__ void __launch_bounds__(NTHR, 2) fwd(Args args) {
    extern __shared__ __attribute__((aligned(16))) unsigned char lds_raw[];
    Frame F;
    F.lds = (LAS unsigned char*)lds_raw;
    F.tid = threadIdx.x; F.lane = F.tid & 63; F.wave = __builtin_amdgcn_readfirstlane(F.tid >> 6);
    F.G = gridDim.x; { const int bx = blockIdx.x; F.vcu = (F.G % 8 == 0) ? (bx % 8) * (F.G / 8) + bx / 8 : bx; }
    F.ws = args.ws; F.out = args.out; F.ctl = (unsigned*)(args.ws + WS_CTL);
    const int lo = args.ph_lo, hi = args.ph_hi;
#ifndef PHMASK
#define PHMASK 0x3ff
#endif
#define IN(k) (((PHMASK >> (k)) & 1) && lo <= (k) && (k) < hi)

    if (IN(0)) { p0_prologue(F, args); }
    if (IN(1)) {
        pg8::StaticOrder S; S.init(NTOK, LDP, F.G, (int)blockIdx.x);
        pg8::EpiBf16 E{(bf16_t*)(F.ws + WS_PROJ), LDP};
        pg8::gemm_phase<pg8::EpiBf16, pg8::StaticOrder, true, false>(F.lds, (const bf16_t*)(F.ws + WS_HN), (const bf16_t*)(F.ws + WS_WIN), DM, S, E);
    }
    if (IN(2)) { p2_naive(F, args); }
    if (IN(3)) { p3_naive(F, args); }
    if (IN(4)) { p4_naive(F, args); }
    if (IN(5)) {
        pg8::StaticOrder S; S.init(NTOK, DM, F.G, (int)blockIdx.x);
        pg8::EpiResF32 E{args.in[0], F.out, DM};
        pg8::gemm_phase<pg8::EpiResF32, pg8::StaticOrder, false, false>(F.lds, (const bf16_t*)(F.ws + WS_HN), (const bf16_t*)(F.ws + WS_WOUT), DM, S, E);
    }
    if (IN(6)) { p6_router(F, args); }
    if (IN(7)) {
        const int nu = moe_setup(F, 3, true);
        pg8::MoeOrder S{(const LAS int*)(F.lds + L_UTAB), (const LAS unsigned*)(F.lds + L_ROWT), nu, 8};
        pg8::EpiGeglu E{(bf16_t*)(F.ws + WS_H)};
        pg8::gemm_phase<pg8::EpiGeglu, pg8::MoeOrder, true, true>(F.lds, (const bf16_t*)(F.ws + WS_HN), (const bf16_t*)(F.ws + WS_WGU), DM, S, E);
    }
    if (IN(8)) {
        const int nu = moe_setup(F, 2, true);
        pg8::MoeOrder S{(const LAS int*)(F.lds + L_UTAB), (const LAS unsigned*)(F.lds + L_ROWT), nu, 4};
        pg8::EpiScaleBf16 E{(bf16_t*)(F.ws + WS_YB)};
        pg8::gemm_phase<pg8::EpiScaleBf16, pg8::MoeOrder, true, false>(F.lds, (const bf16_t*)(F.ws + WS_H), (const bf16_t*)(F.ws + WS_WD), DM, S, E);
    }
    if (IN(9)) { moe_setup(F, 0, false); p9_final(F, args); }
#undef IN
}

extern "C" void kernel_launch(void* const* d_in, const int* in_sizes, int n_in, void* d_out, int out_size, void* d_ws, size_t ws_size, hipStream_t stream) {
    static int grid = 0;
    if (grid == 0) {
        if (n_in != 24 || out_size != NTOK * DM || ws_size < WS_END) { fprintf(stderr, "kernel_launch: unexpected shapes (n_in %d, out %d, ws %zu); nothing launched\n", n_in, out_size, ws_size); grid = -1; return; }
        int dev = 0, cus = 0;
        if (hipGetDevice(&dev) != hipSuccess || hipDeviceGetAttribute(&cus, hipDeviceAttributeMultiprocessorCount, dev) != hipSuccess) { grid = -1; return; }
        if (hipFuncSetAttribute((const void*)fwd, hipFuncAttributeMaxDynamicSharedMemorySize, LDS_BYTES) != hipSuccess) { fprintf(stderr, "kernel_launch: hipFuncSetAttribute failed\n"); grid = -1; return; }
        (void)hipGetLastError();
        grid = cus;
    }
    if (grid < 0) return;
    (void)hipMemsetAsync((char*)d_ws + WS_CTL, 0, CTL_ZERO_BYTES, stream);
    Args a{};
    for (int i = 0; i < 24; ++i) a.in[i] = (const float*)d_in[i];
    a.out = (float*)d_out; a.ws = (unsigned char*)d_ws;
    for (int p = 0; p < NPHASE; ++p) {
        a.ph_lo = p; a.ph_hi = p + 1;
        hipLaunchKernelGGL(fwd, dim3(grid), dim3(NTHR), LDS_BYTES, stream, a);
    }
}
```

```cpp
#include <hip/hip_runtime.h>
#include <cstdio>
#include <cstdint>

#define LAS __attribute__((address_space(3)))
#define GAS __attribute__((address_space(1)))
typedef unsigned short bf16_t;
typedef short bf16x8 __attribute__((ext_vector_type(8)));
typedef float f32x4 __attribute__((ext_vector_type(4)));
typedef float f32x2 __attribute__((ext_vector_type(2)));
typedef unsigned u32x4 __attribute__((ext_vector_type(4)));
typedef unsigned u32x2 __attribute__((ext_vector_type(2)));

constexpr int NTOK = 16384, SEQ = 8192, DM = 1024;
constexpr int RGW = 512, NPROJ = 2576, LDP = 2816;
constexpr int C_XR = 0, C_YR = 512, C_Q = 1024, C_K = 1280, C_V = 1536, C_G = 2048, C_AL = 2560;
constexpr int NEXP = 32, CAP = 16384;
constexpr float EPS = 1e-6f;
constexpr int NWAVES = 8, NTHR = 512;
constexpr int NPHASE = 10;

constexpr size_t MiB = 1u << 20;
constexpr size_t WS_CTL = 0, CTL_ZERO_BYTES = 1 * MiB;
constexpr size_t WS_WRT = 1 * MiB;
constexpr size_t WS_WIN = 2 * MiB;
constexpr size_t WS_WOUT = 8 * MiB;
constexpr size_t WS_WGU = 16 * MiB;
constexpr size_t WS_WD = 144 * MiB;
constexpr size_t WS_HN = 208 * MiB;
constexpr size_t WS_PROJ = 240 * MiB;
constexpr size_t WS_A = 328 * MiB, WS_U = 360 * MiB, WS_ALPHA = 392 * MiB, WS_HRG = 408 * MiB, WS_O = 440 * MiB;
constexpr size_t WS_H = 240 * MiB;
constexpr size_t WS_YB = 320 * MiB;
constexpr size_t WS_STOK = 480 * MiB, WS_SW = 482 * MiB, WS_TIDX = 484 * MiB;
constexpr size_t WS_END = 512 * MiB;
constexpr int CW_BAR = 4096;
constexpr int CW_GCNT = 8192;

constexpr int RING_BYTES = 131072;
constexpr int L_MISC = RING_BYTES;
constexpr int L_CNT = RING_BYTES + 128;
constexpr int L_TST = RING_BYTES + 256;
constexpr int L_UTAB = RING_BYTES + 512;
constexpr int L_ROWT = RING_BYTES + 1024;
constexpr int L_WT = RING_BYTES + 6144;
constexpr int LDS_BYTES = 147456;
static_assert(L_WT + 5 * 1024 <= LDS_BYTES, "LDS map");

__device__ __forceinline__ unsigned f2bf(float f) { unsigned u = __builtin_bit_cast(unsigned, f); return (u + 0x7fffu + ((u >> 16) & 1u)) >> 16; }
__device__ __forceinline__ unsigned pk2(float lo, float hi) { return f2bf(lo) | (f2bf(hi) << 16); }
__device__ __forceinline__ float bf2f(unsigned b) { return __builtin_bit_cast(float, b << 16); }
__device__ __forceinline__ float wave_sum(float v) {
#pragma unroll
    for (int o = 1; o < 64; o <<= 1) v += __shfl_xor(v, o);
    return v;
}
__device__ __forceinline__ float sigmoidf_(float x) { return 1.f / (1.f + __expf(-x)); }
__device__ __forceinline__ float gelu_tanh(float x) { const float z = 0.7978845608028654f * (x + 0.044715f * x * x * x); const float e = __expf(2.f * z); return 0.5f * x * (2.f - 2.f / (e + 1.f)); }

namespace pg8 {
constexpr int BM = 256, BK = 64, HALF = 128, HTB = HALF * BK * 2, NXCD = 8, WGM = 8;
__host__ __device__ __forceinline__ int lds_byte(int r, int c) { const int st = (r >> 4) * 2 + (c >> 5), rr = r & 15, cc = c & 31, ob = rr * 64 + cc * 2; return st * 1024 + (ob ^ (((ob >> 9) & 1) << 5)); }
__host__ __device__ __forceinline__ void stage_rc(int b, int& R, int& C) { const int st = b / 1024, sb = b % 1024, swz = sb ^ (((sb >> 9) & 1) << 5); R = (st >> 1) * 16 + swz / 64; C = (st & 1) * 32 + (swz % 64) / 2; }
__host__ __device__ __forceinline__ int perm32(int rho) { const int n = rho >> 4, i = rho & 15; return 8 * (i >> 2) + 4 * n + (i & 3); }

struct Unit { int pm, pn, bt, ui, e, rows; };

struct StaticOrder {
    int nM, nN, nwg, G, c;
    __device__ void init(int M, int N, int G_, int c_) { nM = M / BM; nN = N / BM; nwg = nM * nN; G = G_; c = c_; }
    __device__ bool next(int i, Unit& u) const {
        const long L = (long)i * G + c; if (L >= nwg) return false;
        int wgid = (int)L; { const int q = nwg / NXCD, r = nwg % NXCD, xcd = wgid % NXCD, off = wgid / NXCD; wgid = (xcd < r ? xcd * (q + 1) : r * (q + 1) + (xcd - r) * q) + off; }
        const int nig = WGM * nN, gid = wgid / nig, fm = gid * WGM, gsz = (nM - fm) < WGM ? (nM - fm) : WGM;
        u.pm = fm + ((wgid % nig) % gsz); u.pn = (wgid % nig) / gsz; u.bt = u.pn; u.ui = i; u.e = 0; u.rows = 256; return true;
    }
    __device__ __forceinline__ unsigned row_byte(const Unit&, int) const { return 0u; }
};

struct MoeOrder {
    const LAS int* utab; const LAS unsigned* rowt; int nu, ncol;
    __device__ bool next(int i, Unit& u) const {
        if (i >= nu) return false;
        u.pm = utab[i * 4 + 0]; u.pn = utab[i * 4 + 1]; u.e = utab[i * 4 + 2]; u.rows = utab[i * 4 + 3]; u.ui = i; u.bt = u.e * ncol + u.pn; return true;
    }
    __device__ __forceinline__ unsigned row_byte(const Unit& u, int r) const { return rowt[u.ui * 256 + r]; }
};

__device__ __forceinline__ unsigned cvt_pk_bf16(float lo, float hi) { unsigned r; asm volatile("v_cvt_pk_bf16_f32 %0, %1, %2" : "=v"(r) : "v"(lo), "v"(hi)); return r; }

struct EpiBf16 {
    static constexpr bool PERM = true;
    bf16_t* O; int ldc;
    __device__ __forceinline__ void operator()(const f32x4 (&acc)[2][2][4][2], const Unit& u, int wr, int wc, int fr, int fq, const LAS unsigned char*) const {
        const int row0 = u.pm * BM + wr * 64 + fr, col0 = u.pn * BM + wc * 32 + 8 * fq;
#pragma unroll
        for (int ai = 0; ai < 2; ++ai)
#pragma unroll
            for (int m = 0; m < 4; ++m) { bf16_t* rowp = O + (size_t)(row0 + ai * HALF + m * 16) * ldc + col0;
#pragma unroll
                for (int bj = 0; bj < 2; ++bj) { const f32x4 v0 = acc[ai][bj][m][0], v1 = acc[ai][bj][m][1];
                    u32x4 w; w.x = cvt_pk_bf16(v0[0], v0[1]); w.y = cvt_pk_bf16(v0[2], v0[3]); w.z = cvt_pk_bf16(v1[0], v1[1]); w.w = cvt_pk_bf16(v1[2], v1[3]);
                    *(u32x4*)(rowp + bj * HALF) = w; } }
    }
};
struct EpiResF32 {
    static constexpr bool PERM = false;
    const float* base; float* out; int ldc;
    __device__ __forceinline__ void operator()(const f32x4 (&acc)[2][2][4][2], const Unit& u, int wr, int wc, int fr, int fq, const LAS unsigned char*) const {
        const int col0 = u.pn * BM + wc * 32 + 4 * fq;
#pragma unroll
        for (int ai = 0; ai < 2; ++ai)
#pragma unroll
            for (int m = 0; m < 4; ++m) { const size_t off = (size_t)(u.pm * BM + ai * HALF + wr * 64 + m * 16 + fr) * ldc + col0;
#pragma unroll
                for (int bj = 0; bj < 2; ++bj)
#pragma unroll
                    for (int n = 0; n < 2; ++n) { const f32x4 bs = *(const f32x4*)(base + off + bj * HALF + n * 16); *(f32x4*)(out + off + bj * HALF + n * 16) = bs + acc[ai][bj][m][n]; } }
    }
};
struct EpiGeglu {
    static constexpr bool PERM = true;
    bf16_t* H;
    __device__ __forceinline__ void operator()(const f32x4 (&acc)[2][2][4][2], const Unit& u, int wr, int wc, int fr, int fq, const LAS unsigned char*) const {
        const int col0 = u.pn * HALF + wc * 32 + 8 * fq;
#pragma unroll
        for (int ai = 0; ai < 2; ++ai)
#pragma unroll
            for (int m = 0; m < 4; ++m) { const int r = ai * HALF + wr * 64 + m * 16 + fr;
                if (r < u.rows) {
                    const f32x4 g0 = acc[ai][0][m][0], g1 = acc[ai][0][m][1], u0 = acc[ai][1][m][0], u1 = acc[ai][1][m][1];
                    u32x4 w;
                    w.x = cvt_pk_bf16(gelu_tanh(g0[0]) * u0[0], gelu_tanh(g0[1]) * u0[1]); w.y = cvt_pk_bf16(gelu_tanh(g0[2]) * u0[2], gelu_tanh(g0[3]) * u0[3]);
                    w.z = cvt_pk_bf16(gelu_tanh(g1[0]) * u1[0], gelu_tanh(g1[1]) * u1[1]); w.w = cvt_pk_bf16(gelu_tanh(g1[2]) * u1[2], gelu_tanh(g1[3]) * u1[3]);
                    *(u32x4*)(H + (size_t)(u.pm * BM + r) * 1024 + col0) = w; } }
    }
};
struct EpiScaleBf16 {
    static constexpr bool PERM = true;
    bf16_t* Y;
    __device__ __forceinline__ void operator()(const f32x4 (&acc)[2][2][4][2], const Unit& u, int wr, int wc, int fr, int fq, const LAS unsigned char* lds) const {
        const int col0 = u.pn * BM + wc * 32 + 8 * fq; const LAS float* wt = (const LAS float*)(lds + L_WT) + u.ui * 256;
#pragma unroll
        for (int ai = 0; ai < 2; ++ai)
#pragma unroll
            for (int m = 0; m < 4; ++m) { const int r = ai * HALF + wr * 64 + m * 16 + fr;
                if (r < u.rows) { const float s = wt[r]; bf16_t* rowp = Y + (size_t)(u.pm * BM + r) * 1024 + col0;
#pragma unroll
                    for (int bj = 0; bj < 2; ++bj) { const f32x4 v0 = acc[ai][bj][m][0] * s, v1 = acc[ai][bj][m][1] * s;
                        u32x4 w; w.x = cvt_pk_bf16(v0[0], v0[1]); w.y = cvt_pk_bf16(v0[2], v0[3]); w.z = cvt_pk_bf16(v1[0], v1[1]); w.w = cvt_pk_bf16(v1[2], v1[3]);
                        *(u32x4*)(rowp + bj * HALF) = w; } } }
    }
};

template <class Epi, class Sched, bool ALIGN_EPI, bool GATHER>
__device__ __forceinline__ void gemm_phase(LAS unsigned char* lds, const bf16_t* Ab, const bf16_t* Bb, const int K, const Sched& S, const Epi& E) {
    const int tid = threadIdx.x, wid = __builtin_amdgcn_readfirstlane(tid >> 6), lane = tid & 63, wr = wid >> 2, wc = wid & 3, fr = lane & 15, fq = lane >> 4;
    const int nt = K / BK;
    int Rr[2], Cc[2]; unsigned voffB[2];
#pragma unroll
    for (int i = 0; i < 2; ++i) { int R, C; stage_rc(tid * 16 + i * 8192, R, C); Rr[i] = R; Cc[i] = C; const int Rb = Epi::PERM ? ((R & ~31) + perm32(R & 31)) : R; voffB[i] = (unsigned)(Rb * K + C) * 2u; }
    const size_t kstep = (size_t)(BK * 2);
    const size_t hstep = (size_t)HALF * K * 2;
    const size_t tstep = 2 * hstep;
    const unsigned ldsw = (unsigned)wid * 1024u;
    const int aoff = lds_byte(wr * 64 + fr, fq * 8), boff = lds_byte(wc * 32 + fr, fq * 8);
#define PG8_SA(b, h) (((b) * 2 + (h)) * HTB)
#define PG8_SB(b, h) ((4 + (b) * 2 + (h)) * HTB)
#define PG8_STAGE2(bufoff, gbase, o0, o1) do { \
        __builtin_amdgcn_global_load_lds((const unsigned*)((const char*)(gbase) + (o0)), (LAS unsigned*)(lds + (bufoff) + ldsw), 16, 0, 0); \
        __builtin_amdgcn_global_load_lds((const unsigned*)((const char*)(gbase) + (o1)), (LAS unsigned*)(lds + (bufoff) + ldsw + 8192), 16, 0, 0); } while (0)
#define PG8_STAGEB(bufoff, gbase) PG8_STAGE2(bufoff, gbase, voffB[0], voffB[1])
#define PG8_LDA(dst, b, h) do { _Pragma("unroll") for (int m = 0; m < 4; ++m) _Pragma("unroll") for (int k = 0; k < 2; ++k) dst[m][k] = *(const LAS bf16x8*)(lds + PG8_SA(b, h) + aoff + m * 2048 + k * 1024); } while (0)
#define PG8_LDB(dst, b, h) do { _Pragma("unroll") for (int n = 0; n < 2; ++n) _Pragma("unroll") for (int k = 0; k < 2; ++k) dst[n][k] = *(const LAS bf16x8*)(lds + PG8_SB(b, h) + boff + n * 2048 + k * 1024); } while (0)
#define PG8_MMA(ai, bj, At, Bt) do { __builtin_amdgcn_s_setprio(1); _Pragma("unroll") for (int m = 0; m < 4; ++m) _Pragma("unroll") for (int n = 0; n < 2; ++n) _Pragma("unroll") for (int k = 0; k < 2; ++k) \
        acc[ai][bj][m][n] = __builtin_amdgcn_mfma_f32_16x16x32_bf16(Bt[n][k], At[m][k], acc[ai][bj][m][n], 0, 0, 0); __builtin_amdgcn_s_setprio(0); } while (0)
#define PG8_WAIT_V(n) asm volatile("s_waitcnt vmcnt(" #n ")" ::: "memory")
#define PG8_WAIT_L(n) asm volatile("s_waitcnt lgkmcnt(" #n ")" ::: "memory")
#define PG8_BAR __builtin_amdgcn_s_barrier()
#define PG8_SCHED __builtin_amdgcn_sched_barrier(0)
    Unit cur, nxt; int ui = 0;
    if (!S.next(0, cur)) return;
    f32x4 acc[2][2][4][2];
#pragma unroll
    for (int a = 0; a < 2; ++a)
#pragma unroll
        for (int b = 0; b < 2; ++b)
#pragma unroll
            for (int m = 0; m < 4; ++m)
#pragma unroll
                for (int n = 0; n < 2; ++n) acc[a][b][m][n] = (f32x4){0.f, 0.f, 0.f, 0.f};
    bf16x8 At[4][2], B0[2][2], B1[2][2];
    unsigned vC[2][2], vN[2][2];
#pragma unroll
    for (int h = 0; h < 2; ++h)
#pragma unroll
        for (int i = 0; i < 2; ++i) { vC[h][i] = GATHER ? (S.row_byte(cur, h * HALF + Rr[i]) + (unsigned)Cc[i] * 2u) : (unsigned)((h * HALF + Rr[i]) * K + Cc[i]) * 2u; vN[h][i] = vC[h][i]; }
    const char* cA = GATHER ? (const char*)Ab : (const char*)Ab + (size_t)cur.pm * tstep; const char* cB = (const char*)Bb + (size_t)cur.bt * tstep;
    PG8_STAGEB(PG8_SB(0, 0), cB); PG8_STAGEB(PG8_SB(0, 1), cB + hstep); PG8_STAGE2(PG8_SA(0, 0), cA, vC[0][0], vC[0][1]); PG8_STAGE2(PG8_SA(0, 1), cA, vC[1][0], vC[1][1]);
    if (wr == 1) PG8_BAR;
    PG8_WAIT_V(2); PG8_BAR;
    PG8_STAGEB(PG8_SB(1, 0), cB + kstep); PG8_STAGE2(PG8_SA(1, 0), cA + kstep, vC[0][0], vC[0][1]); PG8_STAGEB(PG8_SB(1, 1), cB + hstep + kstep);
    PG8_WAIT_V(6); PG8_BAR;
    for (;;) {
        const bool has_next = S.next(ui + 1, nxt);
        const char* nA = has_next ? (GATHER ? (const char*)Ab : (const char*)Ab + (size_t)nxt.pm * tstep) : cA; const char* nB = has_next ? (const char*)Bb + (size_t)nxt.bt * tstep : cB;
        if constexpr (GATHER) {
            if (has_next) {
#pragma unroll
                for (int h = 0; h < 2; ++h)
#pragma unroll
                    for (int i = 0; i < 2; ++i) vN[h][i] = S.row_byte(nxt, h * HALF + Rr[i]) + (unsigned)Cc[i] * 2u;
            }
        }
        for (int t = 0; t < nt; t += 2) {
            const bool last = (t == nt - 2);
            const char* a1 = cA + (size_t)(t + 1) * kstep;
            const char* a2 = last ? nA : cA + (size_t)(t + 2) * kstep; const char* b2 = last ? nB : cB + (size_t)(t + 2) * kstep;
            const char* a3 = a2 + kstep; const char* b3 = b2 + kstep;
            unsigned w00, w01, w10, w11;
            if constexpr (GATHER) { w00 = last ? vN[0][0] : vC[0][0]; w01 = last ? vN[0][1] : vC[0][1]; w10 = last ? vN[1][0] : vC[1][0]; w11 = last ? vN[1][1] : vC[1][1]; }
            else { w00 = vC[0][0]; w01 = vC[0][1]; w10 = vC[1][0]; w11 = vC[1][1]; }
            PG8_LDB(B0, 0, 0); PG8_LDB(B1, 0, 1); PG8_SCHED; PG8_LDA(At, 0, 0); PG8_STAGE2(PG8_SA(1, 1), a1, vC[1][0], vC[1][1]);
            PG8_WAIT_V(8); PG8_WAIT_L(0); PG8_BAR; PG8_MMA(0, 0, At, B0); PG8_MMA(0, 1, At, B1); PG8_BAR; PG8_SCHED;
            PG8_LDA(At, 0, 1); PG8_STAGEB(PG8_SB(0, 0), b2); PG8_STAGEB(PG8_SB(0, 1), b2 + hstep); PG8_STAGE2(PG8_SA(0, 0), a2, w00, w01);
            PG8_WAIT_V(8); PG8_WAIT_L(0); PG8_BAR; PG8_MMA(1, 0, At, B0); PG8_MMA(1, 1, At, B1); PG8_BAR; PG8_SCHED;
            PG8_LDB(B0, 1, 0); PG8_LDB(B1, 1, 1); PG8_SCHED; PG8_LDA(At, 1, 0); PG8_STAGE2(PG8_SA(0, 1), a2, w10, w11);
            PG8_WAIT_V(8); PG8_WAIT_L(0); PG8_BAR; PG8_MMA(0, 0, At, B0); PG8_MMA(0, 1, At, B1); PG8_BAR; PG8_SCHED;
            PG8_LDA(At, 1, 1); PG8_STAGEB(PG8_SB(1, 0), b3); PG8_STAGEB(PG8_SB(1, 1), b3 + hstep); PG8_STAGE2(PG8_SA(1, 0), a3, w00, w01);
            PG8_WAIT_V(8); PG8_WAIT_L(0); PG8_BAR; PG8_MMA(1, 0, At, B0); PG8_MMA(1, 1, At, B1); PG8_BAR; PG8_SCHED;
        }
        if constexpr (ALIGN_EPI) { if (wr == 0) PG8_BAR; }
        E(acc, cur, wr, wc, fr, fq, lds);
        if (!has_next) break;
#pragma unroll
        for (int a = 0; a < 2; ++a)
#pragma unroll
            for (int b = 0; b < 2; ++b)
#pragma unroll
                for (int m = 0; m < 4; ++m)
#pragma unroll
                    for (int n = 0; n < 2; ++n) acc[a][b][m][n] = (f32x4){0.f, 0.f, 0.f, 0.f};
        cur = nxt; cA = nA; cB = nB; ++ui;
        if constexpr (GATHER) {
#pragma unroll
            for (int h = 0; h < 2; ++h)
#pragma unroll
                for (int i = 0; i < 2; ++i) vC[h][i] = vN[h][i];
        }
        if constexpr (ALIGN_EPI) { if (wr == 1) PG8_BAR; }
    }
    PG8_WAIT_V(0);
    if constexpr (!ALIGN_EPI) { if (wr == 0) PG8_BAR; }
    PG8_BAR;
#undef PG8_SA
#undef PG8_SB
#undef PG8_STAGE2
#undef PG8_STAGEB
#undef PG8_LDA
#undef PG8_LDB
#undef PG8_MMA
#undef PG8_WAIT_V
#undef PG8_WAIT_L
#undef PG8_BAR
#undef PG8_SCHED
}
}


#define XB_TMO      128
#define XB_XCNT(j)  (256  + 64 * (j))
#define XB_XSUB(j)  (1280 + 64 * (j))
#define XB_XGEN(j)  (2304 + 64 * (j))
#define XB_TOP      3328
#define XB_TOPGEN   3392
#define XCD_BAR_WORDS 3456
#define XB_SPIN_CAP (1u << 18)

__device__ __forceinline__ unsigned xb_ld(unsigned* p)              { return __hip_atomic_load(p, __ATOMIC_RELAXED, __HIP_MEMORY_SCOPE_AGENT); }
__device__ __forceinline__ unsigned xb_add(unsigned* p, unsigned v) { return __hip_atomic_fetch_add(p, v, __ATOMIC_RELAXED, __HIP_MEMORY_SCOPE_AGENT); }
__device__ __forceinline__ unsigned xb_xcc_id() { return (unsigned)__builtin_amdgcn_s_getreg((3 << 11) | 20) & 0xFu; }
#define XB_SPIN(cond, bar) do { unsigned _sp = 0; while (cond) { __builtin_amdgcn_s_sleep(1); \
    if ((++_sp & 255u) == 0u) { if (xb_ld(&(bar)[XB_TMO])) break; if (_sp > XB_SPIN_CAP) { atomicAdd(&(bar)[XB_TMO], 1u); break; } } } } while (0)

struct XcdBarrier {
    unsigned* bar; unsigned x;
    volatile LAS unsigned* st;
};
__device__ __forceinline__ XcdBarrier xcd_barrier_post(unsigned* bar, volatile LAS unsigned* st) {
    XcdBarrier b; b.bar = bar; b.x = xb_xcc_id(); b.st = st;
    if (threadIdx.x == 0) (void)xb_add(&bar[XB_XCNT(b.x)], 1u);
    return b;
}
__device__ __forceinline__ void xcd_barrier_complete(unsigned* bar, unsigned x, unsigned& nloc, unsigned& nx) {
    const unsigned G = gridDim.x * gridDim.y * gridDim.z;
    unsigned sum, cnt, mine, sp = 0u;
    for (;;) {
        sum = 0u; cnt = 0u; mine = 0u;
#pragma unroll
        for (unsigned j = 0; j < 16; ++j) { const unsigned c = xb_ld(&bar[XB_XCNT(j)]); sum += c; cnt += (c > 0u) ? 1u : 0u; mine = (j == x) ? c : mine; }
        if (sum == G) break;
        __builtin_amdgcn_s_sleep(1);
        if ((++sp & 255u) == 0u) { if (xb_ld(&bar[XB_TMO])) break; if (sp > XB_SPIN_CAP) { atomicAdd(&bar[XB_TMO], 1u); break; } }
    }
    nloc = mine > 0u ? mine : 1u; nx = cnt > 0u ? cnt : 1u;
}
__device__ __forceinline__ void xcd_barrier(const XcdBarrier& b) {
    asm volatile("s_waitcnt vmcnt(0)" ::: "memory");
    __syncthreads();
    if (threadIdx.x == 0) {
        unsigned* bar = b.bar;
        __builtin_amdgcn_s_waitcnt(0);
        unsigned nloc = b.st[0], nx = b.st[1];
        if (nloc == 0u) { xcd_barrier_complete(bar, b.x, nloc, nx); b.st[0] = nloc; b.st[1] = nx; }
        const unsigned old = xb_add(&bar[XB_XSUB(b.x)], 1u);
        const unsigned gen = old / nloc;
        if (old + 1u == (gen + 1u) * nloc) {
            __builtin_amdgcn_fence(__ATOMIC_RELEASE, "agent");
            asm volatile("s_waitcnt vmcnt(0)" ::: "memory");
            const unsigned og = xb_add(&bar[XB_TOP], 1u);
            const unsigned tg = og / nx;
            if (og + 1u == (tg + 1u) * nx) xb_add(&bar[XB_TOPGEN], 1u);
            else XB_SPIN(xb_ld(&bar[XB_TOPGEN]) == tg, bar);
            __builtin_amdgcn_fence(__ATOMIC_ACQUIRE, "agent");
            xb_add(&bar[XB_XGEN(b.x)], 1u);
            asm volatile("s_waitcnt vmcnt(0)" ::: "memory");
        } else {
            XB_SPIN(xb_ld(&bar[XB_XGEN(b.x)]) == gen, bar);
            __builtin_amdgcn_fence(__ATOMIC_ACQUIRE, "agent");
            asm volatile("s_waitcnt vmcnt(0)" ::: "memory");
        }
    }
    __syncthreads();
}

struct Args { const float* in[24]; float* out; unsigned char* ws; int ph_lo, ph_hi; };

struct Frame {
    LAS unsigned char* lds;
    unsigned* ctl;
    int tid, lane, wave, vcu, G;
    unsigned char* ws; float* out;
};

__device__ __forceinline__ void transpose_item(const float* W, int K, int Nsrc, bf16_t* WT, int k0, int n0, int orow0, LAS float* scr, int lane) {
    const int nn = n0 + (lane & 31); const bool ok = nn < Nsrc;
#pragma unroll 8
    for (int i = 0; i < 32; ++i) { const int kk = 2 * i + (lane >> 5); scr[kk * 33 + (lane & 31)] = ok ? W[(size_t)(k0 + kk) * Nsrc + nn] : 0.f; }
    asm volatile("s_waitcnt lgkmcnt(0)" ::: "memory");
    const int c = lane & 7;
#pragma unroll
    for (int j = 0; j < 4; ++j) { const int n = (lane >> 3) + 8 * j; const LAS float* s = scr + (8 * c) * 33 + n;
        u32x4 o; o.x = pk2(s[0 * 33], s[1 * 33]); o.y = pk2(s[2 * 33], s[3 * 33]); o.z = pk2(s[4 * 33], s[5 * 33]); o.w = pk2(s[6 * 33], s[7 * 33]);
        *(u32x4*)(WT + (size_t)(orow0 + n) * K + k0 + 8 * c) = o; }
    asm volatile("s_waitcnt lgkmcnt(0)" ::: "memory");
}
__device__ __forceinline__ void rms_row_to_bf16(const float* xrow, const float* gain, bf16_t* orow, int lane) {
    const f32x4* xr = (const f32x4*)xrow + lane; const f32x4* gr = (const f32x4*)gain + lane;
    f32x4 v[4]; float s = 0.f;
#pragma unroll
    for (int j = 0; j < 4; ++j) { v[j] = xr[64 * j]; s += (v[j].x * v[j].x + v[j].y * v[j].y) + (v[j].z * v[j].z + v[j].w * v[j].w); }
    const float rs = 1.f / sqrtf(wave_sum(s) * (1.f / DM) + EPS);
    unsigned long long* o8 = (unsigned long long*)orow + lane;
#pragma unroll
    for (int j = 0; j < 4; ++j) { const f32x4 g = gr[64 * j]; o8[64 * j] = (unsigned long long)pk2(v[j].x * rs * g.x, v[j].y * rs * g.y) | ((unsigned long long)pk2(v[j].z * rs * g.z, v[j].w * rs * g.w) << 32); }
}

__device__ __forceinline__ void p0_prologue(Frame& F, const Args& a) {
    LAS float* scr = (LAS float*)(F.lds + F.wave * 16384);
    const int gw = F.vcu * NWAVES + F.wave, NGW = F.G * NWAVES;
    bf16_t* WIN = (bf16_t*)(F.ws + WS_WIN); bf16_t* WOUT = (bf16_t*)(F.ws + WS_WOUT); bf16_t* WGU = (bf16_t*)(F.ws + WS_WGU); bf16_t* WD = (bf16_t*)(F.ws + WS_WD);
    constexpr int I_IN = 16 * 88, I_OUT = 16 * 32, I_E = 16 * 32;
    constexpr int NITEMS = I_IN + I_OUT + NEXP * 3 * I_E;
    for (int it = gw; it < NITEMS; it += NGW) {
        int r = it;
        if (r < I_IN) { const int kb = r / 88, nb = r % 88; transpose_item(a.in[2], DM, NPROJ, WIN, 64 * kb, 32 * nb, 32 * nb, scr, F.lane); continue; } r -= I_IN;
        if (r < I_OUT) { const int kb = r / 32, nb = r % 32; transpose_item(a.in[14], DM, DM, WOUT, 64 * kb, 32 * nb, 32 * nb, scr, F.lane); continue; } r -= I_OUT;
        const int e = r / (3 * I_E), w = (r / I_E) % 3, q = r % I_E, kb = q / 32, nb = q % 32, n0 = 32 * nb;
        if (w == 0) transpose_item(a.in[20] + (size_t)e * DM * DM, DM, DM, WGU + (size_t)e * 2048 * DM, 64 * kb, n0, (n0 >> 7) * 256 + (n0 & 127), scr, F.lane);
        else if (w == 1) transpose_item(a.in[21] + (size_t)e * DM * DM, DM, DM, WGU + (size_t)e * 2048 * DM, 64 * kb, n0, (n0 >> 7) * 256 + 128 + (n0 & 127), scr, F.lane);
        else transpose_item(a.in[22] + (size_t)e * DM * DM, DM, DM, WD + (size_t)e * DM * DM, 64 * kb, n0, n0, scr, F.lane);
    }
    float* WRT = (float*)(F.ws + WS_WRT);
    for (int idx = blockIdx.x * NTHR + F.tid; idx < 36 * DM; idx += F.G * NTHR) { const int j = idx / DM, k = idx % DM; WRT[idx] = j < 4 ? a.in[16][k * 4 + j] : a.in[18][k * 32 + (j - 4)]; }
    bf16_t* HN = (bf16_t*)(F.ws + WS_HN);
    for (int m = gw; m < NTOK; m += NGW) rms_row_to_bf16(a.in[0] + (size_t)m * DM, a.in[1], HN + (size_t)m * DM, F.lane);
}

__device__ __forceinline__ void p2_naive(Frame& F, const Args& a) {
    const bf16_t* PROJ = (const bf16_t*)(F.ws + WS_PROJ); float* A_ = (float*)(F.ws + WS_A); float* U_ = (float*)(F.ws + WS_U); float* AL = (float*)(F.ws + WS_ALPHA);
    LAS float* lxc = (LAS float*)F.lds; LAS float* lal = lxc + 512;
    const float* conv_w = a.in[3]; const float* conv_b = a.in[4]; const float* w_a = a.in[5]; const float* b_a = a.in[6]; const float* w_x = a.in[7]; const float* b_x = a.in[8];
    const float* lam = a.in[9]; const float* w_up = a.in[11]; const float* b_al = a.in[12];
    const int c = F.tid;
    for (int t = blockIdx.x; t < NTOK; t += F.G) {
        const int tl = t % SEQ;
        float xc = conv_b[c];
#pragma unroll
        for (int j = 0; j < 4; ++j) { const int tt = tl - 3 + j; if (tt >= 0) xc += conv_w[j * RGW + c] * bf2f(PROJ[(size_t)(t - 3 + j) * LDP + C_XR + c]); }
        lxc[c] = xc;
        if (c < 16) lal[c] = bf2f(PROJ[(size_t)t * LDP + C_AL + c]);
        __syncthreads();
        const int h = c >> 6, j = c & 63;
        float ar = b_a[c], ai = b_x[c];
#pragma unroll 8
        for (int i = 0; i < 64; ++i) { const float x = lxc[h * 64 + i]; ar += x * w_a[(h * 64 + i) * 64 + j]; ai += x * w_x[(h * 64 + i) * 64 + j]; }
        const float r = sigmoidf_(ar), ig = sigmoidf_(ai);
        const float sp = log1pf(expf(-lam[c]));
        const float log_a = -8.f * r * sp;
        A_[(size_t)t * RGW + c] = expf(log_a);
        U_[(size_t)t * RGW + c] = sqrtf(-expm1f(2.f * log_a)) * (ig * xc);
        if (c < 256) { float g = b_al[c];
#pragma unroll
            for (int r2 = 0; r2 < 16; ++r2) g += lal[r2] * w_up[r2 * 256 + c];
            const float ls = fminf(g, 0.f) - log1pf(expf(-fabsf(g)));
            AL[(size_t)t * 256 + c] = expf(ls * (1.f / 16.f)); }
        __syncthreads();
    }
}

__device__ __forceinline__ void p3_naive(Frame& F, const Args& a) {
    const bf16_t* PROJ = (const bf16_t*)(F.ws + WS_PROJ); const float* A_ = (const float*)(F.ws + WS_A); const float* U_ = (const float*)(F.ws + WS_U); const float* AL = (const float*)(F.ws + WS_ALPHA);
    float* HRG = (float*)(F.ws + WS_HRG); float* O_ = (float*)(F.ws + WS_O);
    const int bx = blockIdx.x;
    if (bx < 8) {
        const int b = bx >> 2, h = bx & 3, e = F.tid & 127, dq = F.tid >> 7;
        LAS float* lq = (LAS float*)F.lds; LAS float* lk = lq + 1024; LAS float* la = lk + 1024; LAS float* lv = la + 1024; LAS float* lo = lv + 2048;
        float S[16];
#pragma unroll
        for (int d = 0; d < 16; ++d) S[d] = 0.f;
        for (int t0 = 0; t0 < SEQ; t0 += 16) {
            const size_t row0 = (size_t)b * SEQ + t0;
#pragma unroll
            for (int q = 0; q < 2; ++q) { const int idx = F.tid + 512 * q, s = idx >> 6, d = idx & 63; const size_t rr = row0 + s;
                lq[idx] = bf2f(PROJ[rr * LDP + C_Q + h * 64 + d]); lk[idx] = bf2f(PROJ[rr * LDP + C_K + h * 64 + d]); la[idx] = AL[rr * 256 + h * 64 + d]; }
#pragma unroll
            for (int q = 0; q < 4; ++q) { const int idx = F.tid + 512 * q, s = idx >> 7, ee = idx & 127; lv[idx] = bf2f(PROJ[(row0 + s) * LDP + C_V + h * 128 + ee]); }
            __syncthreads();
            for (int s = 0; s < 16; ++s) { const float vv = lv[s * 128 + e]; float o = 0.f;
#pragma unroll
                for (int dd = 0; dd < 16; ++dd) { const int d = dq * 16 + dd; S[dd] = la[s * 64 + d] * S[dd] + lk[s * 64 + d] * vv; o += lq[s * 64 + d] * S[dd]; }
                lo[(s * 4 + dq) * 128 + e] = o; }
            __syncthreads();
#pragma unroll
            for (int q = 0; q < 4; ++q) { const int idx = F.tid + 512 * q, s = idx >> 7, ee = idx & 127;
                const float o = (lo[(s * 4 + 0) * 128 + ee] + lo[(s * 4 + 1) * 128 + ee]) + (lo[(s * 4 + 2) * 128 + ee] + lo[(s * 4 + 3) * 128 + ee]);
                O_[(row0 + s) * 512 + h * 128 + ee] = o * 0.125f; }
            __syncthreads();
        }
    } else if (bx < 10) {
        const int id = (bx - 8) * 512 + F.tid, b = id >> 9, c = id & 511;
        float hcur = 0.f; const size_t base = (size_t)b * SEQ * RGW + c;
        for (int t = 0; t < SEQ; t += 8) {
            float av[8], uv[8];
#pragma unroll
            for (int q = 0; q < 8; ++q) { av[q] = A_[base + (size_t)(t + q) * RGW]; uv[q] = U_[base + (size_t)(t + q) * RGW]; }
#pragma unroll
            for (int q = 0; q < 8; ++q) { hcur = av[q] * hcur + uv[q]; HRG[base + (size_t)(t + q) * RGW] = hcur; }
        }
    }
}

__device__ __forceinline__ void p4_naive(Frame& F, const Args& a) {
    const bf16_t* PROJ = (const bf16_t*)(F.ws + WS_PROJ); const float* HRG = (const float*)(F.ws + WS_HRG); const float* O_ = (const float*)(F.ws + WS_O);
    bf16_t* Y = (bf16_t*)(F.ws + WS_HN);
    const float* rg_norm = a.in[10]; const float* gla_norm = a.in[13];
    LAS float* red = (LAS float*)F.lds;
    const int c = F.tid;
    for (int t = blockIdx.x; t < NTOK; t += F.G) {
        const float yr = bf2f(PROJ[(size_t)t * LDP + C_YR + c]);
        const float v1 = HRG[(size_t)t * RGW + c] * gelu_tanh(yr);
        const float o = O_[(size_t)t * 512 + c];
        const float s1 = wave_sum(v1 * v1), s2 = wave_sum(o * o);
        if (F.lane == 0) { red[F.wave] = s1; red[8 + F.wave] = s2; }
        __syncthreads();
        float tot = 0.f;
#pragma unroll
        for (int w = 0; w < 8; ++w) tot += red[w];
        const float rs1 = 1.f / sqrtf(tot * (1.f / 512.f) + EPS);
        const int h = c >> 7;
        const float rs2 = 1.f / sqrtf((red[8 + 2 * h] + red[8 + 2 * h + 1]) * (1.f / 128.f) + EPS);
        const float g = bf2f(PROJ[(size_t)t * LDP + C_G + c]);
        Y[(size_t)t * DM + c] = (bf16_t)f2bf(v1 * rs1 * rg_norm[c]);
        Y[(size_t)t * DM + 512 + c] = (bf16_t)f2bf(o * rs2 * gla_norm[c & 127] * (g * sigmoidf_(g)));
        __syncthreads();
    }
}

__device__ __forceinline__ void p6_router(Frame& F, const Args& a) {
    const float* Hf = F.out; bf16_t* HN2 = (bf16_t*)(F.ws + WS_HN); const float* WRT = (const float*)(F.ws + WS_WRT);
    const float* gain = a.in[15]; const float* bg = a.in[17]; const float* be = a.in[19];
    int* STOK = (int*)(F.ws + WS_STOK); float* SW = (float*)(F.ws + WS_SW); int* TIDX = (int*)(F.ws + WS_TIDX);
    unsigned* gcnt = F.ctl + CW_GCNT;
    LAS int* lcnt = (LAS int*)F.lds; LAS int* lbase = lcnt + 32; LAS int* rec_e = lbase + 32; LAS int* rec_l = rec_e + 128; LAS float* rec_w = (LAS float*)(rec_l + 128);
    for (int grp = blockIdx.x; grp < NTOK / 64; grp += F.G) {
        if (F.tid < 32) lcnt[F.tid] = 0;
        __syncthreads();
        for (int j = 0; j < 8; ++j) {
            const int tl = F.wave * 8 + j, t = grp * 64 + tl;
            const f32x4* xr = (const f32x4*)(Hf + (size_t)t * DM) + F.lane; const f32x4* gr = (const f32x4*)gain + F.lane;
            f32x4 v[4]; float s = 0.f;
#pragma unroll
            for (int q = 0; q < 4; ++q) { v[q] = xr[64 * q]; s += (v[q].x * v[q].x + v[q].y * v[q].y) + (v[q].z * v[q].z + v[q].w * v[q].w); }
            const float rs = 1.f / sqrtf(wave_sum(s) * (1.f / DM) + EPS);
            unsigned long long* o8 = (unsigned long long*)(HN2 + (size_t)t * DM) + F.lane;
#pragma unroll
            for (int q = 0; q < 4; ++q) { const f32x4 g = gr[64 * q]; v[q] = v[q] * rs * g; o8[64 * q] = (unsigned long long)pk2(v[q].x, v[q].y) | ((unsigned long long)pk2(v[q].z, v[q].w) << 32); }
            LAS float* llg = (LAS float*)(F.lds + 4096) + F.wave * 64;
#pragma unroll 1
            for (int ob = 0; ob < 36; ob += 4) {
                float p4[4];
#pragma unroll
                for (int oo = 0; oo < 4; ++oo) { const f32x4* wr = (const f32x4*)(WRT + (ob + oo) * DM) + F.lane; float p = 0.f;
#pragma unroll
                    for (int q = 0; q < 4; ++q) { const f32x4 w = wr[64 * q]; p += (v[q].x * w.x + v[q].y * w.y) + (v[q].z * w.z + v[q].w * w.w); }
                    p4[oo] = wave_sum(p); }
                if (F.lane == 0) { llg[ob] = p4[0]; llg[ob + 1] = p4[1]; llg[ob + 2] = p4[2]; llg[ob + 3] = p4[3]; }
            }
            asm volatile("s_waitcnt lgkmcnt(0)" ::: "memory");
            float lg[36];
#pragma unroll
            for (int o = 0; o < 36; ++o) lg[o] = llg[o];
            float gl[4];
#pragma unroll
            for (int q = 0; q < 4; ++q) gl[q] = lg[q] + bg[q];
            int gi = 0; float gm = gl[0];
#pragma unroll
            for (int q = 1; q < 4; ++q) if (gl[q] > gm) { gm = gl[q]; gi = q; }
            float gs = 0.f;
#pragma unroll
            for (int q = 0; q < 4; ++q) gs += expf(gl[q] - gm);
            const float gw = 1.f / gs;
            float le[8];
#pragma unroll
            for (int q = 0; q < 8; ++q) { float x = lg[4 + q] + be[q];
#pragma unroll
                for (int g2 = 1; g2 < 4; ++g2) x = (gi == g2) ? (lg[4 + g2 * 8 + q] + be[g2 * 8 + q]) : x;
                le[q] = x; }
            int i1 = 0; float m1 = le[0];
#pragma unroll
            for (int q = 1; q < 8; ++q) if (le[q] > m1) { m1 = le[q]; i1 = q; }
            int i2 = -1; float m2 = -3.0e38f;
#pragma unroll
            for (int q = 0; q < 8; ++q) if (q != i1 && le[q] > m2) { m2 = le[q]; i2 = q; }
            const float e2 = expf(m2 - m1), inv = 1.f / (1.f + e2);
            const float w1 = gw * inv, w2 = gw * e2 * inv;
            if (F.lane == 0) {
                const int ea = gi * 8 + i1, eb = gi * 8 + i2;
                const int la_ = __hip_atomic_fetch_add(lcnt + ea, 1, __ATOMIC_RELAXED, __HIP_MEMORY_SCOPE_WORKGROUP), lb_ = __hip_atomic_fetch_add(lcnt + eb, 1, __ATOMIC_RELAXED, __HIP_MEMORY_SCOPE_WORKGROUP);
                rec_e[tl * 2] = ea; rec_l[tl * 2] = la_; rec_w[tl * 2] = w1; rec_e[tl * 2 + 1] = eb; rec_l[tl * 2 + 1] = lb_; rec_w[tl * 2 + 1] = w2;
            }
        }
        __syncthreads();
        if (F.tid < 32) { const int cnum = lcnt[F.tid]; lbase[F.tid] = cnum ? (int)__hip_atomic_fetch_add(gcnt + F.tid, (unsigned)cnum, __ATOMIC_RELAXED, __HIP_MEMORY_SCOPE_AGENT) : 0; }
        __syncthreads();
        if (F.tid < 128) { const int e = rec_e[F.tid], idx = e * CAP + lbase[e] + rec_l[F.tid], t = grp * 64 + (F.tid >> 1);
            STOK[idx] = t; SW[idx] = rec_w[F.tid]; TIDX[t * 2 + (F.tid & 1)] = idx; }
        __syncthreads();
    }
}

__device__ __forceinline__ int moe_setup(Frame& F, int ncol_log2, bool tables) {
    const unsigned* gcnt = F.ctl + CW_GCNT;
    LAS int* lcnt = (LAS int*)(F.lds + L_CNT); LAS int* tst = (LAS int*)(F.lds + L_TST); LAS int* utab = (LAS int*)(F.lds + L_UTAB);
    LAS unsigned* rowt = (LAS unsigned*)(F.lds + L_ROWT); LAS float* wt = (LAS float*)(F.lds + L_WT);
    const int* STOK = (const int*)(F.ws + WS_STOK); const float* SW = (const float*)(F.ws + WS_SW);
    if (F.tid < 32) lcnt[F.tid] = (int)__hip_atomic_load(gcnt + F.tid, __ATOMIC_RELAXED, __HIP_MEMORY_SCOPE_AGENT);
    __syncthreads();
    if (F.tid == 0) { int s = 0; for (int e = 0; e < 32; ++e) { tst[e] = s; s += (lcnt[e] + 255) >> 8; } tst[32] = s; }
    __syncthreads();
    if (!tables) return 0;
    const int total = tst[32] << ncol_log2; int nu = 0;
    for (int ui = 0; ui < 5; ++ui) {
        const int L = ui * F.G + F.vcu; if (L >= total) break;
        const int rb = L >> ncol_log2, pn = L & ((1 << ncol_log2) - 1);
        int e = 0;
        for (int j = 1; j < 32; ++j) e += (tst[j] <= rb) ? 1 : 0;
        const int r0 = (rb - tst[e]) * 256; int rows = lcnt[e] - r0; rows = rows > 256 ? 256 : rows;
        if (F.tid < 256) { const bool ok = F.tid < rows; const int idx = e * CAP + r0 + F.tid;
            rowt[ui * 256 + F.tid] = ok ? (unsigned)STOK[idx] * (unsigned)(DM * 2) : 0u; wt[ui * 256 + F.tid] = ok ? SW[idx] : 0.f; }
        if (F.tid == 0) { utab[ui * 4 + 0] = rb; utab[ui * 4 + 1] = pn; utab[ui * 4 + 2] = e; utab[ui * 4 + 3] = rows; }
        ++nu;
    }
    __syncthreads();
    return nu;
}

__device__ __forceinline__ void p9_final(Frame& F, const Args& a) {
    const LAS int* tst = (const LAS int*)(F.lds + L_TST);
    const int* TIDX = (const int*)(F.ws + WS_TIDX); const bf16_t* YB = (const bf16_t*)(F.ws + WS_YB); const float* gain = a.in[23];
    const int gw = F.vcu * NWAVES + F.wave, NGW = F.G * NWAVES;
    for (int t = gw; t < NTOK; t += NGW) {
        const int i1 = TIDX[t * 2], i2 = TIDX[t * 2 + 1];
        const size_t s1 = (size_t)tst[i1 >> 14] * 256 + (i1 & (CAP - 1)), s2 = (size_t)tst[i2 >> 14] * 256 + (i2 & (CAP - 1));
        f32x4* xr = (f32x4*)(F.out + (size_t)t * DM) + F.lane; const f32x4* gr = (const f32x4*)gain + F.lane;
        const u32x2* y1 = (const u32x2*)(YB + s1 * DM) + F.lane; const u32x2* y2 = (const u32x2*)(YB + s2 * DM) + F.lane;
        f32x4 v[4]; float s = 0.f;
#pragma unroll
        for (int q = 0; q < 4; ++q) { v[q] = xr[64 * q]; const u32x2 p = y1[64 * q], r = y2[64 * q];
            v[q].x += bf2f(p.x & 0xffffu) + bf2f(r.x & 0xffffu); v[q].y += bf2f(p.x >> 16) + bf2f(r.x >> 16); v[q].z += bf2f(p.y & 0xffffu) + bf2f(r.y & 0xffffu); v[q].w += bf2f(p.y >> 16) + bf2f(r.y >> 16);
            s += (v[q].x * v[q].x + v[q].y * v[q].y) + (v[q].z * v[q].z + v[q].w * v[q].w); }
        const float rs = 1.f / sqrtf(wave_sum(s) * (1.f / DM) + EPS);
#pragma unroll
        for (int q = 0; q < 4; ++q) { const f32x4 g = gr[64 * q]; xr[64 * q] = v[q] * rs * g; }
    }
}

__global__ void __launch_bounds__(NTHR, 2) fwd(Args args) {
    extern __shared__ __attribute__((aligned(16))) unsigned char lds_raw[];
    Frame F;
    F.lds = (LAS unsigned char*)lds_raw;
    F.tid = threadIdx.x; F.lane = F.tid & 63; F.wave = __builtin_amdgcn_readfirstlane(F.tid >> 6);
    F.G = gridDim.x; { const int bx = blockIdx.x; F.vcu = (F.G % 8 == 0) ? (bx % 8) * (F.G / 8) + bx / 8 : bx; }
    F.ws = args.ws; F.out = args.out; F.ctl = (unsigned*)(args.ws + WS_CTL);
    const int lo = args.ph_lo, hi = args.ph_hi;
    if (F.tid < 32) ((LAS unsigned*)(F.lds + L_MISC))[F.tid] = 0u;
    __syncthreads();
    XcdBarrier bar; bar.bar = F.ctl + CW_BAR; bar.x = 0; bar.st = nullptr;
    if (hi - lo > 1) bar = xcd_barrier_post(F.ctl + CW_BAR, (volatile LAS unsigned*)(F.lds + L_MISC) + 8);
#define SEAM(k) do { if (IN(k) && IN((k) + 1)) xcd_barrier(bar); } while (0)
#ifndef PHMASK
#define PHMASK 0x3ff
#endif
#define IN(k) (((PHMASK >> (k)) & 1) && lo <= (k) && (k) < hi)

    if (IN(0)) { p0_prologue(F, args); }
    SEAM(0);
    if (IN(1)) {
        pg8::StaticOrder S; S.init(NTOK, LDP, F.G, (int)blockIdx.x);
        pg8::EpiBf16 E{(bf16_t*)(F.ws + WS_PROJ), LDP};
        pg8::gemm_phase<pg8::EpiBf16, pg8::StaticOrder, true, false>(F.lds, (const bf16_t*)(F.ws + WS_HN), (const bf16_t*)(F.ws + WS_WIN), DM, S, E);
    }
    SEAM(1);
    if (IN(2)) { p2_naive(F, args); }
    SEAM(2);
    if (IN(3)) { p3_naive(F, args); }
    SEAM(3);
    if (IN(4)) { p4_naive(F, args); }
    SEAM(4);
    if (IN(5)) {
        pg8::StaticOrder S; S.init(NTOK, DM, F.G, (int)blockIdx.x);
        pg8::EpiResF32 E{args.in[0], F.out, DM};
        pg8::gemm_phase<pg8::EpiResF32, pg8::StaticOrder, false, false>(F.lds, (const bf16_t*)(F.ws + WS_HN), (const bf16_t*)(F.ws + WS_WOUT), DM, S, E);
    }
    SEAM(5);
    if (IN(6)) { p6_router(F, args); }
    SEAM(6);
    if (IN(7)) {
        const int nu = moe_setup(F, 3, true);
        pg8::MoeOrder S{(const LAS int*)(F.lds + L_UTAB), (const LAS unsigned*)(F.lds + L_ROWT), nu, 8};
        pg8::EpiGeglu E{(bf16_t*)(F.ws + WS_H)};
        pg8::gemm_phase<pg8::EpiGeglu, pg8::MoeOrder, true, true>(F.lds, (const bf16_t*)(F.ws + WS_HN), (const bf16_t*)(F.ws + WS_WGU), DM, S, E);
    }
    SEAM(7);
    if (IN(8)) {
        const int nu = moe_setup(F, 2, true);
        pg8::MoeOrder S{(const LAS int*)(F.lds + L_UTAB), (const LAS unsigned*)(F.lds + L_ROWT), nu, 4};
        pg8::EpiScaleBf16 E{(bf16_t*)(F.ws + WS_YB)};
        pg8::gemm_phase<pg8::EpiScaleBf16, pg8::MoeOrder, true, false>(F.lds, (const bf16_t*)(F.ws + WS_H), (const bf16_t*)(F.ws + WS_WD), DM, S, E);
    }
    SEAM(8);
    if (IN(9)) { moe_setup(F, 0, false); p9_final(F, args); }
#undef IN
#undef SEAM
}

extern "C" void kernel_launch(void* const* d_in, const int* in_sizes, int n_in, void* d_out, int out_size, void* d_ws, size_t ws_size, hipStream_t stream) {
    static int grid = 0;
    if (grid == 0) {
        if (n_in != 24 || out_size != NTOK * DM || ws_size < WS_END) { fprintf(stderr, "kernel_launch: unexpected shapes (n_in %d, out %d, ws %zu); nothing launched\n", n_in, out_size, ws_size); grid = -1; return; }
        int dev = 0, cus = 0;
        if (hipGetDevice(&dev) != hipSuccess || hipDeviceGetAttribute(&cus, hipDeviceAttributeMultiprocessorCount, dev) != hipSuccess) { grid = -1; return; }
        if (hipFuncSetAttribute((const void*)fwd, hipFuncAttributeMaxDynamicSharedMemorySize, LDS_BYTES) != hipSuccess) { fprintf(stderr, "kernel_launch: hipFuncSetAttribute failed\n"); grid = -1; return; }
        (void)hipGetLastError();
        grid = cus;
    }
    if (grid < 0) return;
    (void)hipMemsetAsync((char*)d_ws + WS_CTL, 0, CTL_ZERO_BYTES, stream);
    Args a{};
    for (int i = 0; i < 24; ++i) a.in[i] = (const float*)d_in[i];
    a.out = (float*)d_out; a.ws = (unsigned char*)d_ws;
#ifndef N_LAUNCHES
#define N_LAUNCHES 1
#endif
    if (N_LAUNCHES == 1) { a.ph_lo = 0; a.ph_hi = NPHASE; hipLaunchKernelGGL(fwd, dim3(grid), dim3(NTHR), LDS_BYTES, stream, a); }
    else for (int p = 0; p < NPHASE; ++p) { a.ph_lo = p; a.ph_hi = p + 1; hipLaunchKernelGGL(fwd, dim3(grid), dim3(NTHR), LDS_BYTES, stream, a); }
}
```

```cpp
#include <hip/hip_runtime.h>
#include <cstdio>
#include <cstdint>

#define LAS __attribute__((address_space(3)))
#define GAS __attribute__((address_space(1)))
typedef unsigned short bf16_t;
typedef short bf16x8 __attribute__((ext_vector_type(8)));
typedef float f32x4 __attribute__((ext_vector_type(4)));
typedef float f32x2 __attribute__((ext_vector_type(2)));
typedef unsigned u32x4 __attribute__((ext_vector_type(4)));
typedef unsigned u32x2 __attribute__((ext_vector_type(2)));

constexpr int NTOK = 16384, SEQ = 8192, DM = 1024;
constexpr int RGW = 512, NPROJ = 2576, LDP = 2816;
constexpr int C_XR = 0, C_YR = 512, C_Q = 1024, C_K = 1280, C_V = 1536, C_G = 2048, C_AL = 2560;
constexpr int NEXP = 32, CAP = 16384;
constexpr float EPS = 1e-6f;
constexpr int NWAVES = 8, NTHR = 512;
constexpr int NPHASE = 10;

constexpr size_t MiB = 1u << 20;
constexpr size_t WS_CTL = 0, CTL_ZERO_BYTES = 1 * MiB;
constexpr size_t WS_WRT = 1 * MiB;
constexpr size_t WS_WIN = 2 * MiB;
constexpr size_t WS_WOUT = 8 * MiB;
constexpr size_t WS_WGU = 16 * MiB;
constexpr size_t WS_WD = 144 * MiB;
constexpr size_t WS_HN = 208 * MiB;
constexpr size_t WS_PROJ = 240 * MiB;
constexpr size_t WS_SMALL = 10 * MiB;
constexpr size_t WS_KVT = 328 * MiB;
constexpr size_t WS_ST = 360 * MiB;
constexpr size_t WS_DEC = 376 * MiB, WS_RGSA = 377 * MiB, WS_RGSH = 377 * MiB + 512 * 1024, WS_RGC = 378 * MiB;
constexpr size_t WS_H = 240 * MiB;
constexpr size_t WS_YB = 320 * MiB;
constexpr size_t WS_STOK = 480 * MiB, WS_SW = 482 * MiB, WS_TIDX = 484 * MiB;
constexpr size_t WS_END = 512 * MiB;
constexpr int CW_BAR = 4096;
constexpr int CW_GCNT = 8192;

constexpr int RING_BYTES = 131072;
constexpr int CTRL_BASE = 143360;
constexpr int L_MISC = CTRL_BASE;
constexpr int L_CNT = CTRL_BASE + 128;
constexpr int L_TST = CTRL_BASE + 256;
constexpr int L_UTAB = CTRL_BASE + 512;
constexpr int L_ROWT = CTRL_BASE + 1024;
constexpr int L_WT = CTRL_BASE + 6144;
constexpr int LDS_BYTES = 155648;
static_assert(L_WT + 5 * 1024 <= LDS_BYTES, "LDS map");

__device__ __forceinline__ unsigned f2bf(float f) { unsigned u = __builtin_bit_cast(unsigned, f); return (u + 0x7fffu + ((u >> 16) & 1u)) >> 16; }
__device__ __forceinline__ unsigned pk2(float lo, float hi) { return f2bf(lo) | (f2bf(hi) << 16); }
__device__ __forceinline__ float bf2f(unsigned b) { return __builtin_bit_cast(float, b << 16); }
__device__ __forceinline__ float wave_sum(float v) {
#pragma unroll
    for (int o = 1; o < 64; o <<= 1) v += __shfl_xor(v, o);
    return v;
}
__device__ __forceinline__ float sigmoidf_(float x) { return 1.f / (1.f + __expf(-x)); }
__device__ __forceinline__ float gelu_tanh(float x) { const float z = 0.7978845608028654f * (x + 0.044715f * x * x * x); const float e = __expf(2.f * z); return 0.5f * x * (2.f - 2.f / (e + 1.f)); }

namespace pg8 {
constexpr int BM = 256, BK = 64, HALF = 128, HTB = HALF * BK * 2, NXCD = 8, WGM = 8;
__host__ __device__ __forceinline__ int lds_byte(int r, int c) { const int st = (r >> 4) * 2 + (c >> 5), rr = r & 15, cc = c & 31, ob = rr * 64 + cc * 2; return st * 1024 + (ob ^ (((ob >> 9) & 1) << 5)); }
__host__ __device__ __forceinline__ void stage_rc(int b, int& R, int& C) { const int st = b / 1024, sb = b % 1024, swz = sb ^ (((sb >> 9) & 1) << 5); R = (st >> 1) * 16 + swz / 64; C = (st & 1) * 32 + (swz % 64) / 2; }
__host__ __device__ __forceinline__ int perm32(int rho) { const int n = rho >> 4, i = rho & 15; return 8 * (i >> 2) + 4 * n + (i & 3); }

struct Unit { int pm, pn, bt, ui, e, rows; };

struct StaticOrder {
    int nM, nN, nwg, G, c;
    __device__ void init(int M, int N, int G_, int c_) { nM = M / BM; nN = N / BM; nwg = nM * nN; G = G_; c = c_; }
    __device__ bool next(int i, Unit& u) const {
        const long L = (long)i * G + c; if (L >= nwg) return false;
        int wgid = (int)L; { const int q = nwg / NXCD, r = nwg % NXCD, xcd = wgid % NXCD, off = wgid / NXCD; wgid = (xcd < r ? xcd * (q + 1) : r * (q + 1) + (xcd - r) * q) + off; }
        const int nig = WGM * nN, gid = wgid / nig, fm = gid * WGM, gsz = (nM - fm) < WGM ? (nM - fm) : WGM;
        u.pm = fm + ((wgid % nig) % gsz); u.pn = (wgid % nig) / gsz; u.bt = u.pn; u.ui = i; u.e = 0; u.rows = 256; return true;
    }
    __device__ __forceinline__ unsigned row_byte(const Unit&, int) const { return 0u; }
};

struct MoeOrder {
    const LAS int* utab; const LAS unsigned* rowt; int nu, ncol;
    __device__ bool next(int i, Unit& u) const {
        if (i >= nu) return false;
        u.pm = utab[i * 4 + 0]; u.pn = utab[i * 4 + 1]; u.e = utab[i * 4 + 2]; u.rows = utab[i * 4 + 3]; u.ui = i; u.bt = u.e * ncol + u.pn; return true;
    }
    __device__ __forceinline__ unsigned row_byte(const Unit& u, int r) const { return rowt[u.ui * 256 + r]; }
};

__device__ __forceinline__ unsigned cvt_pk_bf16(float lo, float hi) { unsigned r; asm volatile("v_cvt_pk_bf16_f32 %0, %1, %2" : "=v"(r) : "v"(lo), "v"(hi)); return r; }

struct EpiBf16 {
    static constexpr bool PERM = true;
    bf16_t* O; int ldc;
    __device__ __forceinline__ void operator()(const f32x4 (&acc)[2][2][4][2], const Unit& u, int wr, int wc, int fr, int fq, const LAS unsigned char*) const {
        const int row0 = u.pm * BM + wr * 64 + fr, col0 = u.pn * BM + wc * 32 + 8 * fq;
#pragma unroll
        for (int ai = 0; ai < 2; ++ai)
#pragma unroll
            for (int m = 0; m < 4; ++m) { bf16_t* rowp = O + (size_t)(row0 + ai * HALF + m * 16) * ldc + col0;
#pragma unroll
                for (int bj = 0; bj < 2; ++bj) { const f32x4 v0 = acc[ai][bj][m][0], v1 = acc[ai][bj][m][1];
                    u32x4 w; w.x = cvt_pk_bf16(v0[0], v0[1]); w.y = cvt_pk_bf16(v0[2], v0[3]); w.z = cvt_pk_bf16(v1[0], v1[1]); w.w = cvt_pk_bf16(v1[2], v1[3]);
                    *(u32x4*)(rowp + bj * HALF) = w; } }
    }
};
struct EpiResF32 {
    static constexpr bool PERM = false;
    const float* base; float* out; int ldc;
    __device__ __forceinline__ void operator()(const f32x4 (&acc)[2][2][4][2], const Unit& u, int wr, int wc, int fr, int fq, const LAS unsigned char*) const {
        const int col0 = u.pn * BM + wc * 32 + 4 * fq;
#pragma unroll
        for (int ai = 0; ai < 2; ++ai)
#pragma unroll
            for (int m = 0; m < 4; ++m) { const size_t off = (size_t)(u.pm * BM + ai * HALF + wr * 64 + m * 16 + fr) * ldc + col0;
#pragma unroll
                for (int bj = 0; bj < 2; ++bj)
#pragma unroll
                    for (int n = 0; n < 2; ++n) { const f32x4 bs = *(const f32x4*)(base + off + bj * HALF + n * 16); *(f32x4*)(out + off + bj * HALF + n * 16) = bs + acc[ai][bj][m][n]; } }
    }
};
struct EpiGeglu {
    static constexpr bool PERM = true;
    bf16_t* H;
    __device__ __forceinline__ void operator()(const f32x4 (&acc)[2][2][4][2], const Unit& u, int wr, int wc, int fr, int fq, const LAS unsigned char*) const {
        const int col0 = u.pn * HALF + wc * 32 + 8 * fq;
#pragma unroll
        for (int ai = 0; ai < 2; ++ai)
#pragma unroll
            for (int m = 0; m < 4; ++m) { const int r = ai * HALF + wr * 64 + m * 16 + fr;
                if (r < u.rows) {
                    const f32x4 g0 = acc[ai][0][m][0], g1 = acc[ai][0][m][1], u0 = acc[ai][1][m][0], u1 = acc[ai][1][m][1];
                    u32x4 w;
                    w.x = cvt_pk_bf16(gelu_tanh(g0[0]) * u0[0], gelu_tanh(g0[1]) * u0[1]); w.y = cvt_pk_bf16(gelu_tanh(g0[2]) * u0[2], gelu_tanh(g0[3]) * u0[3]);
                    w.z = cvt_pk_bf16(gelu_tanh(g1[0]) * u1[0], gelu_tanh(g1[1]) * u1[1]); w.w = cvt_pk_bf16(gelu_tanh(g1[2]) * u1[2], gelu_tanh(g1[3]) * u1[3]);
                    *(u32x4*)(H + (size_t)(u.pm * BM + r) * 1024 + col0) = w; } }
    }
};
struct EpiScaleBf16 {
    static constexpr bool PERM = true;
    bf16_t* Y;
    __device__ __forceinline__ void operator()(const f32x4 (&acc)[2][2][4][2], const Unit& u, int wr, int wc, int fr, int fq, const LAS unsigned char* lds) const {
        const int col0 = u.pn * BM + wc * 32 + 8 * fq; const LAS float* wt = (const LAS float*)(lds + L_WT) + u.ui * 256;
#pragma unroll
        for (int ai = 0; ai < 2; ++ai)
#pragma unroll
            for (int m = 0; m < 4; ++m) { const int r = ai * HALF + wr * 64 + m * 16 + fr;
                if (r < u.rows) { const float s = wt[r]; bf16_t* rowp = Y + (size_t)(u.pm * BM + r) * 1024 + col0;
#pragma unroll
                    for (int bj = 0; bj < 2; ++bj) { const f32x4 v0 = acc[ai][bj][m][0] * s, v1 = acc[ai][bj][m][1] * s;
                        u32x4 w; w.x = cvt_pk_bf16(v0[0], v0[1]); w.y = cvt_pk_bf16(v0[2], v0[3]); w.z = cvt_pk_bf16(v1[0], v1[1]); w.w = cvt_pk_bf16(v1[2], v1[3]);
                        *(u32x4*)(rowp + bj * HALF) = w; } } }
    }
};

template <class Epi, class Sched, bool ALIGN_EPI, bool GATHER>
__device__ __forceinline__ void gemm_phase(LAS unsigned char* lds, const bf16_t* Ab, const bf16_t* Bb, const int K, const Sched& S, const Epi& E) {
    const int tid = threadIdx.x, wid = __builtin_amdgcn_readfirstlane(tid >> 6), lane = tid & 63, wr = wid >> 2, wc = wid & 3, fr = lane & 15, fq = lane >> 4;
    const int nt = K / BK;
    int Rr[2], Cc[2]; unsigned voffB[2];
#pragma unroll
    for (int i = 0; i < 2; ++i) { int R, C; stage_rc(tid * 16 + i * 8192, R, C); Rr[i] = R; Cc[i] = C; const int Rb = Epi::PERM ? ((R & ~31) + perm32(R & 31)) : R; voffB[i] = (unsigned)(Rb * K + C) * 2u; }
    const size_t kstep = (size_t)(BK * 2);
    const size_t hstep = (size_t)HALF * K * 2;
    const size_t tstep = 2 * hstep;
    const unsigned ldsw = (unsigned)wid * 1024u;
    const int aoff = lds_byte(wr * 64 + fr, fq * 8), boff = lds_byte(wc * 32 + fr, fq * 8);
#define PG8_SA(b, h) (((b) * 2 + (h)) * HTB)
#define PG8_SB(b, h) ((4 + (b) * 2 + (h)) * HTB)
#define PG8_STAGE2(bufoff, gbase, o0, o1) do { \
        __builtin_amdgcn_global_load_lds((const unsigned*)((const char*)(gbase) + (o0)), (LAS unsigned*)(lds + (bufoff) + ldsw), 16, 0, 0); \
        __builtin_amdgcn_global_load_lds((const unsigned*)((const char*)(gbase) + (o1)), (LAS unsigned*)(lds + (bufoff) + ldsw + 8192), 16, 0, 0); } while (0)
#define PG8_STAGEB(bufoff, gbase) PG8_STAGE2(bufoff, gbase, voffB[0], voffB[1])
#define PG8_LDA(dst, b, h) do { _Pragma("unroll") for (int m = 0; m < 4; ++m) _Pragma("unroll") for (int k = 0; k < 2; ++k) dst[m][k] = *(const LAS bf16x8*)(lds + PG8_SA(b, h) + aoff + m * 2048 + k * 1024); } while (0)
#define PG8_LDB(dst, b, h) do { _Pragma("unroll") for (int n = 0; n < 2; ++n) _Pragma("unroll") for (int k = 0; k < 2; ++k) dst[n][k] = *(const LAS bf16x8*)(lds + PG8_SB(b, h) + boff + n * 2048 + k * 1024); } while (0)
#define PG8_MMA(ai, bj, At, Bt) do { __builtin_amdgcn_s_setprio(1); _Pragma("unroll") for (int m = 0; m < 4; ++m) _Pragma("unroll") for (int n = 0; n < 2; ++n) _Pragma("unroll") for (int k = 0; k < 2; ++k) \
        acc[ai][bj][m][n] = __builtin_amdgcn_mfma_f32_16x16x32_bf16(Bt[n][k], At[m][k], acc[ai][bj][m][n], 0, 0, 0); __builtin_amdgcn_s_setprio(0); } while (0)
#define PG8_WAIT_V(n) asm volatile("s_waitcnt vmcnt(" #n ")" ::: "memory")
#define PG8_WAIT_L(n) asm volatile("s_waitcnt lgkmcnt(" #n ")" ::: "memory")
#define PG8_BAR __builtin_amdgcn_s_barrier()
#define PG8_SCHED __builtin_amdgcn_sched_barrier(0)
    Unit cur, nxt; int ui = 0;
    if (!S.next(0, cur)) return;
    f32x4 acc[2][2][4][2];
#pragma unroll
    for (int a = 0; a < 2; ++a)
#pragma unroll
        for (int b = 0; b < 2; ++b)
#pragma unroll
            for (int m = 0; m < 4; ++m)
#pragma unroll
                for (int n = 0; n < 2; ++n) acc[a][b][m][n] = (f32x4){0.f, 0.f, 0.f, 0.f};
    bf16x8 At[4][2], B0[2][2], B1[2][2];
    unsigned vC[2][2], vN[2][2];
#pragma unroll
    for (int h = 0; h < 2; ++h)
#pragma unroll
        for (int i = 0; i < 2; ++i) { vC[h][i] = GATHER ? (S.row_byte(cur, h * HALF + Rr[i]) + (unsigned)Cc[i] * 2u) : (unsigned)((h * HALF + Rr[i]) * K + Cc[i]) * 2u; vN[h][i] = vC[h][i]; }
    const char* cA = GATHER ? (const char*)Ab : (const char*)Ab + (size_t)cur.pm * tstep; const char* cB = (const char*)Bb + (size_t)cur.bt * tstep;
    PG8_STAGEB(PG8_SB(0, 0), cB); PG8_STAGEB(PG8_SB(0, 1), cB + hstep); PG8_STAGE2(PG8_SA(0, 0), cA, vC[0][0], vC[0][1]); PG8_STAGE2(PG8_SA(0, 1), cA, vC[1][0], vC[1][1]);
    if (wr == 1) PG8_BAR;
    PG8_WAIT_V(2); PG8_BAR;
    PG8_STAGEB(PG8_SB(1, 0), cB + kstep); PG8_STAGE2(PG8_SA(1, 0), cA + kstep, vC[0][0], vC[0][1]); PG8_STAGEB(PG8_SB(1, 1), cB + hstep + kstep);
    PG8_WAIT_V(6); PG8_BAR;
    for (;;) {
        const bool has_next = S.next(ui + 1, nxt);
        const char* nA = has_next ? (GATHER ? (const char*)Ab : (const char*)Ab + (size_t)nxt.pm * tstep) : cA; const char* nB = has_next ? (const char*)Bb + (size_t)nxt.bt * tstep : cB;
        if constexpr (GATHER) {
            if (has_next) {
#pragma unroll
                for (int h = 0; h < 2; ++h)
#pragma unroll
                    for (int i = 0; i < 2; ++i) vN[h][i] = S.row_byte(nxt, h * HALF + Rr[i]) + (unsigned)Cc[i] * 2u;
            }
        }
        for (int t = 0; t < nt; t += 2) {
            const bool last = (t == nt - 2);
            const char* a1 = cA + (size_t)(t + 1) * kstep;
            const char* a2 = last ? nA : cA + (size_t)(t + 2) * kstep; const char* b2 = last ? nB : cB + (size_t)(t + 2) * kstep;
            const char* a3 = a2 + kstep; const char* b3 = b2 + kstep;
            unsigned w00, w01, w10, w11;
            if constexpr (GATHER) { w00 = last ? vN[0][0] : vC[0][0]; w01 = last ? vN[0][1] : vC[0][1]; w10 = last ? vN[1][0] : vC[1][0]; w11 = last ? vN[1][1] : vC[1][1]; }
            else { w00 = vC[0][0]; w01 = vC[0][1]; w10 = vC[1][0]; w11 = vC[1][1]; }
            PG8_LDB(B0, 0, 0); PG8_LDB(B1, 0, 1); PG8_SCHED; PG8_LDA(At, 0, 0); PG8_STAGE2(PG8_SA(1, 1), a1, vC[1][0], vC[1][1]);
            PG8_WAIT_V(8); PG8_WAIT_L(0); PG8_BAR; PG8_MMA(0, 0, At, B0); PG8_MMA(0, 1, At, B1); PG8_BAR; PG8_SCHED;
            PG8_LDA(At, 0, 1); PG8_STAGEB(PG8_SB(0, 0), b2); PG8_STAGEB(PG8_SB(0, 1), b2 + hstep); PG8_STAGE2(PG8_SA(0, 0), a2, w00, w01);
            PG8_WAIT_V(8); PG8_WAIT_L(0); PG8_BAR; PG8_MMA(1, 0, At, B0); PG8_MMA(1, 1, At, B1); PG8_BAR; PG8_SCHED;
            PG8_LDB(B0, 1, 0); PG8_LDB(B1, 1, 1); PG8_SCHED; PG8_LDA(At, 1, 0); PG8_STAGE2(PG8_SA(0, 1), a2, w10, w11);
            PG8_WAIT_V(8); PG8_WAIT_L(0); PG8_BAR; PG8_MMA(0, 0, At, B0); PG8_MMA(0, 1, At, B1); PG8_BAR; PG8_SCHED;
            PG8_LDA(At, 1, 1); PG8_STAGEB(PG8_SB(1, 0), b3); PG8_STAGEB(PG8_SB(1, 1), b3 + hstep); PG8_STAGE2(PG8_SA(1, 0), a3, w00, w01);
            PG8_WAIT_V(8); PG8_WAIT_L(0); PG8_BAR; PG8_MMA(1, 0, At, B0); PG8_MMA(1, 1, At, B1); PG8_BAR; PG8_SCHED;
        }
        if constexpr (ALIGN_EPI) { if (wr == 0) PG8_BAR; }
        E(acc, cur, wr, wc, fr, fq, lds);
        if (!has_next) break;
#pragma unroll
        for (int a = 0; a < 2; ++a)
#pragma unroll
            for (int b = 0; b < 2; ++b)
#pragma unroll
                for (int m = 0; m < 4; ++m)
#pragma unroll
                    for (int n = 0; n < 2; ++n) acc[a][b][m][n] = (f32x4){0.f, 0.f, 0.f, 0.f};
        cur = nxt; cA = nA; cB = nB; ++ui;
        if constexpr (GATHER) {
#pragma unroll
            for (int h = 0; h < 2; ++h)
#pragma unroll
                for (int i = 0; i < 2; ++i) vC[h][i] = vN[h][i];
        }
        if constexpr (ALIGN_EPI) { if (wr == 1) PG8_BAR; }
    }
    PG8_WAIT_V(0);
    if constexpr (!ALIGN_EPI) { if (wr == 0) PG8_BAR; }
    PG8_BAR;
#undef PG8_SA
#undef PG8_SB
#undef PG8_STAGE2
#undef PG8_STAGEB
#undef PG8_LDA
#undef PG8_LDB
#undef PG8_MMA
#undef PG8_WAIT_V
#undef PG8_WAIT_L
#undef PG8_BAR
#undef PG8_SCHED
}
}


#define XB_TMO      128
#define XB_XCNT(j)  (256  + 64 * (j))
#define XB_XSUB(j)  (1280 + 64 * (j))
#define XB_XGEN(j)  (2304 + 64 * (j))
#define XB_TOP      3328
#define XB_TOPGEN   3392
#define XCD_BAR_WORDS 3456
#define XB_SPIN_CAP (1u << 18)

__device__ __forceinline__ unsigned xb_ld(unsigned* p)              { return __hip_atomic_load(p, __ATOMIC_RELAXED, __HIP_MEMORY_SCOPE_AGENT); }
__device__ __forceinline__ unsigned xb_add(unsigned* p, unsigned v) { return __hip_atomic_fetch_add(p, v, __ATOMIC_RELAXED, __HIP_MEMORY_SCOPE_AGENT); }
__device__ __forceinline__ unsigned xb_xcc_id() { return (unsigned)__builtin_amdgcn_s_getreg((3 << 11) | 20) & 0xFu; }
#define XB_SPIN(cond, bar) do { unsigned _sp = 0; while (cond) { __builtin_amdgcn_s_sleep(1); \
    if ((++_sp & 255u) == 0u) { if (xb_ld(&(bar)[XB_TMO])) break; if (_sp > XB_SPIN_CAP) { atomicAdd(&(bar)[XB_TMO], 1u); break; } } } } while (0)

struct XcdBarrier {
    unsigned* bar; unsigned x;
    volatile LAS unsigned* st;
};
__device__ __forceinline__ XcdBarrier xcd_barrier_post(unsigned* bar, volatile LAS unsigned* st) {
    XcdBarrier b; b.bar = bar; b.x = xb_xcc_id(); b.st = st;
    if (threadIdx.x == 0) (void)xb_add(&bar[XB_XCNT(b.x)], 1u);
    return b;
}
__device__ __forceinline__ void xcd_barrier_complete(unsigned* bar, unsigned x, unsigned& nloc, unsigned& nx) {
    const unsigned G = gridDim.x * gridDim.y * gridDim.z;
    unsigned sum, cnt, mine, sp = 0u;
    for (;;) {
        sum = 0u; cnt = 0u; mine = 0u;
#pragma unroll
        for (unsigned j = 0; j < 16; ++j) { const unsigned c = xb_ld(&bar[XB_XCNT(j)]); sum += c; cnt += (c > 0u) ? 1u : 0u; mine = (j == x) ? c : mine; }
        if (sum == G) break;
        __builtin_amdgcn_s_sleep(1);
        if ((++sp & 255u) == 0u) { if (xb_ld(&bar[XB_TMO])) break; if (sp > XB_SPIN_CAP) { atomicAdd(&bar[XB_TMO], 1u); break; } }
    }
    nloc = mine > 0u ? mine : 1u; nx = cnt > 0u ? cnt : 1u;
}
__device__ __forceinline__ void xcd_barrier(const XcdBarrier& b) {
    asm volatile("s_waitcnt vmcnt(0)" ::: "memory");
    __syncthreads();
    if (threadIdx.x == 0) {
        unsigned* bar = b.bar;
        __builtin_amdgcn_s_waitcnt(0);
        unsigned nloc = b.st[0], nx = b.st[1];
        if (nloc == 0u) { xcd_barrier_complete(bar, b.x, nloc, nx); b.st[0] = nloc; b.st[1] = nx; }
        const unsigned old = xb_add(&bar[XB_XSUB(b.x)], 1u);
        const unsigned gen = old / nloc;
        if (old + 1u == (gen + 1u) * nloc) {
            __builtin_amdgcn_fence(__ATOMIC_RELEASE, "agent");
            asm volatile("s_waitcnt vmcnt(0)" ::: "memory");
            const unsigned og = xb_add(&bar[XB_TOP], 1u);
            const unsigned tg = og / nx;
            if (og + 1u == (tg + 1u) * nx) xb_add(&bar[XB_TOPGEN], 1u);
            else XB_SPIN(xb_ld(&bar[XB_TOPGEN]) == tg, bar);
            __builtin_amdgcn_fence(__ATOMIC_ACQUIRE, "agent");
            xb_add(&bar[XB_XGEN(b.x)], 1u);
            asm volatile("s_waitcnt vmcnt(0)" ::: "memory");
        } else {
            XB_SPIN(xb_ld(&bar[XB_XGEN(b.x)]) == gen, bar);
            __builtin_amdgcn_fence(__ATOMIC_ACQUIRE, "agent");
            asm volatile("s_waitcnt vmcnt(0)" ::: "memory");
        }
    }
    __syncthreads();
}

struct Args { const float* in[24]; float* out; unsigned char* ws; int ph_lo, ph_hi; };

struct Frame {
    LAS unsigned char* lds;
    unsigned* ctl;
    int tid, lane, wave, vcu, G;
    unsigned char* ws; float* out;
};

__device__ __forceinline__ void transpose_item(const float* W, int K, int Nsrc, bf16_t* WT, int k0, int n0, int orow0, LAS float* scr, int lane) {
    const int nn = n0 + (lane & 31); const bool ok = nn < Nsrc;
#pragma unroll 8
    for (int i = 0; i < 32; ++i) { const int kk = 2 * i + (lane >> 5); scr[kk * 33 + (lane & 31)] = ok ? W[(size_t)(k0 + kk) * Nsrc + nn] : 0.f; }
    asm volatile("s_waitcnt lgkmcnt(0)" ::: "memory");
    const int c = lane & 7;
#pragma unroll
    for (int j = 0; j < 4; ++j) { const int n = (lane >> 3) + 8 * j; const LAS float* s = scr + (8 * c) * 33 + n;
        u32x4 o; o.x = pk2(s[0 * 33], s[1 * 33]); o.y = pk2(s[2 * 33], s[3 * 33]); o.z = pk2(s[4 * 33], s[5 * 33]); o.w = pk2(s[6 * 33], s[7 * 33]);
        *(u32x4*)(WT + (size_t)(orow0 + n) * K + k0 + 8 * c) = o; }
    asm volatile("s_waitcnt lgkmcnt(0)" ::: "memory");
}
__device__ __forceinline__ void rms_row_to_bf16(const float* xrow, const float* gain, bf16_t* orow, int lane) {
    const f32x4* xr = (const f32x4*)xrow + lane; const f32x4* gr = (const f32x4*)gain + lane;
    f32x4 v[4]; float s = 0.f;
#pragma unroll
    for (int j = 0; j < 4; ++j) { v[j] = xr[64 * j]; s += (v[j].x * v[j].x + v[j].y * v[j].y) + (v[j].z * v[j].z + v[j].w * v[j].w); }
    const float rs = 1.f / sqrtf(wave_sum(s) * (1.f / DM) + EPS);
    unsigned long long* o8 = (unsigned long long*)orow + lane;
#pragma unroll
    for (int j = 0; j < 4; ++j) { const f32x4 g = gr[64 * j]; o8[64 * j] = (unsigned long long)pk2(v[j].x * rs * g.x, v[j].y * rs * g.y) | ((unsigned long long)pk2(v[j].z * rs * g.z, v[j].w * rs * g.w) << 32); }
}

__device__ __forceinline__ void p0_prologue(Frame& F, const Args& a) {
    LAS float* scr = (LAS float*)(F.lds + F.wave * 16384);
    const int gw = F.vcu * NWAVES + F.wave, NGW = F.G * NWAVES;
    bf16_t* WIN = (bf16_t*)(F.ws + WS_WIN); bf16_t* WOUT = (bf16_t*)(F.ws + WS_WOUT); bf16_t* WGU = (bf16_t*)(F.ws + WS_WGU); bf16_t* WD = (bf16_t*)(F.ws + WS_WD);
    constexpr int I_IN = 16 * 88, I_OUT = 16 * 32, I_E = 16 * 32;
    constexpr int NITEMS = I_IN + I_OUT + NEXP * 3 * I_E;
    for (int it = gw; it < NITEMS; it += NGW) {
        int r = it;
        if (r < I_IN) { const int kb = r / 88, nb = r % 88; transpose_item(a.in[2], DM, NPROJ, WIN, 64 * kb, 32 * nb, 32 * nb, scr, F.lane); continue; } r -= I_IN;
        if (r < I_OUT) { const int kb = r / 32, nb = r % 32; transpose_item(a.in[14], DM, DM, WOUT, 64 * kb, 32 * nb, 32 * nb, scr, F.lane); continue; } r -= I_OUT;
        const int e = r / (3 * I_E), w = (r / I_E) % 3, q = r % I_E, kb = q / 32, nb = q % 32, n0 = 32 * nb;
        if (w == 0) transpose_item(a.in[20] + (size_t)e * DM * DM, DM, DM, WGU + (size_t)e * 2048 * DM, 64 * kb, n0, (n0 >> 7) * 256 + (n0 & 127), scr, F.lane);
        else if (w == 1) transpose_item(a.in[21] + (size_t)e * DM * DM, DM, DM, WGU + (size_t)e * 2048 * DM, 64 * kb, n0, (n0 >> 7) * 256 + 128 + (n0 & 127), scr, F.lane);
        else transpose_item(a.in[22] + (size_t)e * DM * DM, DM, DM, WD + (size_t)e * DM * DM, 64 * kb, n0, n0, scr, F.lane);
    }
    float* WRT = (float*)(F.ws + WS_WRT);
    for (int idx = blockIdx.x * NTHR + F.tid; idx < 36 * DM; idx += F.G * NTHR) { const int j = idx / DM, k = idx % DM; WRT[idx] = j < 4 ? a.in[16][k * 4 + j] : a.in[18][k * 32 + (j - 4)]; }
    {
        bf16_t* WAT = (bf16_t*)(F.ws + WS_SMALL); bf16_t* WXT = WAT + 8 * 64 * 64; bf16_t* WUPT = WXT + 8 * 64 * 64;
        for (int idx = blockIdx.x * NTHR + F.tid; idx < 8 * 64 * 64; idx += F.G * NTHR) { const int h = idx >> 12, j = (idx >> 6) & 63, i = idx & 63;
            WAT[idx] = (bf16_t)f2bf(a.in[5][(h * 64 + i) * 64 + j]); WXT[idx] = (bf16_t)f2bf(a.in[7][(h * 64 + i) * 64 + j]); }
        for (int idx = blockIdx.x * NTHR + F.tid; idx < 256 * 32; idx += F.G * NTHR) { const int n = idx >> 5, k = idx & 31; WUPT[idx] = k < 16 ? (bf16_t)f2bf(a.in[11][k * 256 + n]) : (bf16_t)0; }
    }
    bf16_t* HN = (bf16_t*)(F.ws + WS_HN);
    for (int m = gw; m < NTOK; m += NGW) rms_row_to_bf16(a.in[0] + (size_t)m * DM, a.in[1], HN + (size_t)m * DM, F.lane);
}

template <int KS> __device__ __forceinline__ f32x4 mma_ll(f32x4 acc, const LAS unsigned char* A, int lda, const LAS unsigned char* Bt, int ldb, int lane) {
    const LAS unsigned char* ap = A + (lane & 15) * lda + (lane >> 4) * 16; const LAS unsigned char* bp = Bt + (lane & 15) * ldb + (lane >> 4) * 16;
#pragma unroll
    for (int ks = 0; ks < KS; ++ks) acc = __builtin_amdgcn_mfma_f32_16x16x32_bf16(*(const LAS bf16x8*)(ap + ks * 64), *(const LAS bf16x8*)(bp + ks * 64), acc, 0, 0, 0);
    return acc;
}
template <int KS> __device__ __forceinline__ f32x4 mma_lg(f32x4 acc, const LAS unsigned char* A, int lda, const bf16_t* Bt, int ldb_elems, int lane) {
    const LAS unsigned char* ap = A + (lane & 15) * lda + (lane >> 4) * 16; const bf16_t* bp = Bt + (size_t)(lane & 15) * ldb_elems + (lane >> 4) * 8;
#pragma unroll
    for (int ks = 0; ks < KS; ++ks) acc = __builtin_amdgcn_mfma_f32_16x16x32_bf16(*(const LAS bf16x8*)(ap + ks * 64), *(const bf16x8*)(bp + ks * 32), acc, 0, 0, 0);
    return acc;
}
#define WAVE_LDS_FENCE() asm volatile("s_waitcnt lgkmcnt(0)" ::: "memory")
__device__ __forceinline__ float logsigmoidf_(float g) { return fminf(g, 0.f) - __logf(1.f + __expf(-fabsf(g))); }
__device__ __forceinline__ void unpack8(const u32x4 w, float (&f)[8]) { f[0] = bf2f(w.x & 0xffffu); f[1] = bf2f(w.x >> 16); f[2] = bf2f(w.y & 0xffffu); f[3] = bf2f(w.y >> 16); f[4] = bf2f(w.z & 0xffffu); f[5] = bf2f(w.z >> 16); f[6] = bf2f(w.w & 0xffffu); f[7] = bf2f(w.w >> 16); }
__device__ __forceinline__ u32x4 pack8(const float (&f)[8]) { u32x4 w; w.x = pk2(f[0], f[1]); w.y = pk2(f[2], f[3]); w.z = pk2(f[4], f[5]); w.w = pk2(f[6], f[7]); return w; }

constexpr int XS = 144;
constexpr int RG_AU = 8 * 64 * XS;
constexpr int GL_AL = 0, GL_BT = 5120, GL_T1 = 21504, GL_T2 = 30720, GL_T3 = 39936, GL_VT4 = 49152, GL_REGION = 67584;
static_assert(RG_AU + 8 * 8192 <= 143360 && 2 * GL_REGION <= 143360, "mixer LDS");

template <bool FIN> __device__ __forceinline__ void mixer_chunk(Frame& F, const Args& a, const int chunk) {
    const bf16_t* PROJ = (const bf16_t*)(F.ws + WS_PROJ); bf16_t* Y = (bf16_t*)(F.ws + WS_HN);
    const int t0 = chunk * 64, nloc = chunk & 127, lane = F.lane, w = F.wave, c16 = lane & 15, g4 = lane >> 4;
    LAS unsigned char* L = F.lds;
    {
        LAS unsigned char* slab = L + w * (64 * XS);
        LAS float* au_a = (LAS float*)(L + RG_AU + w * 8192); LAS float* au_u = au_a + 1024;
        const float* conv_w = a.in[3]; const float* conv_b = a.in[4];
        {
            const int cg = lane & 7, ch0 = 64 * w + 8 * cg;
            float cw[4][8], cb[8];
#pragma unroll
            for (int j = 0; j < 4; ++j) { const f32x4 p = *(const f32x4*)(conv_w + j * RGW + ch0), q = *(const f32x4*)(conv_w + j * RGW + ch0 + 4); cw[j][0] = p.x; cw[j][1] = p.y; cw[j][2] = p.z; cw[j][3] = p.w; cw[j][4] = q.x; cw[j][5] = q.y; cw[j][6] = q.z; cw[j][7] = q.w; }
            { const f32x4 p = *(const f32x4*)(conv_b + ch0), q = *(const f32x4*)(conv_b + ch0 + 4); cb[0] = p.x; cb[1] = p.y; cb[2] = p.z; cb[3] = p.w; cb[4] = q.x; cb[5] = q.y; cb[6] = q.z; cb[7] = q.w; }
#pragma unroll 2
            for (int it = 0; it < 8; ++it) {
                const int tok = (lane >> 3) + 8 * it;
                float xc[8];
#pragma unroll
                for (int i = 0; i < 8; ++i) xc[i] = cb[i];
#pragma unroll
                for (int j = 0; j < 4; ++j) { const int tl = nloc * 64 + tok - 3 + j;
                    if (tl >= 0) { float xv[8]; unpack8(*(const u32x4*)(PROJ + (size_t)(t0 + tok - 3 + j) * LDP + C_XR + ch0), xv);
#pragma unroll
                        for (int i = 0; i < 8; ++i) xc[i] += cw[j][i] * xv[i]; } }
                *(LAS u32x4*)(slab + tok * XS + cg * 16) = pack8(xc);
            }
        }
        WAVE_LDS_FENCE();
        bf16x8 af[4][2];
#pragma unroll
        for (int mt = 0; mt < 4; ++mt)
#pragma unroll
            for (int ks = 0; ks < 2; ++ks) af[mt][ks] = *(const LAS bf16x8*)(slab + (16 * mt + c16) * XS + ks * 64 + g4 * 16);
        const bf16_t* WAT = (const bf16_t*)(F.ws + WS_SMALL); const bf16_t* WXT = WAT + 8 * 64 * 64;
        const float* b_a = a.in[6]; const float* b_x = a.in[8]; const float* lam = a.in[9];
        const float* RGC = (const float*)(F.ws + WS_RGC); float* RGSA = (float*)(F.ws + WS_RGSA); float* RGSH = (float*)(F.ws + WS_RGSH);
#pragma unroll 1
        for (int nt = 0; nt < 4; ++nt) {
            const int ch = 64 * w + 16 * nt + c16;
            const bf16_t* wa = WAT + (size_t)(64 * w + 16 * nt + c16) * 64 + g4 * 8; const bf16_t* wx = WXT + (size_t)(64 * w + 16 * nt + c16) * 64 + g4 * 8;
            const bf16x8 ba0 = *(const bf16x8*)wa, ba1 = *(const bf16x8*)(wa + 32), bx0 = *(const bf16x8*)wx, bx1 = *(const bf16x8*)(wx + 32);
            const float bias_a = b_a[ch], bias_x = b_x[ch], sp8 = 8.f * log1pf(__expf(-lam[ch]));
#pragma unroll
            for (int mt = 0; mt < 4; ++mt) {
                f32x4 R = {0.f, 0.f, 0.f, 0.f}, I = {0.f, 0.f, 0.f, 0.f};
                R = __builtin_amdgcn_mfma_f32_16x16x32_bf16(af[mt][0], ba0, R, 0, 0, 0); R = __builtin_amdgcn_mfma_f32_16x16x32_bf16(af[mt][1], ba1, R, 0, 0, 0);
                I = __builtin_amdgcn_mfma_f32_16x16x32_bf16(af[mt][0], bx0, I, 0, 0, 0); I = __builtin_amdgcn_mfma_f32_16x16x32_bf16(af[mt][1], bx1, I, 0, 0, 0);
#pragma unroll
                for (int r = 0; r < 4; ++r) { const int tok = 16 * mt + 4 * g4 + r;
                    const float rr = sigmoidf_(R[r] + bias_a), ii = sigmoidf_(I[r] + bias_x);
                    const float x2 = -2.f * sp8 * rr;
                    const float av = __expf(0.5f * x2);
                    const float om = (x2 > -0.1f) ? -x2 * (1.f + x2 * (0.5f + x2 * (0.16666667f + x2 * 0.041666668f))) : 1.f - __expf(x2);
                    const float xcv = bf2f(*(const LAS unsigned short*)(slab + tok * XS + (16 * nt + c16) * 2));
                    au_a[tok * 16 + c16] = av; au_u[tok * 16 + c16] = sqrtf(om) * (ii * xcv); }
            }
            WAVE_LDS_FENCE();
            if (lane < 16) {
                float h = FIN ? RGC[(size_t)chunk * RGW + ch] : 0.f, P = 1.f;
#pragma unroll 8
                for (int tok = 0; tok < 64; ++tok) { const float av = au_a[tok * 16 + lane], uv = au_u[tok * 16 + lane]; h = av * h + uv; P *= av;
                    if (FIN) *(LAS unsigned short*)(slab + tok * XS + (16 * nt + lane) * 2) = (unsigned short)f2bf(h); }
                if (!FIN) { RGSA[(size_t)chunk * RGW + ch] = P; RGSH[(size_t)chunk * RGW + ch] = h; }
            }
            WAVE_LDS_FENCE();
        }
        if (FIN) {
            __syncthreads();
            const float* rg_norm = a.in[10];
            float gn[8]; { const f32x4 p = *(const f32x4*)(rg_norm + 8 * lane), q = *(const f32x4*)(rg_norm + 8 * lane + 4); gn[0] = p.x; gn[1] = p.y; gn[2] = p.z; gn[3] = p.w; gn[4] = q.x; gn[5] = q.y; gn[6] = q.z; gn[7] = q.w; }
#pragma unroll 2
            for (int i = 0; i < 8; ++i) { const int tok = 8 * w + i;
                float hv[8], yv[8]; unpack8(*(const LAS u32x4*)(L + (lane >> 3) * (64 * XS) + tok * XS + (lane & 7) * 16), hv); unpack8(*(const u32x4*)(PROJ + (size_t)(t0 + tok) * LDP + C_YR + 8 * lane), yv);
                float ss = 0.f;
#pragma unroll
                for (int j = 0; j < 8; ++j) { hv[j] *= gelu_tanh(yv[j]); ss += hv[j] * hv[j]; }
                const float rs = 1.f / sqrtf(wave_sum(ss) * (1.f / 512.f) + EPS);
#pragma unroll
                for (int j = 0; j < 8; ++j) hv[j] *= rs * gn[j];
                *(u32x4*)(Y + (size_t)(t0 + tok) * DM + 8 * lane) = pack8(hv); }
        }
        __syncthreads();
    }
    const bf16_t* WUPT = (const bf16_t*)(F.ws + WS_SMALL) + 2 * 8 * 64 * 64;
    const float* b_al = a.in[12];
    float* KVT = (float*)(F.ws + WS_KVT); float* DEC = (float*)(F.ws + WS_DEC); const bf16_t* ST = (const bf16_t*)(F.ws + WS_ST);
#pragma unroll 1
    for (int pass = 0; pass < 2; ++pass) {
        const int s = w >> 2, q4 = w & 3, hh = 2 * pass + s, ht = F.tid & 255;
        LAS unsigned char* R = L + s * GL_REGION;
        LAS float* BT = (LAS float*)(R + GL_BT);
        LAS unsigned char* VT = R + (FIN ? GL_VT4 : GL_T2);
        if (ht < 128) { const int tok = ht >> 1, half = ht & 1; *(LAS u32x4*)(R + GL_AL + tok * 80 + half * 16) = *(const u32x4*)(PROJ + (size_t)(t0 + tok) * LDP + C_AL + 8 * half); *(LAS u32x4*)(R + GL_AL + tok * 80 + 32 + half * 16) = (u32x4){0u, 0u, 0u, 0u}; }
#pragma unroll
        for (int i = 0; i < 4; ++i) { const int idx = ht + 256 * i, tok = idx >> 4, ec = idx & 15; const u32x4 v = *(const u32x4*)(PROJ + (size_t)(t0 + tok) * LDP + C_V + hh * 128 + 8 * ec);
            LAS unsigned short* vt = (LAS unsigned short*)(VT + (8 * ec) * XS + tok * 2);
            vt[0 * (XS / 2)] = (unsigned short)(v.x & 0xffffu); vt[1 * (XS / 2)] = (unsigned short)(v.x >> 16); vt[2 * (XS / 2)] = (unsigned short)(v.y & 0xffffu); vt[3 * (XS / 2)] = (unsigned short)(v.y >> 16);
            vt[4 * (XS / 2)] = (unsigned short)(v.z & 0xffffu); vt[5 * (XS / 2)] = (unsigned short)(v.z >> 16); vt[6 * (XS / 2)] = (unsigned short)(v.w & 0xffffu); vt[7 * (XS / 2)] = (unsigned short)(v.w >> 16); }
        __syncthreads();
#pragma unroll
        for (int nt = 0; nt < 4; ++nt) { f32x4 acc = {0.f, 0.f, 0.f, 0.f};
            acc = mma_lg<1>(acc, R + GL_AL + (16 * q4) * 80, 80, WUPT + (size_t)(hh * 64 + 16 * nt) * 32, 32, lane);
            const float bb = b_al[hh * 64 + 16 * nt + c16];
#pragma unroll
            for (int r = 0; r < 4; ++r) BT[(16 * q4 + 4 * g4 + r) * 64 + 16 * nt + c16] = logsigmoidf_(acc[r] + bb) * (1.f / 16.f); }
        __syncthreads();
        if (q4 == 0) { float run = 0.f;
#pragma unroll 8
            for (int tok = 0; tok < 64; ++tok) { run += BT[tok * 64 + lane]; BT[tok * 64 + lane] = run; } }
        __syncthreads();
#pragma unroll
        for (int i = 0; i < 2; ++i) { const int idx = ht + 256 * i, tok = idx >> 3, dc = idx & 7;
            float bv[8], kv[8]; { const f32x4 p = *(const LAS f32x4*)(BT + tok * 64 + 8 * dc), q = *(const LAS f32x4*)(BT + tok * 64 + 8 * dc + 4); bv[0] = p.x; bv[1] = p.y; bv[2] = p.z; bv[3] = p.w; bv[4] = q.x; bv[5] = q.y; bv[6] = q.z; bv[7] = q.w; }
            unpack8(*(const u32x4*)(PROJ + (size_t)(t0 + tok) * LDP + C_K + hh * 64 + 8 * dc), kv);
            if (!FIN) { float bl[8]; { const f32x4 p = *(const LAS f32x4*)(BT + 63 * 64 + 8 * dc), q = *(const LAS f32x4*)(BT + 63 * 64 + 8 * dc + 4); bl[0] = p.x; bl[1] = p.y; bl[2] = p.z; bl[3] = p.w; bl[4] = q.x; bl[5] = q.y; bl[6] = q.z; bl[7] = q.w; }
                LAS unsigned short* ke = (LAS unsigned short*)(R + GL_T1 + (8 * dc) * XS + tok * 2);
#pragma unroll
                for (int j = 0; j < 8; ++j) ke[j * (XS / 2)] = (unsigned short)f2bf(kv[j] * __expf(bl[j] - bv[j])); }
            else { float qv[8]; unpack8(*(const u32x4*)(PROJ + (size_t)(t0 + tok) * LDP + C_Q + hh * 64 + 8 * dc), qv);
#pragma unroll
                for (int j = 0; j < 8; ++j) { const float eb = __expf(bv[j]); qv[j] *= 0.125f * eb; kv[j] *= 1.f / eb; }
                *(LAS u32x4*)(R + GL_T1 + tok * XS + dc * 16) = pack8(qv); *(LAS u32x4*)(R + GL_T2 + tok * XS + dc * 16) = pack8(kv); } }
        if (!FIN && ht < 64) DEC[(size_t)(chunk * 4 + hh) * 64 + ht] = __expf(BT[63 * 64 + ht]);
        __syncthreads();
        if (!FIN) {
#pragma unroll
            for (int mi = 0; mi < 2; ++mi) { const int mt = 2 * q4 + mi;
#pragma unroll
                for (int nt = 0; nt < 4; ++nt) { f32x4 acc = {0.f, 0.f, 0.f, 0.f}; acc = mma_ll<2>(acc, VT + (16 * mt) * XS, XS, R + GL_T1 + (16 * nt) * XS, XS, lane);
#pragma unroll
                    for (int r = 0; r < 4; ++r) KVT[((size_t)(chunk * 4 + hh) * 128 + 16 * mt + 4 * g4 + r) * 64 + 16 * nt + c16] = acc[r]; } }
        } else {
#pragma unroll
            for (int nt = 0; nt < 4; ++nt) { f32x4 acc = {0.f, 0.f, 0.f, 0.f}; acc = mma_ll<2>(acc, R + GL_T2 + (16 * q4) * XS, XS, R + GL_T1 + (16 * nt) * XS, XS, lane);
                const int i = 16 * nt + c16, j0 = 16 * q4 + 4 * g4;
                u32x2 pw; pw.x = pk2(j0 <= i ? acc[0] : 0.f, j0 + 1 <= i ? acc[1] : 0.f); pw.y = pk2(j0 + 2 <= i ? acc[2] : 0.f, j0 + 3 <= i ? acc[3] : 0.f);
                *(LAS u32x2*)(R + GL_T3 + i * XS + j0 * 2) = pw; }
            __syncthreads();
            f32x4 o[8]; const bf16_t* st = ST + (size_t)(chunk * 4 + hh) * 128 * 64;
#pragma unroll
            for (int nt = 0; nt < 8; ++nt) { f32x4 acc = {0.f, 0.f, 0.f, 0.f};
                acc = mma_ll<2>(acc, R + GL_T3 + (16 * q4) * XS, XS, VT + (16 * nt) * XS, XS, lane);
                acc = mma_lg<2>(acc, R + GL_T1 + (16 * q4) * XS, XS, st + (size_t)(16 * nt) * 64, 64, lane);
                o[nt] = acc; }
            const float* gla_norm = a.in[13];
            float rs[4];
#pragma unroll
            for (int r = 0; r < 4; ++r) { float ss = 0.f;
#pragma unroll
                for (int nt = 0; nt < 8; ++nt) ss += o[nt][r] * o[nt][r];
                ss += __shfl_xor(ss, 1); ss += __shfl_xor(ss, 2); ss += __shfl_xor(ss, 4); ss += __shfl_xor(ss, 8);
                rs[r] = 1.f / sqrtf(ss * (1.f / 128.f) + EPS); }
            LAS unsigned short* OY = (LAS unsigned short*)(R + GL_BT);
#pragma unroll
            for (int nt = 0; nt < 8; ++nt) { const float gnv = gla_norm[16 * nt + c16];
#pragma unroll
                for (int r = 0; r < 4; ++r) OY[(16 * q4 + 4 * g4 + r) * 128 + 16 * nt + c16] = (unsigned short)f2bf(o[nt][r] * rs[r] * gnv); }
            __syncthreads();
#pragma unroll
            for (int i = 0; i < 4; ++i) { const int idx = ht + 256 * i, tok = idx >> 4, ec = idx & 15;
                float ov[8], gv[8]; unpack8(*(const LAS u32x4*)(OY + tok * 128 + 8 * ec), ov); unpack8(*(const u32x4*)(PROJ + (size_t)(t0 + tok) * LDP + C_G + hh * 128 + 8 * ec), gv);
#pragma unroll
                for (int j = 0; j < 8; ++j) ov[j] *= gv[j] * sigmoidf_(gv[j]);
                *(u32x4*)(Y + (size_t)(t0 + tok) * DM + 512 + hh * 128 + 8 * ec) = pack8(ov); }
        }
        __syncthreads();
    }
}

__device__ __forceinline__ void m3_scan(Frame& F) {
    const float* KVT = (const float*)(F.ws + WS_KVT); const float* DEC = (const float*)(F.ws + WS_DEC); bf16_t* ST = (bf16_t*)(F.ws + WS_ST);
    const float* RGSA = (const float*)(F.ws + WS_RGSA); const float* RGSH = (const float*)(F.ws + WS_RGSH); float* RGC = (float*)(F.ws + WS_RGC);
    const int bx = blockIdx.x;
    if (bx < 128) {
        const int id = bx * 512 + F.tid, d = id & 63, e = (id >> 6) & 127, bh = id >> 13, b = bh >> 2, hh = bh & 3;
        float sv = 0.f;
        for (int n = 0; n < 128; n += 8) {
            float kv[8], dc[8];
#pragma unroll
            for (int q = 0; q < 8; ++q) { const size_t ch = (size_t)((b * 128 + n + q) * 4 + hh); kv[q] = KVT[(ch * 128 + e) * 64 + d]; dc[q] = DEC[ch * 64 + d]; }
#pragma unroll
            for (int q = 0; q < 8; ++q) { const size_t ch = (size_t)((b * 128 + n + q) * 4 + hh); ST[(ch * 128 + e) * 64 + d] = (bf16_t)f2bf(sv); sv = dc[q] * sv + kv[q]; }
        }
    } else if (bx < 130) {
        const int id = (bx - 128) * 512 + F.tid, b = id >> 9, ch = id & 511;
        float h = 0.f;
        for (int n = 0; n < 128; n += 8) {
            float av[8], hv[8];
#pragma unroll
            for (int q = 0; q < 8; ++q) { const size_t o = (size_t)(b * 128 + n + q) * RGW + ch; av[q] = RGSA[o]; hv[q] = RGSH[o]; }
#pragma unroll
            for (int q = 0; q < 8; ++q) { const size_t o = (size_t)(b * 128 + n + q) * RGW + ch; RGC[o] = h; h = av[q] * h + hv[q]; }
        }
    }
}

__device__ __forceinline__ void p6_router(Frame& F, const Args& a) {
    const float* Hf = F.out; bf16_t* HN2 = (bf16_t*)(F.ws + WS_HN); const float* WRT = (const float*)(F.ws + WS_WRT);
    const float* gain = a.in[15]; const float* bg = a.in[17]; const float* be = a.in[19];
    int* STOK = (int*)(F.ws + WS_STOK); float* SW = (float*)(F.ws + WS_SW); int* TIDX = (int*)(F.ws + WS_TIDX);
    unsigned* gcnt = F.ctl + CW_GCNT;
    LAS int* lcnt = (LAS int*)F.lds; LAS int* lbase = lcnt + 32; LAS int* rec_e = lbase + 32; LAS int* rec_l = rec_e + 128; LAS float* rec_w = (LAS float*)(rec_l + 128);
    for (int grp = blockIdx.x; grp < NTOK / 64; grp += F.G) {
        if (F.tid < 32) lcnt[F.tid] = 0;
        __syncthreads();
        for (int j = 0; j < 8; ++j) {
            const int tl = F.wave * 8 + j, t = grp * 64 + tl;
            const f32x4* xr = (const f32x4*)(Hf + (size_t)t * DM) + F.lane; const f32x4* gr = (const f32x4*)gain + F.lane;
            f32x4 v[4]; float s = 0.f;
#pragma unroll
            for (int q = 0; q < 4; ++q) { v[q] = xr[64 * q]; s += (v[q].x * v[q].x + v[q].y * v[q].y) + (v[q].z * v[q].z + v[q].w * v[q].w); }
            const float rs = 1.f / sqrtf(wave_sum(s) * (1.f / DM) + EPS);
            unsigned long long* o8 = (unsigned long long*)(HN2 + (size_t)t * DM) + F.lane;
#pragma unroll
            for (int q = 0; q < 4; ++q) { const f32x4 g = gr[64 * q]; v[q] = v[q] * rs * g; o8[64 * q] = (unsigned long long)pk2(v[q].x, v[q].y) | ((unsigned long long)pk2(v[q].z, v[q].w) << 32); }
            LAS float* llg = (LAS float*)(F.lds + 4096) + F.wave * 64;
#pragma unroll 1
            for (int ob = 0; ob < 36; ob += 4) {
                float p4[4];
#pragma unroll
                for (int oo = 0; oo < 4; ++oo) { const f32x4* wr = (const f32x4*)(WRT + (ob + oo) * DM) + F.lane; float p = 0.f;
#pragma unroll
                    for (int q = 0; q < 4; ++q) { const f32x4 w = wr[64 * q]; p += (v[q].x * w.x + v[q].y * w.y) + (v[q].z * w.z + v[q].w * w.w); }
                    p4[oo] = wave_sum(p); }
                if (F.lane == 0) { llg[ob] = p4[0]; llg[ob + 1] = p4[1]; llg[ob + 2] = p4[2]; llg[ob + 3] = p4[3]; }
            }
            asm volatile("s_waitcnt lgkmcnt(0)" ::: "memory");
            float lg[36];
#pragma unroll
            for (int o = 0; o < 36; ++o) lg[o] = llg[o];
            float gl[4];
#pragma unroll
            for (int q = 0; q < 4; ++q) gl[q] = lg[q] + bg[q];
            int gi = 0; float gm = gl[0];
#pragma unroll
            for (int q = 1; q < 4; ++q) if (gl[q] > gm) { gm = gl[q]; gi = q; }
            float gs = 0.f;
#pragma unroll
            for (int q = 0; q < 4; ++q) gs += expf(gl[q] - gm);
            const float gw = 1.f / gs;
            float le[8];
#pragma unroll
            for (int q = 0; q < 8; ++q) { float x = lg[4 + q] + be[q];
#pragma unroll
                for (int g2 = 1; g2 < 4; ++g2) x = (gi == g2) ? (lg[4 + g2 * 8 + q] + be[g2 * 8 + q]) : x;
                le[q] = x; }
            int i1 = 0; float m1 = le[0];
#pragma unroll
            for (int q = 1; q < 8; ++q) if (le[q] > m1) { m1 = le[q]; i1 = q; }
            int i2 = -1; float m2 = -3.0e38f;
#pragma unroll
            for (int q = 0; q < 8; ++q) if (q != i1 && le[q] > m2) { m2 = le[q]; i2 = q; }
            const float e2 = expf(m2 - m1), inv = 1.f / (1.f + e2);
            const float w1 = gw * inv, w2 = gw * e2 * inv;
            if (F.lane == 0) {
                const int ea = gi * 8 + i1, eb = gi * 8 + i2;
                const int la_ = __hip_atomic_fetch_add(lcnt + ea, 1, __ATOMIC_RELAXED, __HIP_MEMORY_SCOPE_WORKGROUP), lb_ = __hip_atomic_fetch_add(lcnt + eb, 1, __ATOMIC_RELAXED, __HIP_MEMORY_SCOPE_WORKGROUP);
                rec_e[tl * 2] = ea; rec_l[tl * 2] = la_; rec_w[tl * 2] = w1; rec_e[tl * 2 + 1] = eb; rec_l[tl * 2 + 1] = lb_; rec_w[tl * 2 + 1] = w2;
            }
        }
        __syncthreads();
        if (F.tid < 32) { const int cnum = lcnt[F.tid]; lbase[F.tid] = cnum ? (int)__hip_atomic_fetch_add(gcnt + F.tid, (unsigned)cnum, __ATOMIC_RELAXED, __HIP_MEMORY_SCOPE_AGENT) : 0; }
        __syncthreads();
        if (F.tid < 128) { const int e = rec_e[F.tid], idx = e * CAP + lbase[e] + rec_l[F.tid], t = grp * 64 + (F.tid >> 1);
            STOK[idx] = t; SW[idx] = rec_w[F.tid]; TIDX[t * 2 + (F.tid & 1)] = idx; }
        __syncthreads();
    }
}

__device__ __forceinline__ int moe_setup(Frame& F, int ncol_log2, bool tables) {
    const unsigned* gcnt = F.ctl + CW_GCNT;
    LAS int* lcnt = (LAS int*)(F.lds + L_CNT); LAS int* tst = (LAS int*)(F.lds + L_TST); LAS int* utab = (LAS int*)(F.lds + L_UTAB);
    LAS unsigned* rowt = (LAS unsigned*)(F.lds + L_ROWT); LAS float* wt = (LAS float*)(F.lds + L_WT);
    const int* STOK = (const int*)(F.ws + WS_STOK); const float* SW = (const float*)(F.ws + WS_SW);
    if (F.tid < 32) lcnt[F.tid] = (int)__hip_atomic_load(gcnt + F.tid, __ATOMIC_RELAXED, __HIP_MEMORY_SCOPE_AGENT);
    __syncthreads();
    if (F.tid == 0) { int s = 0; for (int e = 0; e < 32; ++e) { tst[e] = s; s += (lcnt[e] + 255) >> 8; } tst[32] = s; }
    __syncthreads();
    if (!tables) return 0;
    const int total = tst[32] << ncol_log2; int nu = 0;
    for (int ui = 0; ui < 5; ++ui) {
        const int L = ui * F.G + F.vcu; if (L >= total) break;
        const int rb = L >> ncol_log2, pn = L & ((1 << ncol_log2) - 1);
        int e = 0;
        for (int j = 1; j < 32; ++j) e += (tst[j] <= rb) ? 1 : 0;
        const int r0 = (rb - tst[e]) * 256; int rows = lcnt[e] - r0; rows = rows > 256 ? 256 : rows;
        if (F.tid < 256) { const bool ok = F.tid < rows; const int idx = e * CAP + r0 + F.tid;
            rowt[ui * 256 + F.tid] = ok ? (unsigned)STOK[idx] * (unsigned)(DM * 2) : 0u; wt[ui * 256 + F.tid] = ok ? SW[idx] : 0.f; }
        if (F.tid == 0) { utab[ui * 4 + 0] = rb; utab[ui * 4 + 1] = pn; utab[ui * 4 + 2] = e; utab[ui * 4 + 3] = rows; }
        ++nu;
    }
    __syncthreads();
    return nu;
}

__device__ __forceinline__ void p9_final(Frame& F, const Args& a) {
    const LAS int* tst = (const LAS int*)(F.lds + L_TST);
    const int* TIDX = (const int*)(F.ws + WS_TIDX); const bf16_t* YB = (const bf16_t*)(F.ws + WS_YB); const float* gain = a.in[23];
    const int gw = F.vcu * NWAVES + F.wave, NGW = F.G * NWAVES;
    for (int t = gw; t < NTOK; t += NGW) {
        const int i1 = TIDX[t * 2], i2 = TIDX[t * 2 + 1];
        const size_t s1 = (size_t)tst[i1 >> 14] * 256 + (i1 & (CAP - 1)), s2 = (size_t)tst[i2 >> 14] * 256 + (i2 & (CAP - 1));
        f32x4* xr = (f32x4*)(F.out + (size_t)t * DM) + F.lane; const f32x4* gr = (const f32x4*)gain + F.lane;
        const u32x2* y1 = (const u32x2*)(YB + s1 * DM) + F.lane; const u32x2* y2 = (const u32x2*)(YB + s2 * DM) + F.lane;
        f32x4 v[4]; float s = 0.f;
#pragma unroll
        for (int q = 0; q < 4; ++q) { v[q] = xr[64 * q]; const u32x2 p = y1[64 * q], r = y2[64 * q];
            v[q].x += bf2f(p.x & 0xffffu) + bf2f(r.x & 0xffffu); v[q].y += bf2f(p.x >> 16) + bf2f(r.x >> 16); v[q].z += bf2f(p.y & 0xffffu) + bf2f(r.y & 0xffffu); v[q].w += bf2f(p.y >> 16) + bf2f(r.y >> 16);
            s += (v[q].x * v[q].x + v[q].y * v[q].y) + (v[q].z * v[q].z + v[q].w * v[q].w); }
        const float rs = 1.f / sqrtf(wave_sum(s) * (1.f / DM) + EPS);
#pragma unroll
        for (int q = 0; q < 4; ++q) { const f32x4 g = gr[64 * q]; xr[64 * q] = v[q] * rs * g; }
    }
}

__global__ void __launch_bounds__(NTHR, 2) fwd(Args args) {
    extern __shared__ __attribute__((aligned(16))) unsigned char lds_raw[];
    Frame F;
    F.lds = (LAS unsigned char*)lds_raw;
    F.tid = threadIdx.x; F.lane = F.tid & 63; F.wave = __builtin_amdgcn_readfirstlane(F.tid >> 6);
    F.G = gridDim.x; { const int bx = blockIdx.x; F.vcu = (F.G % 8 == 0) ? (bx % 8) * (F.G / 8) + bx / 8 : bx; }
    F.ws = args.ws; F.out = args.out; F.ctl = (unsigned*)(args.ws + WS_CTL);
    const int lo = args.ph_lo, hi = args.ph_hi;
    if (F.tid < 32) ((LAS unsigned*)(F.lds + L_MISC))[F.tid] = 0u;
    __syncthreads();
    XcdBarrier bar; bar.bar = F.ctl + CW_BAR; bar.x = 0; bar.st = nullptr;
    if (hi - lo > 1) bar = xcd_barrier_post(F.ctl + CW_BAR, (volatile LAS unsigned*)(F.lds + L_MISC) + 8);
#define SEAM(k) do { if (IN(k) && IN((k) + 1)) xcd_barrier(bar); } while (0)
#ifndef PHMASK
#define PHMASK 0x3ff
#endif
#define IN(k) (((PHMASK >> (k)) & 1) && lo <= (k) && (k) < hi)

    if (IN(0)) { p0_prologue(F, args); }
    SEAM(0);
    if (IN(1)) {
        pg8::StaticOrder S; S.init(NTOK, LDP, F.G, (int)blockIdx.x);
        pg8::EpiBf16 E{(bf16_t*)(F.ws + WS_PROJ), LDP};
        pg8::gemm_phase<pg8::EpiBf16, pg8::StaticOrder, true, false>(F.lds, (const bf16_t*)(F.ws + WS_HN), (const bf16_t*)(F.ws + WS_WIN), DM, S, E);
    }
    SEAM(1);
    if (IN(2)) { for (int ck = blockIdx.x; ck < NTOK / 64; ck += F.G) mixer_chunk<false>(F, args, ck); }
    SEAM(2);
    if (IN(3)) { m3_scan(F); }
    SEAM(3);
    if (IN(4)) { for (int ck = blockIdx.x; ck < NTOK / 64; ck += F.G) mixer_chunk<true>(F, args, ck); }
    SEAM(4);
    if (IN(5)) {
        pg8::StaticOrder S; S.init(NTOK, DM, F.G, (int)blockIdx.x);
        pg8::EpiResF32 E{args.in[0], F.out, DM};
        pg8::gemm_phase<pg8::EpiResF32, pg8::StaticOrder, false, false>(F.lds, (const bf16_t*)(F.ws + WS_HN), (const bf16_t*)(F.ws + WS_WOUT), DM, S, E);
    }
    SEAM(5);
    if (IN(6)) { p6_router(F, args); }
    SEAM(6);
    if (IN(7)) {
        const int nu = moe_setup(F, 3, true);
        pg8::MoeOrder S{(const LAS int*)(F.lds + L_UTAB), (const LAS unsigned*)(F.lds + L_ROWT), nu, 8};
        pg8::EpiGeglu E{(bf16_t*)(F.ws + WS_H)};
        pg8::gemm_phase<pg8::EpiGeglu, pg8::MoeOrder, true, true>(F.lds, (const bf16_t*)(F.ws + WS_HN), (const bf16_t*)(F.ws + WS_WGU), DM, S, E);
    }
    SEAM(7);
    if (IN(8)) {
        const int nu = moe_setup(F, 2, true);
        pg8::MoeOrder S{(const LAS int*)(F.lds + L_UTAB), (const LAS unsigned*)(F.lds + L_ROWT), nu, 4};
        pg8::EpiScaleBf16 E{(bf16_t*)(F.ws + WS_YB)};
        pg8::gemm_phase<pg8::EpiScaleBf16, pg8::MoeOrder, true, false>(F.lds, (const bf16_t*)(F.ws + WS_H), (const bf16_t*)(F.ws + WS_WD), DM, S, E);
    }
    SEAM(8);
    if (IN(9)) { moe_setup(F, 0, false); p9_final(F, args); }
#undef IN
#undef SEAM
}

extern "C" void kernel_launch(void* const* d_in, const int* in_sizes, int n_in, void* d_out, int out_size, void* d_ws, size_t ws_size, hipStream_t stream) {
    static int grid = 0;
    if (grid == 0) {
        if (n_in != 24 || out_size != NTOK * DM || ws_size < WS_END) { fprintf(stderr, "kernel_launch: unexpected shapes (n_in %d, out %d, ws %zu); nothing launched\n", n_in, out_size, ws_size); grid = -1; return; }
        int dev = 0, cus = 0;
        if (hipGetDevice(&dev) != hipSuccess || hipDeviceGetAttribute(&cus, hipDeviceAttributeMultiprocessorCount, dev) != hipSuccess) { grid = -1; return; }
        if (hipFuncSetAttribute((const void*)fwd, hipFuncAttributeMaxDynamicSharedMemorySize, LDS_BYTES) != hipSuccess) { fprintf(stderr, "kernel_launch: hipFuncSetAttribute failed\n"); grid = -1; return; }
        (void)hipGetLastError();
        grid = cus;
    }
    if (grid < 0) return;
    (void)hipMemsetAsync((char*)d_ws + WS_CTL, 0, CTL_ZERO_BYTES, stream);
    Args a{};
    for (int i = 0; i < 24; ++i) a.in[i] = (const float*)d_in[i];
    a.out = (float*)d_out; a.ws = (unsigned char*)d_ws;
#ifndef N_LAUNCHES
#define N_LAUNCHES 1
#endif
    if (N_LAUNCHES == 1) { a.ph_lo = 0; a.ph_hi = NPHASE; hipLaunchKernelGGL(fwd, dim3(grid), dim3(NTHR), LDS_BYTES, stream, a); }
    else for (int p = 0; p < NPHASE; ++p) { a.ph_lo = p; a.ph_hi = p + 1; hipLaunchKernelGGL(fwd, dim3(grid), dim3(NTHR), LDS_BYTES, stream, a); }
}
```

```cpp
#include <hip/hip_runtime.h>
#include <cstdio>
#include <cstdint>

#define LAS __attribute__((address_space(3)))
#define GAS __attribute__((address_space(1)))
typedef unsigned short bf16_t;
typedef short bf16x8 __attribute__((ext_vector_type(8)));
typedef float f32x4 __attribute__((ext_vector_type(4)));
typedef float f32x2 __attribute__((ext_vector_type(2)));
typedef unsigned u32x4 __attribute__((ext_vector_type(4)));
typedef unsigned u32x2 __attribute__((ext_vector_type(2)));
typedef int v4i __attribute__((ext_vector_type(4)));
typedef int v8i __attribute__((ext_vector_type(8)));

constexpr int NTOK = 16384, SEQ = 8192, DM = 1024;
constexpr int RGW = 512, NPROJ = 2576, LDP = 2816;
constexpr int C_XR = 0, C_YR = 512, C_Q = 1024, C_K = 1280, C_V = 1536, C_G = 2048, C_AL = 2560;
constexpr int NEXP = 32, CAP = 16384;
constexpr float EPS = 1e-6f;
constexpr int NWAVES = 8, NTHR = 512;
constexpr int NPHASE = 10;
constexpr unsigned REP_MASK = 0x000;

constexpr size_t MiB = 1u << 20;
constexpr size_t WS_CTL = 0, CTL_ZERO_BYTES = 1 * MiB;
constexpr size_t WS_WRT = 1 * MiB;
constexpr size_t WS_RS = 1 * MiB + 512 * 1024;
constexpr size_t WS_WIN = 2 * MiB;
constexpr size_t WS_WOUT = 8 * MiB;
constexpr size_t WS_WGU = 16 * MiB;
constexpr size_t WS_WD = 80 * MiB;
constexpr float WSCALE = 32.f, WUNSCALE = 1.f / 32.f;
constexpr size_t WS_HN = 208 * MiB;
constexpr size_t WS_PROJ = 240 * MiB;
constexpr size_t WS_SMALL = 10 * MiB;
constexpr size_t WS_KVT = 328 * MiB;
constexpr size_t WS_ST = 360 * MiB;
constexpr size_t WS_DEC = 376 * MiB, WS_RGSA = 377 * MiB, WS_RGSH = 377 * MiB + 512 * 1024, WS_RGC = 378 * MiB;
constexpr size_t WS_H = 240 * MiB;
constexpr size_t WS_YB = 320 * MiB;
constexpr size_t WS_STOK = 480 * MiB, WS_SW = 482 * MiB, WS_TIDX = 484 * MiB;
constexpr size_t WS_END = 512 * MiB;
constexpr int CW_BAR = 4096;
constexpr int CW_GCNT = 8192;

constexpr int RING_BYTES = 131072;
constexpr int CTRL_BASE = 143360;
constexpr int L_MISC = CTRL_BASE;
constexpr int L_CNT = CTRL_BASE + 128;
constexpr int L_TST = CTRL_BASE + 256;
constexpr int L_UTAB = CTRL_BASE + 512;
constexpr int L_ROWT = CTRL_BASE + 1024;
constexpr int L_WT = CTRL_BASE + 6144;
constexpr int LDS_BYTES = 155648;
static_assert(L_WT + 5 * 1024 <= LDS_BYTES, "LDS map");

__device__ __forceinline__ unsigned f2bf(float f) { unsigned u = __builtin_bit_cast(unsigned, f); return (u + 0x7fffu + ((u >> 16) & 1u)) >> 16; }
__device__ __forceinline__ unsigned pk2(float lo, float hi) { return f2bf(lo) | (f2bf(hi) << 16); }
__device__ __forceinline__ unsigned pk4_fp8(float a, float b, float c, float d) { int w = 0; w = __builtin_amdgcn_cvt_pk_fp8_f32(a, b, w, false); w = __builtin_amdgcn_cvt_pk_fp8_f32(c, d, w, true); return (unsigned)w; }
__device__ __forceinline__ float bf2f(unsigned b) { return __builtin_bit_cast(float, b << 16); }
__device__ __forceinline__ float wave_sum(float v) {
#pragma unroll
    for (int o = 1; o < 64; o <<= 1) v += __shfl_xor(v, o);
    return v;
}
__device__ __forceinline__ float sigmoidf_(float x) { return 1.f / (1.f + __expf(-x)); }
__device__ __forceinline__ float gelu_tanh(float x) { const float z = 0.7978845608028654f * (x + 0.044715f * x * x * x); const float e = __expf(2.f * z); return 0.5f * x * (2.f - 2.f / (e + 1.f)); }

namespace pg8 {
constexpr int BM = 256, BK = 64, HALF = 128, HTB = HALF * BK * 2, NXCD = 8, WGM = 8;
__host__ __device__ __forceinline__ int lds_byte(int r, int c) { const int st = (r >> 4) * 2 + (c >> 5), rr = r & 15, cc = c & 31, ob = rr * 64 + cc * 2; return st * 1024 + (ob ^ (((ob >> 9) & 1) << 5)); }
__host__ __device__ __forceinline__ void stage_rc(int b, int& R, int& C) { const int st = b / 1024, sb = b % 1024, swz = sb ^ (((sb >> 9) & 1) << 5); R = (st >> 1) * 16 + swz / 64; C = (st & 1) * 32 + (swz % 64) / 2; }
__host__ __device__ __forceinline__ int perm32(int rho) { const int n = rho >> 4, i = rho & 15; return 8 * (i >> 2) + 4 * n + (i & 3); }

struct Unit { int pm, pn, bt, ui, e, rows; };

struct StaticOrder {
    int nM, nN, nwg, G, c;
    __device__ void init(int M, int N, int G_, int c_) { nM = M / BM; nN = N / BM; nwg = nM * nN; G = G_; c = c_; }
    __device__ bool next(int i, Unit& u) const {
        const long L = (long)i * G + c; if (L >= nwg) return false;
        int wgid = (int)L; { const int q = nwg / NXCD, r = nwg % NXCD, xcd = wgid % NXCD, off = wgid / NXCD; wgid = (xcd < r ? xcd * (q + 1) : r * (q + 1) + (xcd - r) * q) + off; }
        const int nig = WGM * nN, gid = wgid / nig, fm = gid * WGM, gsz = (nM - fm) < WGM ? (nM - fm) : WGM;
        u.pm = fm + ((wgid % nig) % gsz); u.pn = (wgid % nig) / gsz; u.bt = u.pn; u.ui = i; u.e = 0; u.rows = 256; return true;
    }
    __device__ __forceinline__ unsigned row_byte(const Unit&, int) const { return 0u; }
};

struct MoeOrder {
    const LAS int* utab; const LAS unsigned* rowt; int nu, ncol;
    __device__ bool next(int i, Unit& u) const {
        if (i >= nu) return false;
        u.pm = __builtin_amdgcn_readfirstlane(utab[i * 4 + 0]); u.pn = __builtin_amdgcn_readfirstlane(utab[i * 4 + 1]); u.e = __builtin_amdgcn_readfirstlane(utab[i * 4 + 2]); u.rows = __builtin_amdgcn_readfirstlane(utab[i * 4 + 3]); u.ui = i; u.bt = u.e * ncol + u.pn; return true;
    }
    __device__ __forceinline__ unsigned row_byte(const Unit& u, int r) const { return rowt[u.ui * 256 + r]; }
};

__device__ __forceinline__ unsigned cvt_pk_bf16(float lo, float hi) { unsigned r; asm volatile("v_cvt_pk_bf16_f32 %0, %1, %2" : "=v"(r) : "v"(lo), "v"(hi)); return r; }

struct EpiBf16 {
    static constexpr bool PERM = true;
    bf16_t* O; int ldc;
    __device__ __forceinline__ void operator()(const f32x4 (&acc)[2][2][4][2], const Unit& u, int wr, int wc, int fr, int fq, const LAS unsigned char*) const {
        const int row0 = u.pm * BM + wr * 64 + fr, col0 = u.pn * BM + wc * 32 + 8 * fq;
#pragma unroll
        for (int ai = 0; ai < 2; ++ai)
#pragma unroll
            for (int m = 0; m < 4; ++m) { bf16_t* rowp = O + (size_t)(row0 + ai * HALF + m * 16) * ldc + col0;
#pragma unroll
                for (int bj = 0; bj < 2; ++bj) { const f32x4 v0 = acc[ai][bj][m][0], v1 = acc[ai][bj][m][1];
                    u32x4 w; w.x = cvt_pk_bf16(v0[0], v0[1]); w.y = cvt_pk_bf16(v0[2], v0[3]); w.z = cvt_pk_bf16(v1[0], v1[1]); w.w = cvt_pk_bf16(v1[2], v1[3]);
                    *(u32x4*)(rowp + bj * HALF) = w; } }
    }
};
struct EpiResF32 {
    static constexpr bool PERM = false;
    const float* base; float* out; int ldc;
    __device__ __forceinline__ void operator()(const f32x4 (&acc)[2][2][4][2], const Unit& u, int wr, int wc, int fr, int fq, const LAS unsigned char*) const {
        const int col0 = u.pn * BM + wc * 32 + 4 * fq;
#pragma unroll
        for (int ai = 0; ai < 2; ++ai)
#pragma unroll
            for (int m = 0; m < 4; ++m) { const size_t off = (size_t)(u.pm * BM + ai * HALF + wr * 64 + m * 16 + fr) * ldc + col0;
#pragma unroll
                for (int bj = 0; bj < 2; ++bj)
#pragma unroll
                    for (int n = 0; n < 2; ++n) { const f32x4 bs = *(const f32x4*)(base + off + bj * HALF + n * 16); *(f32x4*)(out + off + bj * HALF + n * 16) = bs + acc[ai][bj][m][n]; } }
    }
};
struct EpiGeglu {
    static constexpr bool PERM = true;
    unsigned char* H;
    __device__ __forceinline__ void operator()(const f32x4 (&acc)[2][2][4][2], const Unit& u, int wr, int wc, int fr, int fq, const LAS unsigned char* lds) const {
        const int col0 = u.pn * HALF + wc * 32 + 8 * fq; const LAS float* wt = (const LAS float*)(lds + L_WT) + u.ui * 256;
#pragma unroll
        for (int ai = 0; ai < 2; ++ai)
#pragma unroll
            for (int m = 0; m < 4; ++m) { const int r = ai * HALF + wr * 64 + m * 16 + fr;
                if (r < u.rows) { const float s = wt[r] * WUNSCALE;
                    const f32x4 g0 = acc[ai][0][m][0] * s, g1 = acc[ai][0][m][1] * s, u0 = acc[ai][1][m][0] * s, u1 = acc[ai][1][m][1] * s;
                    u32x2 w;
                    w.x = pk4_fp8(gelu_tanh(g0[0]) * u0[0], gelu_tanh(g0[1]) * u0[1], gelu_tanh(g0[2]) * u0[2], gelu_tanh(g0[3]) * u0[3]);
                    w.y = pk4_fp8(gelu_tanh(g1[0]) * u1[0], gelu_tanh(g1[1]) * u1[1], gelu_tanh(g1[2]) * u1[2], gelu_tanh(g1[3]) * u1[3]);
                    *(u32x2*)(H + (size_t)(u.pm * BM + r) * 1024 + col0) = w; } }
    }
};
struct EpiScaleBf16 {
    static constexpr bool PERM = true;
    bf16_t* Y;
    __device__ __forceinline__ void operator()(const f32x4 (&acc)[2][2][4][2], const Unit& u, int wr, int wc, int fr, int fq, const LAS unsigned char* lds) const {
        const int col0 = u.pn * BM + wc * 32 + 8 * fq; const LAS float* wt = (const LAS float*)(lds + L_WT) + u.ui * 256;
#pragma unroll
        for (int ai = 0; ai < 2; ++ai)
#pragma unroll
            for (int m = 0; m < 4; ++m) { const int r = ai * HALF + wr * 64 + m * 16 + fr;
                if (r < u.rows) { const float s = wt[r] * WUNSCALE; bf16_t* rowp = Y + (size_t)(u.pm * BM + r) * 1024 + col0;
#pragma unroll
                    for (int bj = 0; bj < 2; ++bj) { const f32x4 v0 = acc[ai][bj][m][0] * s, v1 = acc[ai][bj][m][1] * s;
                        u32x4 w; w.x = cvt_pk_bf16(v0[0], v0[1]); w.y = cvt_pk_bf16(v0[2], v0[3]); w.z = cvt_pk_bf16(v1[0], v1[1]); w.w = cvt_pk_bf16(v1[2], v1[3]);
                        *(u32x4*)(rowp + bj * HALF) = w; } } }
    }
};

template <class Epi, class Sched, bool ALIGN_EPI, bool GATHER, bool FP8>
__device__ __forceinline__ void gemm_phase(LAS unsigned char* lds, const bf16_t* Ab, const bf16_t* Bb, const int K, const Sched& S, const Epi& E) {
    const int tid = threadIdx.x, wid = __builtin_amdgcn_readfirstlane(tid >> 6), lane = tid & 63, wr = wid >> 2, wc = wid & 3, fr = lane & 15, fq = lane >> 4;
    const int nt = K / BK;
    int Rr[2], Cc[2]; unsigned voffB[2];
#pragma unroll
    for (int i = 0; i < 2; ++i) { int R, C; stage_rc(tid * 16 + i * 8192, R, C); Rr[i] = R; Cc[i] = C; const int Rb = Epi::PERM ? ((R & ~31) + perm32(R & 31)) : R; voffB[i] = (unsigned)(Rb * K + C) * 2u; }
    const size_t kstep = (size_t)(BK * 2);
    const size_t hstep = (size_t)HALF * K * 2;
    const size_t tstep = 2 * hstep;
    const unsigned ldsw = (unsigned)wid * 1024u;
    const int aoff = lds_byte(wr * 64 + fr, fq * 8), boff = lds_byte(wc * 32 + fr, fq * 8);
#define PG8_SA(b, h) (((b) * 2 + (h)) * HTB)
#define PG8_SB(b, h) ((4 + (b) * 2 + (h)) * HTB)
#define PG8_STAGE2(bufoff, gbase, o0, o1) do { unsigned _o0 = (o0), _o1 = (o1); asm volatile("" : "+v"(_o0), "+v"(_o1));     \
        __builtin_amdgcn_global_load_lds((const unsigned*)((const char*)(gbase) + _o0), (LAS unsigned*)(lds + (bufoff) + ldsw), 16, 0, 0); \
        __builtin_amdgcn_global_load_lds((const unsigned*)((const char*)(gbase) + _o1), (LAS unsigned*)(lds + (bufoff) + ldsw + 8192), 16, 0, 0); } while (0)
#define PG8_STAGEB(bufoff, gbase) PG8_STAGE2(bufoff, gbase, voffB[0], voffB[1])
#define PG8_AH(p) (GATHER ? (p) : (p) + hstep)
#define PG8_V1(i) (GATHER ? vC[1][i] : vC[0][i])
#define PG8_LD8(p) __builtin_shufflevector(*(const LAS v4i*)(p), *(const LAS v4i*)((p) + 1024), 0, 1, 2, 3, 4, 5, 6, 7)
#define PG8_LDA(dst, b, h) do { _Pragma("unroll") for (int m = 0; m < 4; ++m) dst[m] = PG8_LD8(lds + PG8_SA(b, h) + aoff + m * 2048); } while (0)
#define PG8_LDB(dst, b, h) do { _Pragma("unroll") for (int n = 0; n < 2; ++n) dst[n] = PG8_LD8(lds + PG8_SB(b, h) + boff + n * 2048); } while (0)
#define PG8_LO(x) __builtin_bit_cast(bf16x8, __builtin_shufflevector(x, x, 0, 1, 2, 3))
#define PG8_HI(x) __builtin_bit_cast(bf16x8, __builtin_shufflevector(x, x, 4, 5, 6, 7))
#define PG8_MMA(ai, bj, At, Bt) do { __builtin_amdgcn_s_setprio(1); _Pragma("unroll") for (int m = 0; m < 4; ++m) _Pragma("unroll") for (int n = 0; n < 2; ++n) { \
        if constexpr (FP8) acc[ai][bj][m][n] = __builtin_amdgcn_mfma_scale_f32_16x16x128_f8f6f4(Bt[n], At[m], acc[ai][bj][m][n], 0, 0, 0, 0x7f7f7f7f, 0, 0x7f7f7f7f); \
        else { acc[ai][bj][m][n] = __builtin_amdgcn_mfma_f32_16x16x32_bf16(PG8_LO(Bt[n]), PG8_LO(At[m]), acc[ai][bj][m][n], 0, 0, 0); \
               acc[ai][bj][m][n] = __builtin_amdgcn_mfma_f32_16x16x32_bf16(PG8_HI(Bt[n]), PG8_HI(At[m]), acc[ai][bj][m][n], 0, 0, 0); } } __builtin_amdgcn_s_setprio(0); } while (0)
#define PG8_WAIT_V(n) asm volatile("s_waitcnt vmcnt(" #n ")" ::: "memory")
#define PG8_WAIT_L(n) asm volatile("s_waitcnt lgkmcnt(" #n ")" ::: "memory")
#define PG8_BAR __builtin_amdgcn_s_barrier()
#define PG8_SCHED __builtin_amdgcn_sched_barrier(0)
    Unit cur, nxt; int ui = 0;
    if (!S.next(0, cur)) return;
    f32x4 acc[2][2][4][2];
#pragma unroll
    for (int a = 0; a < 2; ++a)
#pragma unroll
        for (int b = 0; b < 2; ++b)
#pragma unroll
            for (int m = 0; m < 4; ++m)
#pragma unroll
                for (int n = 0; n < 2; ++n) acc[a][b][m][n] = (f32x4){0.f, 0.f, 0.f, 0.f};
    v8i At[4], B0[2], B1[2];
    unsigned vC[2][2];
#pragma unroll
    for (int h = 0; h < 2; ++h)
#pragma unroll
        for (int i = 0; i < 2; ++i) vC[h][i] = GATHER ? (S.row_byte(cur, h * HALF + Rr[i]) + (unsigned)Cc[i] * 2u) : (unsigned)(Rr[i] * K + Cc[i]) * 2u;
    const char* cA = GATHER ? (const char*)Ab : (const char*)Ab + (size_t)cur.pm * tstep; const char* cB = (const char*)Bb + (size_t)cur.bt * tstep;
    PG8_STAGEB(PG8_SB(0, 0), cB); PG8_STAGEB(PG8_SB(0, 1), cB + hstep); PG8_STAGE2(PG8_SA(0, 0), cA, vC[0][0], vC[0][1]); PG8_STAGE2(PG8_SA(0, 1), PG8_AH(cA), PG8_V1(0), PG8_V1(1));
    if (wr == 1) PG8_BAR;
    PG8_WAIT_V(2); PG8_BAR;
    PG8_STAGEB(PG8_SB(1, 0), cB + kstep); PG8_STAGE2(PG8_SA(1, 0), cA + kstep, vC[0][0], vC[0][1]); PG8_STAGEB(PG8_SB(1, 1), cB + hstep + kstep);
    PG8_WAIT_V(6); PG8_BAR;
    for (;;) {
        const bool has_next = S.next(ui + 1, nxt);
        const char* nA = has_next ? (GATHER ? (const char*)Ab : (const char*)Ab + (size_t)nxt.pm * tstep) : cA; const char* nB = has_next ? (const char*)Bb + (size_t)nxt.bt * tstep : cB;
#pragma unroll 1
        for (int t = 0; t < nt; t += 2) {
            const bool last = (t == nt - 2);
            const char* a1 = cA + (size_t)(t + 1) * kstep;
            const char* a2 = last ? nA : cA + (size_t)(t + 2) * kstep; const char* b2 = last ? nB : cB + (size_t)(t + 2) * kstep;
            const char* a3 = a2 + kstep; const char* b3 = b2 + kstep;
            PG8_LDB(B0, 0, 0); PG8_LDB(B1, 0, 1); PG8_SCHED; PG8_LDA(At, 0, 0); PG8_STAGE2(PG8_SA(1, 1), PG8_AH(a1), PG8_V1(0), PG8_V1(1));
            if constexpr (GATHER) {
                if (last && has_next) {
                    int ln_ = (int)__builtin_amdgcn_mbcnt_hi(~0u, __builtin_amdgcn_mbcnt_lo(~0u, 0u)); asm volatile("" : "+v"(ln_));
#pragma unroll
                    for (int i = 0; i < 2; ++i) { int R, C; stage_rc((wid * 64 + ln_) * 16 + i * 8192, R, C);
#pragma unroll
                        for (int h = 0; h < 2; ++h) vC[h][i] = S.row_byte(nxt, h * HALF + R) + (unsigned)C * 2u; }
                }
            }
            const unsigned w00 = vC[0][0], w01 = vC[0][1], w10 = PG8_V1(0), w11 = PG8_V1(1);
            PG8_WAIT_V(8); PG8_WAIT_L(0); PG8_BAR; PG8_MMA(0, 0, At, B0); PG8_MMA(0, 1, At, B1); PG8_BAR; PG8_SCHED;
            PG8_LDA(At, 0, 1); PG8_STAGEB(PG8_SB(0, 0), b2); PG8_STAGEB(PG8_SB(0, 1), b2 + hstep); PG8_STAGE2(PG8_SA(0, 0), a2, w00, w01);
            PG8_WAIT_V(8); PG8_WAIT_L(0); PG8_BAR; PG8_MMA(1, 0, At, B0); PG8_MMA(1, 1, At, B1); PG8_BAR; PG8_SCHED;
            PG8_LDB(B0, 1, 0); PG8_LDB(B1, 1, 1); PG8_SCHED; PG8_LDA(At, 1, 0); PG8_STAGE2(PG8_SA(0, 1), PG8_AH(a2), w10, w11);
            PG8_WAIT_V(8); PG8_WAIT_L(0); PG8_BAR; PG8_MMA(0, 0, At, B0); PG8_MMA(0, 1, At, B1); PG8_BAR; PG8_SCHED;
            PG8_LDA(At, 1, 1); PG8_STAGEB(PG8_SB(1, 0), b3); PG8_STAGEB(PG8_SB(1, 1), b3 + hstep); PG8_STAGE2(PG8_SA(1, 0), a3, w00, w01);
            PG8_WAIT_V(8); PG8_WAIT_L(0); PG8_BAR; PG8_MMA(1, 0, At, B0); PG8_MMA(1, 1, At, B1); PG8_BAR; PG8_SCHED;
        }
        if constexpr (ALIGN_EPI) { if (wr == 0) PG8_BAR; }
        { int ln_ = (int)__builtin_amdgcn_mbcnt_hi(~0u, __builtin_amdgcn_mbcnt_lo(~0u, 0u)); asm volatile("" : "+v"(ln_));
          E(acc, cur, wr, wc, ln_ & 15, ln_ >> 4, lds); }
        if (!has_next) break;
#pragma unroll
        for (int a = 0; a < 2; ++a)
#pragma unroll
            for (int b = 0; b < 2; ++b)
#pragma unroll
                for (int m = 0; m < 4; ++m)
#pragma unroll
                    for (int n = 0; n < 2; ++n) acc[a][b][m][n] = (f32x4){0.f, 0.f, 0.f, 0.f};
        cur = nxt; cA = nA; cB = nB; ++ui;
        if constexpr (ALIGN_EPI) { if (wr == 1) PG8_BAR; }
    }
    PG8_WAIT_V(0);
    if constexpr (!ALIGN_EPI) { if (wr == 0) PG8_BAR; }
    PG8_BAR;
#undef PG8_SA
#undef PG8_SB
#undef PG8_STAGE2
#undef PG8_STAGEB
#undef PG8_AH
#undef PG8_V1
#undef PG8_LDA
#undef PG8_LDB
#undef PG8_MMA
#undef PG8_LD8
#undef PG8_LO
#undef PG8_HI
#undef PG8_WAIT_V
#undef PG8_WAIT_L
#undef PG8_BAR
#undef PG8_SCHED
}
}


#define XB_TMO      128
#define XB_XCNT(j)  (256  + 64 * (j))
#define XB_XSUB(j)  (1280 + 64 * (j))
#define XB_XGEN(j)  (2304 + 64 * (j))
#define XB_TOP      3328
#define XB_TOPGEN   3392
#define XCD_BAR_WORDS 3456
#define XB_SPIN_CAP (1u << 18)

__device__ __forceinline__ unsigned xb_ld(unsigned* p)              { return __hip_atomic_load(p, __ATOMIC_RELAXED, __HIP_MEMORY_SCOPE_AGENT); }
__device__ __forceinline__ unsigned xb_add(unsigned* p, unsigned v) { return __hip_atomic_fetch_add(p, v, __ATOMIC_RELAXED, __HIP_MEMORY_SCOPE_AGENT); }
__device__ __forceinline__ unsigned xb_xcc_id() { return (unsigned)__builtin_amdgcn_s_getreg((3 << 11) | 20) & 0xFu; }
#define XB_SPIN(cond, bar) do { unsigned _sp = 0; while (cond) { __builtin_amdgcn_s_sleep(1); \
    if ((++_sp & 255u) == 0u) { if (xb_ld(&(bar)[XB_TMO])) break; if (_sp > XB_SPIN_CAP) { atomicAdd(&(bar)[XB_TMO], 1u); break; } } } } while (0)

struct XcdBarrier {
    unsigned* bar; unsigned x;
    volatile LAS unsigned* st;
};
__device__ __forceinline__ XcdBarrier xcd_barrier_post(unsigned* bar, volatile LAS unsigned* st) {
    XcdBarrier b; b.bar = bar; b.x = xb_xcc_id(); b.st = st;
    if (threadIdx.x == 0) (void)xb_add(&bar[XB_XCNT(b.x)], 1u);
    return b;
}
__device__ __forceinline__ void xcd_barrier_complete(unsigned* bar, unsigned x, unsigned& nloc, unsigned& nx) {
    const unsigned G = gridDim.x * gridDim.y * gridDim.z;
    unsigned sum, cnt, mine, sp = 0u;
    for (;;) {
        sum = 0u; cnt = 0u; mine = 0u;
#pragma unroll
        for (unsigned j = 0; j < 16; ++j) { const unsigned c = xb_ld(&bar[XB_XCNT(j)]); sum += c; cnt += (c > 0u) ? 1u : 0u; mine = (j == x) ? c : mine; }
        if (sum == G) break;
        __builtin_amdgcn_s_sleep(1);
        if ((++sp & 255u) == 0u) { if (xb_ld(&bar[XB_TMO])) break; if (sp > XB_SPIN_CAP) { atomicAdd(&bar[XB_TMO], 1u); break; } }
    }
    nloc = mine > 0u ? mine : 1u; nx = cnt > 0u ? cnt : 1u;
}
__device__ __forceinline__ void xcd_barrier(const XcdBarrier& b) {
    asm volatile("s_waitcnt vmcnt(0)" ::: "memory");
    __syncthreads();
    if (threadIdx.x == 0) {
        unsigned* bar = b.bar;
        __builtin_amdgcn_s_waitcnt(0);
        unsigned nloc = b.st[0], nx = b.st[1];
        if (nloc == 0u) { xcd_barrier_complete(bar, b.x, nloc, nx); b.st[0] = nloc; b.st[1] = nx; }
        const unsigned old = xb_add(&bar[XB_XSUB(b.x)], 1u);
        const unsigned gen = old / nloc;
        if (old + 1u == (gen + 1u) * nloc) {
            __builtin_amdgcn_fence(__ATOMIC_RELEASE, "agent");
            asm volatile("s_waitcnt vmcnt(0)" ::: "memory");
            const unsigned og = xb_add(&bar[XB_TOP], 1u);
            const unsigned tg = og / nx;
            if (og + 1u == (tg + 1u) * nx) xb_add(&bar[XB_TOPGEN], 1u);
            else XB_SPIN(xb_ld(&bar[XB_TOPGEN]) == tg, bar);
            __builtin_amdgcn_fence(__ATOMIC_ACQUIRE, "agent");
            xb_add(&bar[XB_XGEN(b.x)], 1u);
            asm volatile("s_waitcnt vmcnt(0)" ::: "memory");
        } else {
            XB_SPIN(xb_ld(&bar[XB_XGEN(b.x)]) == gen, bar);
            __builtin_amdgcn_fence(__ATOMIC_ACQUIRE, "agent");
            asm volatile("s_waitcnt vmcnt(0)" ::: "memory");
        }
    }
    __syncthreads();
}

struct Args { const float* in[24]; float* out; unsigned char* ws; int ph_lo, ph_hi; };

struct Frame {
    LAS unsigned char* lds;
    unsigned* ctl;
    int tid, lane, wave, vcu, G;
    unsigned char* ws; float* out;
};

struct TTile { const float* src; unsigned char* dst; int Nsrc, k0, n0, orow0, fp8; };
__device__ __forceinline__ TTile p0_tile(const Args& a, unsigned char* ws, int it) {
    constexpr int I_IN = 16 * 44, I_OUT = 16 * 16, I_E = 16 * 16;
    TTile t;
    if (it < I_IN) { const int kb = it / 44, nb = it % 44; t.fp8 = 0; t.src = a.in[2]; t.dst = ws + WS_WIN; t.Nsrc = NPROJ; t.k0 = 64 * kb; t.n0 = 64 * nb; t.orow0 = 64 * nb; return t; }
    it -= I_IN;
    if (it < I_OUT) { const int kb = it >> 4, nb = it & 15; t.fp8 = 0; t.src = a.in[14]; t.dst = ws + WS_WOUT; t.Nsrc = DM; t.k0 = 64 * kb; t.n0 = 64 * nb; t.orow0 = 64 * nb; return t; }
    it -= I_OUT;
    const int e = it / (3 * I_E), w = (it / I_E) % 3, q = it % I_E, kb = q >> 4, nb = q & 15, n0 = 64 * nb;
    t.Nsrc = DM; t.k0 = 64 * kb; t.n0 = n0; t.fp8 = 1;
    if (w == 0) { t.src = a.in[20] + (size_t)e * DM * DM; t.dst = ws + WS_WGU + (size_t)e * 2048 * DM; t.orow0 = (n0 >> 7) * 256 + (n0 & 127); }
    else if (w == 1) { t.src = a.in[21] + (size_t)e * DM * DM; t.dst = ws + WS_WGU + (size_t)e * 2048 * DM; t.orow0 = (n0 >> 7) * 256 + 128 + (n0 & 127); }
    else { t.src = a.in[22] + (size_t)e * DM * DM; t.dst = ws + WS_WD + (size_t)e * DM * DM; t.orow0 = n0; }
    return t;
}
__device__ __forceinline__ void p0_load(f32x4 (&v)[16], const TTile& t, int lane) {
    const int n = t.n0 + 4 * (lane & 15); const bool ok = n < t.Nsrc; const float* p = t.src + (size_t)(t.k0 + (lane >> 4)) * t.Nsrc + n;
#pragma unroll
    for (int i = 0; i < 16; ++i) v[i] = ok ? *(const f32x4*)(p + (size_t)(4 * i) * t.Nsrc) : (f32x4){0.f, 0.f, 0.f, 0.f};
}
__device__ __forceinline__ void p0_store(const f32x4 (&v)[16], const TTile& t, LAS float* scr, int lane) {
#pragma unroll
    for (int i = 0; i < 16; ++i) { LAS float* d = scr + ((lane >> 4) + 4 * i) * 65 + 4 * (lane & 15); d[0] = v[i].x; d[1] = v[i].y; d[2] = v[i].z; d[3] = v[i].w; }
    asm volatile("s_waitcnt lgkmcnt(0)" ::: "memory");
    const int c = lane & 7;
#pragma unroll
    for (int j = 0; j < 8; ++j) { const int n = (lane >> 3) + 8 * j; const LAS float* sp = scr + (8 * c) * 65 + n;
        if (t.fp8) { u32x2 o; o.x = pk4_fp8(sp[0 * 65] * WSCALE, sp[1 * 65] * WSCALE, sp[2 * 65] * WSCALE, sp[3 * 65] * WSCALE); o.y = pk4_fp8(sp[4 * 65] * WSCALE, sp[5 * 65] * WSCALE, sp[6 * 65] * WSCALE, sp[7 * 65] * WSCALE);
            *(u32x2*)(t.dst + (size_t)(t.orow0 + n) * DM + t.k0 + 8 * c) = o; }
        else { u32x4 o; o.x = pk2(sp[0 * 65], sp[1 * 65]); o.y = pk2(sp[2 * 65], sp[3 * 65]); o.z = pk2(sp[4 * 65], sp[5 * 65]); o.w = pk2(sp[6 * 65], sp[7 * 65]);
            *(u32x4*)(t.dst + ((size_t)(t.orow0 + n) * DM + t.k0 + 8 * c) * 2) = o; } }
    asm volatile("s_waitcnt lgkmcnt(0)" ::: "memory");
}
__device__ __forceinline__ void rms_row_to_bf16(const float* xrow, const float* gain, bf16_t* orow, int lane) {
    const f32x4* xr = (const f32x4*)xrow + lane; const f32x4* gr = (const f32x4*)gain + lane;
    f32x4 v[4]; float s = 0.f;
#pragma unroll
    for (int j = 0; j < 4; ++j) { v[j] = xr[64 * j]; s += (v[j].x * v[j].x + v[j].y * v[j].y) + (v[j].z * v[j].z + v[j].w * v[j].w); }
    const float rs = 1.f / sqrtf(wave_sum(s) * (1.f / DM) + EPS);
    unsigned long long* o8 = (unsigned long long*)orow + lane;
#pragma unroll
    for (int j = 0; j < 4; ++j) { const f32x4 g = gr[64 * j]; o8[64 * j] = (unsigned long long)pk2(v[j].x * rs * g.x, v[j].y * rs * g.y) | ((unsigned long long)pk2(v[j].z * rs * g.z, v[j].w * rs * g.w) << 32); }
}

__device__ __forceinline__ void p0_prologue(Frame& F, const Args& a) {
    LAS float* scr = (LAS float*)(F.lds + F.wave * 16640);
    const int gw = F.vcu * NWAVES + F.wave, NGW = F.G * NWAVES;
    constexpr int NT = 16 * 44 + 16 * 16 + NEXP * 3 * 256;
    {
        f32x4 va[16], vb[16];
        int it = gw;
        if (it < NT) { const TTile t = p0_tile(a, F.ws, it); p0_load(va, t, F.lane); }
        while (it < NT) {
            int it2 = it + NGW;
            if (it2 < NT) { const TTile t2 = p0_tile(a, F.ws, it2); p0_load(vb, t2, F.lane); }
            { const TTile t = p0_tile(a, F.ws, it); p0_store(va, t, scr, F.lane); }
            it = it2; if (it >= NT) break;
            it2 = it + NGW;
            if (it2 < NT) { const TTile t2 = p0_tile(a, F.ws, it2); p0_load(va, t2, F.lane); }
            { const TTile t = p0_tile(a, F.ws, it); p0_store(vb, t, scr, F.lane); }
            it = it2;
        }
    }
    bf16_t* WRH = (bf16_t*)(F.ws + WS_WRT); bf16_t* WRL = WRH + 48 * DM;
    for (int idx = blockIdx.x * NTHR + F.tid; idx < 48 * DM; idx += F.G * NTHR) { const int j = idx / DM, k = idx % DM; const float wv = j < 4 ? a.in[16][k * 4 + j] : (j < 36 ? a.in[18][k * 32 + (j - 4)] : 0.f);
        const unsigned hi = f2bf(wv); WRH[idx] = (bf16_t)hi; WRL[idx] = (bf16_t)f2bf(wv - bf2f(hi)); }
    {
        bf16_t* WAT = (bf16_t*)(F.ws + WS_SMALL); bf16_t* WXT = WAT + 8 * 64 * 64; bf16_t* WUPT = WXT + 8 * 64 * 64;
        for (int idx = blockIdx.x * NTHR + F.tid; idx < 8 * 64 * 64; idx += F.G * NTHR) { const int h = idx >> 12, j = (idx >> 6) & 63, i = idx & 63;
            WAT[idx] = (bf16_t)f2bf(a.in[5][(h * 64 + i) * 64 + j]); WXT[idx] = (bf16_t)f2bf(a.in[7][(h * 64 + i) * 64 + j]); }
        for (int idx = blockIdx.x * NTHR + F.tid; idx < 256 * 32; idx += F.G * NTHR) { const int n = idx >> 5, k = idx & 31; WUPT[idx] = k < 16 ? (bf16_t)f2bf(a.in[11][k * 256 + n]) : (bf16_t)0; }
    }
    bf16_t* HN = (bf16_t*)(F.ws + WS_HN);
    for (int m = gw; m < NTOK; m += NGW) rms_row_to_bf16(a.in[0] + (size_t)m * DM, a.in[1], HN + (size_t)m * DM, F.lane);
}

template <int KS> __device__ __forceinline__ f32x4 mma_ll(f32x4 acc, const LAS unsigned char* A, int lda, const LAS unsigned char* Bt, int ldb, int lane) {
    const LAS unsigned char* ap = A + (lane & 15) * lda + (lane >> 4) * 16; const LAS unsigned char* bp = Bt + (lane & 15) * ldb + (lane >> 4) * 16;
#pragma unroll
    for (int ks = 0; ks < KS; ++ks) acc = __builtin_amdgcn_mfma_f32_16x16x32_bf16(*(const LAS bf16x8*)(ap + ks * 64), *(const LAS bf16x8*)(bp + ks * 64), acc, 0, 0, 0);
    return acc;
}
template <int KS> __device__ __forceinline__ f32x4 mma_lg(f32x4 acc, const LAS unsigned char* A, int lda, const bf16_t* Bt, int ldb_elems, int lane) {
    const LAS unsigned char* ap = A + (lane & 15) * lda + (lane >> 4) * 16; const bf16_t* bp = Bt + (size_t)(lane & 15) * ldb_elems + (lane >> 4) * 8;
#pragma unroll
    for (int ks = 0; ks < KS; ++ks) acc = __builtin_amdgcn_mfma_f32_16x16x32_bf16(*(const LAS bf16x8*)(ap + ks * 64), *(const bf16x8*)(bp + ks * 32), acc, 0, 0, 0);
    return acc;
}
#define WAVE_LDS_FENCE() asm volatile("s_waitcnt lgkmcnt(0)" ::: "memory")
__device__ __forceinline__ float logsigmoidf_(float g) { return fminf(g, 0.f) - __logf(1.f + __expf(-fabsf(g))); }
__device__ __forceinline__ void unpack8(const u32x4 w, float (&f)[8]) { f[0] = bf2f(w.x & 0xffffu); f[1] = bf2f(w.x >> 16); f[2] = bf2f(w.y & 0xffffu); f[3] = bf2f(w.y >> 16); f[4] = bf2f(w.z & 0xffffu); f[5] = bf2f(w.z >> 16); f[6] = bf2f(w.w & 0xffffu); f[7] = bf2f(w.w >> 16); }
__device__ __forceinline__ u32x4 pack8(const float (&f)[8]) { u32x4 w; w.x = pk2(f[0], f[1]); w.y = pk2(f[2], f[3]); w.z = pk2(f[4], f[5]); w.w = pk2(f[6], f[7]); return w; }

constexpr int XS = 144;
constexpr int RG_AU = 8 * 64 * XS;
constexpr int GL_AL = 0, GL_BT = 5120, GL_T1 = 21504, GL_T2 = 30720, GL_T3 = 39936, GL_VT4 = 49152, GL_REGION = 67584;
static_assert(RG_AU + 8 * 8192 <= 143360 && 2 * GL_REGION <= 143360, "mixer LDS");

template <bool FIN> __device__ __forceinline__ void mixer_chunk(Frame& F, const Args& a, const int chunk) {
    const bf16_t* PROJ = (const bf16_t*)(F.ws + WS_PROJ); bf16_t* Y = (bf16_t*)(F.ws + WS_HN);
    const int t0 = chunk * 64, nloc = chunk & 127, lane = F.lane, w = F.wave, c16 = lane & 15, g4 = lane >> 4;
    LAS unsigned char* L = F.lds;
    {
        LAS unsigned char* slab = L + w * (64 * XS);
        LAS float* au_a = (LAS float*)(L + RG_AU + w * 8192); LAS float* au_u = au_a + 1024;
        const float* conv_w = a.in[3]; const float* conv_b = a.in[4];
        {
            const int cg = lane & 7, ch0 = 64 * w + 8 * cg;
            float cw[4][8], cb[8];
#pragma unroll
            for (int j = 0; j < 4; ++j) { const f32x4 p = *(const f32x4*)(conv_w + j * RGW + ch0), q = *(const f32x4*)(conv_w + j * RGW + ch0 + 4); cw[j][0] = p.x; cw[j][1] = p.y; cw[j][2] = p.z; cw[j][3] = p.w; cw[j][4] = q.x; cw[j][5] = q.y; cw[j][6] = q.z; cw[j][7] = q.w; }
            { const f32x4 p = *(const f32x4*)(conv_b + ch0), q = *(const f32x4*)(conv_b + ch0 + 4); cb[0] = p.x; cb[1] = p.y; cb[2] = p.z; cb[3] = p.w; cb[4] = q.x; cb[5] = q.y; cb[6] = q.z; cb[7] = q.w; }
#pragma unroll 2
            for (int it = 0; it < 8; ++it) {
                const int tok = (lane >> 3) + 8 * it;
                float xc[8];
#pragma unroll
                for (int i = 0; i < 8; ++i) xc[i] = cb[i];
#pragma unroll
                for (int j = 0; j < 4; ++j) { const int tl = nloc * 64 + tok - 3 + j;
                    if (tl >= 0) { float xv[8]; unpack8(*(const u32x4*)(PROJ + (size_t)(t0 + tok - 3 + j) * LDP + C_XR + ch0), xv);
#pragma unroll
                        for (int i = 0; i < 8; ++i) xc[i] += cw[j][i] * xv[i]; } }
                *(LAS u32x4*)(slab + tok * XS + cg * 16) = pack8(xc);
            }
        }
        WAVE_LDS_FENCE();
        bf16x8 af[4][2];
#pragma unroll
        for (int mt = 0; mt < 4; ++mt)
#pragma unroll
            for (int ks = 0; ks < 2; ++ks) af[mt][ks] = *(const LAS bf16x8*)(slab + (16 * mt + c16) * XS + ks * 64 + g4 * 16);
        const bf16_t* WAT = (const bf16_t*)(F.ws + WS_SMALL); const bf16_t* WXT = WAT + 8 * 64 * 64;
        const float* b_a = a.in[6]; const float* b_x = a.in[8]; const float* lam = a.in[9];
        const float* RGC = (const float*)(F.ws + WS_RGC); float* RGSA = (float*)(F.ws + WS_RGSA); float* RGSH = (float*)(F.ws + WS_RGSH);
#pragma unroll 1
        for (int nt = 0; nt < 4; ++nt) {
            const int ch = 64 * w + 16 * nt + c16;
            const bf16_t* wa = WAT + (size_t)(64 * w + 16 * nt + c16) * 64 + g4 * 8; const bf16_t* wx = WXT + (size_t)(64 * w + 16 * nt + c16) * 64 + g4 * 8;
            const bf16x8 ba0 = *(const bf16x8*)wa, ba1 = *(const bf16x8*)(wa + 32), bx0 = *(const bf16x8*)wx, bx1 = *(const bf16x8*)(wx + 32);
            const float bias_a = b_a[ch], bias_x = b_x[ch], sp8 = 8.f * log1pf(__expf(-lam[ch]));
#pragma unroll
            for (int mt = 0; mt < 4; ++mt) {
                f32x4 R = {0.f, 0.f, 0.f, 0.f}, I = {0.f, 0.f, 0.f, 0.f};
                R = __builtin_amdgcn_mfma_f32_16x16x32_bf16(af[mt][0], ba0, R, 0, 0, 0); R = __builtin_amdgcn_mfma_f32_16x16x32_bf16(af[mt][1], ba1, R, 0, 0, 0);
                I = __builtin_amdgcn_mfma_f32_16x16x32_bf16(af[mt][0], bx0, I, 0, 0, 0); I = __builtin_amdgcn_mfma_f32_16x16x32_bf16(af[mt][1], bx1, I, 0, 0, 0);
#pragma unroll
                for (int r = 0; r < 4; ++r) { const int tok = 16 * mt + 4 * g4 + r;
                    const float rr = sigmoidf_(R[r] + bias_a), ii = sigmoidf_(I[r] + bias_x);
                    const float x2 = -2.f * sp8 * rr;
                    const float av = __expf(0.5f * x2);
                    const float om = (x2 > -0.1f) ? -x2 * (1.f + x2 * (0.5f + x2 * (0.16666667f + x2 * 0.041666668f))) : 1.f - __expf(x2);
                    const float xcv = bf2f(*(const LAS unsigned short*)(slab + tok * XS + (16 * nt + c16) * 2));
                    au_a[tok * 16 + c16] = av; au_u[tok * 16 + c16] = sqrtf(om) * (ii * xcv); }
            }
            WAVE_LDS_FENCE();
            if (lane < 16) {
                float h = FIN ? RGC[(size_t)chunk * RGW + ch] : 0.f, P = 1.f;
#pragma unroll 8
                for (int tok = 0; tok < 64; ++tok) { const float av = au_a[tok * 16 + lane], uv = au_u[tok * 16 + lane]; h = av * h + uv; P *= av;
                    if (FIN) *(LAS unsigned short*)(slab + tok * XS + (16 * nt + lane) * 2) = (unsigned short)f2bf(h); }
                if (!FIN) { RGSA[(size_t)chunk * RGW + ch] = P; RGSH[(size_t)chunk * RGW + ch] = h; }
            }
            WAVE_LDS_FENCE();
        }
        if (FIN) {
            __syncthreads();
            const float* rg_norm = a.in[10];
            float gn[8]; { const f32x4 p = *(const f32x4*)(rg_norm + 8 * lane), q = *(const f32x4*)(rg_norm + 8 * lane + 4); gn[0] = p.x; gn[1] = p.y; gn[2] = p.z; gn[3] = p.w; gn[4] = q.x; gn[5] = q.y; gn[6] = q.z; gn[7] = q.w; }
#pragma unroll 2
            for (int i = 0; i < 8; ++i) { const int tok = 8 * w + i;
                float hv[8], yv[8]; unpack8(*(const LAS u32x4*)(L + (lane >> 3) * (64 * XS) + tok * XS + (lane & 7) * 16), hv); unpack8(*(const u32x4*)(PROJ + (size_t)(t0 + tok) * LDP + C_YR + 8 * lane), yv);
                float ss = 0.f;
#pragma unroll
                for (int j = 0; j < 8; ++j) { hv[j] *= gelu_tanh(yv[j]); ss += hv[j] * hv[j]; }
                const float rs = 1.f / sqrtf(wave_sum(ss) * (1.f / 512.f) + EPS);
#pragma unroll
                for (int j = 0; j < 8; ++j) hv[j] *= rs * gn[j];
                *(u32x4*)(Y + (size_t)(t0 + tok) * DM + 8 * lane) = pack8(hv); }
        }
        __syncthreads();
    }
    const bf16_t* WUPT = (const bf16_t*)(F.ws + WS_SMALL) + 2 * 8 * 64 * 64;
    const float* b_al = a.in[12];
    float* KVT = (float*)(F.ws + WS_KVT); float* DEC = (float*)(F.ws + WS_DEC); const bf16_t* ST = (const bf16_t*)(F.ws + WS_ST);
#pragma unroll 1
    for (int pass = 0; pass < 2; ++pass) {
        const int s = w >> 2, q4 = w & 3, hh = 2 * pass + s, ht = F.tid & 255;
        LAS unsigned char* R = L + s * GL_REGION;
        LAS float* BT = (LAS float*)(R + GL_BT);
        LAS unsigned char* VT = R + (FIN ? GL_VT4 : GL_T2);
        if (ht < 128) { const int tok = ht >> 1, half = ht & 1; *(LAS u32x4*)(R + GL_AL + tok * 80 + half * 16) = *(const u32x4*)(PROJ + (size_t)(t0 + tok) * LDP + C_AL + 8 * half); *(LAS u32x4*)(R + GL_AL + tok * 80 + 32 + half * 16) = (u32x4){0u, 0u, 0u, 0u}; }
#pragma unroll
        for (int i = 0; i < 4; ++i) { const int idx = ht + 256 * i, tok = idx >> 4, ec = idx & 15; const u32x4 v = *(const u32x4*)(PROJ + (size_t)(t0 + tok) * LDP + C_V + hh * 128 + 8 * ec);
            LAS unsigned short* vt = (LAS unsigned short*)(VT + (8 * ec) * XS + tok * 2);
            vt[0 * (XS / 2)] = (unsigned short)(v.x & 0xffffu); vt[1 * (XS / 2)] = (unsigned short)(v.x >> 16); vt[2 * (XS / 2)] = (unsigned short)(v.y & 0xffffu); vt[3 * (XS / 2)] = (unsigned short)(v.y >> 16);
            vt[4 * (XS / 2)] = (unsigned short)(v.z & 0xffffu); vt[5 * (XS / 2)] = (unsigned short)(v.z >> 16); vt[6 * (XS / 2)] = (unsigned short)(v.w & 0xffffu); vt[7 * (XS / 2)] = (unsigned short)(v.w >> 16); }
        __syncthreads();
#pragma unroll
        for (int nt = 0; nt < 4; ++nt) { f32x4 acc = {0.f, 0.f, 0.f, 0.f};
            acc = mma_lg<1>(acc, R + GL_AL + (16 * q4) * 80, 80, WUPT + (size_t)(hh * 64 + 16 * nt) * 32, 32, lane);
            const float bb = b_al[hh * 64 + 16 * nt + c16];
#pragma unroll
            for (int r = 0; r < 4; ++r) BT[(16 * q4 + 4 * g4 + r) * 64 + 16 * nt + c16] = logsigmoidf_(acc[r] + bb) * (1.f / 16.f); }
        __syncthreads();
        if (q4 == 0) { float run = 0.f;
#pragma unroll 8
            for (int tok = 0; tok < 64; ++tok) { run += BT[tok * 64 + lane]; BT[tok * 64 + lane] = run; } }
        __syncthreads();
#pragma unroll
        for (int i = 0; i < 2; ++i) { const int idx = ht + 256 * i, tok = idx >> 3, dc = idx & 7;
            float bv[8], kv[8]; { const f32x4 p = *(const LAS f32x4*)(BT + tok * 64 + 8 * dc), q = *(const LAS f32x4*)(BT + tok * 64 + 8 * dc + 4); bv[0] = p.x; bv[1] = p.y; bv[2] = p.z; bv[3] = p.w; bv[4] = q.x; bv[5] = q.y; bv[6] = q.z; bv[7] = q.w; }
            unpack8(*(const u32x4*)(PROJ + (size_t)(t0 + tok) * LDP + C_K + hh * 64 + 8 * dc), kv);
            if (!FIN) { float bl[8]; { const f32x4 p = *(const LAS f32x4*)(BT + 63 * 64 + 8 * dc), q = *(const LAS f32x4*)(BT + 63 * 64 + 8 * dc + 4); bl[0] = p.x; bl[1] = p.y; bl[2] = p.z; bl[3] = p.w; bl[4] = q.x; bl[5] = q.y; bl[6] = q.z; bl[7] = q.w; }
                LAS unsigned short* ke = (LAS unsigned short*)(R + GL_T1 + (8 * dc) * XS + tok * 2);
#pragma unroll
                for (int j = 0; j < 8; ++j) ke[j * (XS / 2)] = (unsigned short)f2bf(kv[j] * __expf(bl[j] - bv[j])); }
            else { float qv[8]; unpack8(*(const u32x4*)(PROJ + (size_t)(t0 + tok) * LDP + C_Q + hh * 64 + 8 * dc), qv);
#pragma unroll
                for (int j = 0; j < 8; ++j) { const float eb = __expf(bv[j]); qv[j] *= 0.125f * eb; kv[j] *= 1.f / eb; }
                *(LAS u32x4*)(R + GL_T1 + tok * XS + dc * 16) = pack8(qv); *(LAS u32x4*)(R + GL_T2 + tok * XS + dc * 16) = pack8(kv); } }
        if (!FIN && ht < 64) DEC[(size_t)(chunk * 4 + hh) * 64 + ht] = __expf(BT[63 * 64 + ht]);
        __syncthreads();
        if (!FIN) {
#pragma unroll
            for (int mi = 0; mi < 2; ++mi) { const int mt = 2 * q4 + mi;
#pragma unroll
                for (int nt = 0; nt < 4; ++nt) { f32x4 acc = {0.f, 0.f, 0.f, 0.f}; acc = mma_ll<2>(acc, VT + (16 * mt) * XS, XS, R + GL_T1 + (16 * nt) * XS, XS, lane);
#pragma unroll
                    for (int r = 0; r < 4; ++r) KVT[((size_t)(chunk * 4 + hh) * 128 + 16 * mt + 4 * g4 + r) * 64 + 16 * nt + c16] = acc[r]; } }
        } else {
#pragma unroll
            for (int nt = 0; nt < 4; ++nt) { f32x4 acc = {0.f, 0.f, 0.f, 0.f}; acc = mma_ll<2>(acc, R + GL_T2 + (16 * q4) * XS, XS, R + GL_T1 + (16 * nt) * XS, XS, lane);
                const int i = 16 * nt + c16, j0 = 16 * q4 + 4 * g4;
                u32x2 pw; pw.x = pk2(j0 <= i ? acc[0] : 0.f, j0 + 1 <= i ? acc[1] : 0.f); pw.y = pk2(j0 + 2 <= i ? acc[2] : 0.f, j0 + 3 <= i ? acc[3] : 0.f);
                *(LAS u32x2*)(R + GL_T3 + i * XS + j0 * 2) = pw; }
            __syncthreads();
            f32x4 o[8]; const bf16_t* st = ST + (size_t)(chunk * 4 + hh) * 128 * 64;
#pragma unroll
            for (int nt = 0; nt < 8; ++nt) { f32x4 acc = {0.f, 0.f, 0.f, 0.f};
                acc = mma_ll<2>(acc, R + GL_T3 + (16 * q4) * XS, XS, VT + (16 * nt) * XS, XS, lane);
                acc = mma_lg<2>(acc, R + GL_T1 + (16 * q4) * XS, XS, st + (size_t)(16 * nt) * 64, 64, lane);
                o[nt] = acc; }
            const float* gla_norm = a.in[13];
            float rs[4];
#pragma unroll
            for (int r = 0; r < 4; ++r) { float ss = 0.f;
#pragma unroll
                for (int nt = 0; nt < 8; ++nt) ss += o[nt][r] * o[nt][r];
                ss += __shfl_xor(ss, 1); ss += __shfl_xor(ss, 2); ss += __shfl_xor(ss, 4); ss += __shfl_xor(ss, 8);
                rs[r] = 1.f / sqrtf(ss * (1.f / 128.f) + EPS); }
            LAS unsigned short* OY = (LAS unsigned short*)(R + GL_BT);
#pragma unroll
            for (int nt = 0; nt < 8; ++nt) { const float gnv = gla_norm[16 * nt + c16];
#pragma unroll
                for (int r = 0; r < 4; ++r) OY[(16 * q4 + 4 * g4 + r) * 128 + 16 * nt + c16] = (unsigned short)f2bf(o[nt][r] * rs[r] * gnv); }
            __syncthreads();
#pragma unroll
            for (int i = 0; i < 4; ++i) { const int idx = ht + 256 * i, tok = idx >> 4, ec = idx & 15;
                float ov[8], gv[8]; unpack8(*(const LAS u32x4*)(OY + tok * 128 + 8 * ec), ov); unpack8(*(const u32x4*)(PROJ + (size_t)(t0 + tok) * LDP + C_G + hh * 128 + 8 * ec), gv);
#pragma unroll
                for (int j = 0; j < 8; ++j) ov[j] *= gv[j] * sigmoidf_(gv[j]);
                *(u32x4*)(Y + (size_t)(t0 + tok) * DM + 512 + hh * 128 + 8 * ec) = pack8(ov); }
        }
        __syncthreads();
    }
}

__device__ __forceinline__ void m3_scan(Frame& F) {
    const float* KVT = (const float*)(F.ws + WS_KVT); const float* DEC = (const float*)(F.ws + WS_DEC); bf16_t* ST = (bf16_t*)(F.ws + WS_ST);
    const float* RGSA = (const float*)(F.ws + WS_RGSA); const float* RGSH = (const float*)(F.ws + WS_RGSH); float* RGC = (float*)(F.ws + WS_RGC);
    const int bx = blockIdx.x;
    if (bx < 128) {
        const int id = bx * 512 + F.tid, d = id & 63, e = (id >> 6) & 127, bh = id >> 13, b = bh >> 2, hh = bh & 3;
        float sv = 0.f;
        for (int n = 0; n < 128; n += 8) {
            float kv[8], dc[8];
#pragma unroll
            for (int q = 0; q < 8; ++q) { const size_t ch = (size_t)((b * 128 + n + q) * 4 + hh); kv[q] = KVT[(ch * 128 + e) * 64 + d]; dc[q] = DEC[ch * 64 + d]; }
#pragma unroll
            for (int q = 0; q < 8; ++q) { const size_t ch = (size_t)((b * 128 + n + q) * 4 + hh); ST[(ch * 128 + e) * 64 + d] = (bf16_t)f2bf(sv); sv = dc[q] * sv + kv[q]; }
        }
    } else if (bx < 130) {
        const int id = (bx - 128) * 512 + F.tid, b = id >> 9, ch = id & 511;
        float h = 0.f;
        for (int n = 0; n < 128; n += 8) {
            float av[8], hv[8];
#pragma unroll
            for (int q = 0; q < 8; ++q) { const size_t o = (size_t)(b * 128 + n + q) * RGW + ch; av[q] = RGSA[o]; hv[q] = RGSH[o]; }
#pragma unroll
            for (int q = 0; q < 8; ++q) { const size_t o = (size_t)(b * 128 + n + q) * RGW + ch; RGC[o] = h; h = av[q] * h + hv[q]; }
        }
    }
}

__device__ __forceinline__ void p6_router(Frame& F, const Args& a) {
    const float* Hf = F.out; unsigned char* HN8 = F.ws + WS_HN; const bf16_t* WRH = (const bf16_t*)(F.ws + WS_WRT); const bf16_t* WRL = WRH + 48 * DM;
    const float* gain = a.in[15]; const float* bg = a.in[17]; const float* be = a.in[19];
    int* STOK = (int*)(F.ws + WS_STOK); float* SW = (float*)(F.ws + WS_SW); int* TIDX = (int*)(F.ws + WS_TIDX); float* RS = (float*)(F.ws + WS_RS);
    unsigned* gcnt = F.ctl + CW_GCNT;
    LAS float* part = (LAS float*)F.lds;
    LAS float* ssp = part + 2 * 64 * 48;
    LAS int* lcnt = (LAS int*)(ssp + 128); LAS int* lbase = lcnt + 32; LAS int* rec_e = lbase + 32; LAS int* rec_l = rec_e + 128; LAS float* rec_w = (LAS float*)(rec_l + 128);
    const int lane = F.lane, c16 = lane & 15, g4 = lane >> 4, mt = F.wave & 3, kh = F.wave >> 2;
    for (int grp = blockIdx.x; grp < NTOK / 64; grp += F.G) {
        if (F.tid < 32) lcnt[F.tid] = 0;
        {
            const int t = grp * 64 + 16 * mt + c16;
            f32x4 acc[3] = {{0.f, 0.f, 0.f, 0.f}, {0.f, 0.f, 0.f, 0.f}, {0.f, 0.f, 0.f, 0.f}}; float ss = 0.f;
#pragma unroll 2
            for (int ks = 0; ks < 16; ++ks) {
                const int k0 = 512 * kh + 32 * ks + 8 * g4;
                const f32x4 h0 = *(const f32x4*)(Hf + (size_t)t * DM + k0), h1 = *(const f32x4*)(Hf + (size_t)t * DM + k0 + 4), g0 = *(const f32x4*)(gain + k0), g1 = *(const f32x4*)(gain + k0 + 4);
                ss += (h0.x * h0.x + h0.y * h0.y) + (h0.z * h0.z + h0.w * h0.w) + (h1.x * h1.x + h1.y * h1.y) + (h1.z * h1.z + h1.w * h1.w);
                float v[8] = {h0.x * g0.x, h0.y * g0.y, h0.z * g0.z, h0.w * g0.w, h1.x * g1.x, h1.y * g1.y, h1.z * g1.z, h1.w * g1.w};
                bf16x8 ahi, alo;
#pragma unroll
                for (int j = 0; j < 8; ++j) { const unsigned hi = f2bf(v[j]); ahi[j] = (short)hi; alo[j] = (short)f2bf(v[j] - bf2f(hi)); }
                { u32x2 p8; p8.x = pk4_fp8(v[0], v[1], v[2], v[3]); p8.y = pk4_fp8(v[4], v[5], v[6], v[7]); *(u32x2*)(HN8 + (size_t)t * DM + k0) = p8; }
#pragma unroll
                for (int nt = 0; nt < 3; ++nt) { const bf16x8 wh = *(const bf16x8*)(WRH + (size_t)(16 * nt + c16) * DM + k0), wl = *(const bf16x8*)(WRL + (size_t)(16 * nt + c16) * DM + k0);
                    acc[nt] = __builtin_amdgcn_mfma_f32_16x16x32_bf16(ahi, wh, acc[nt], 0, 0, 0); acc[nt] = __builtin_amdgcn_mfma_f32_16x16x32_bf16(alo, wh, acc[nt], 0, 0, 0); acc[nt] = __builtin_amdgcn_mfma_f32_16x16x32_bf16(ahi, wl, acc[nt], 0, 0, 0); }
            }
            ss += __shfl_xor(ss, 16); ss += __shfl_xor(ss, 32);
            if (g4 == 0) ssp[kh * 64 + 16 * mt + c16] = ss;
#pragma unroll
            for (int nt = 0; nt < 3; ++nt)
#pragma unroll
                for (int r = 0; r < 4; ++r) part[(kh * 64 + 16 * mt + 4 * g4 + r) * 48 + 16 * nt + c16] = acc[nt][r];
        }
        __syncthreads();
        if (F.tid < 64) {
            const int tl = F.tid, t = grp * 64 + tl;
            const float rs = 1.f / sqrtf((ssp[tl] + ssp[64 + tl]) * (1.f / DM) + EPS);
            RS[t] = rs;
            float lg[36];
#pragma unroll
            for (int o = 0; o < 36; ++o) lg[o] = rs * (part[tl * 48 + o] + part[(64 + tl) * 48 + o]);
            float gl[4];
#pragma unroll
            for (int q = 0; q < 4; ++q) gl[q] = lg[q] + bg[q];
            int gi = 0; float gm = gl[0];
#pragma unroll
            for (int q = 1; q < 4; ++q) if (gl[q] > gm) { gm = gl[q]; gi = q; }
            float gs = 0.f;
#pragma unroll
            for (int q = 0; q < 4; ++q) gs += expf(gl[q] - gm);
            const float gwt = 1.f / gs;
            float le[8];
#pragma unroll
            for (int q = 0; q < 8; ++q) { float x = lg[4 + q] + be[q];
#pragma unroll
                for (int g2 = 1; g2 < 4; ++g2) x = (gi == g2) ? (lg[4 + g2 * 8 + q] + be[g2 * 8 + q]) : x;
                le[q] = x; }
            int i1 = 0; float m1 = le[0];
#pragma unroll
            for (int q = 1; q < 8; ++q) if (le[q] > m1) { m1 = le[q]; i1 = q; }
            int i2 = -1; float m2 = -3.0e38f;
#pragma unroll
            for (int q = 0; q < 8; ++q) if (q != i1 && le[q] > m2) { m2 = le[q]; i2 = q; }
            const float e2 = expf(m2 - m1), inv = 1.f / (1.f + e2);
            const int ea = gi * 8 + i1, eb = gi * 8 + i2;
            const int la_ = __hip_atomic_fetch_add(lcnt + ea, 1, __ATOMIC_RELAXED, __HIP_MEMORY_SCOPE_WORKGROUP), lb_ = __hip_atomic_fetch_add(lcnt + eb, 1, __ATOMIC_RELAXED, __HIP_MEMORY_SCOPE_WORKGROUP);
            rec_e[tl * 2] = ea; rec_l[tl * 2] = la_; rec_w[tl * 2] = gwt * inv; rec_e[tl * 2 + 1] = eb; rec_l[tl * 2 + 1] = lb_; rec_w[tl * 2 + 1] = gwt * e2 * inv;
        }
        __syncthreads();
        if (F.tid < 32) { const int cnum = lcnt[F.tid]; lbase[F.tid] = cnum ? (int)__hip_atomic_fetch_add(gcnt + F.tid, (unsigned)cnum, __ATOMIC_RELAXED, __HIP_MEMORY_SCOPE_AGENT) : 0; }
        __syncthreads();
        if (F.tid < 128) { const int e = rec_e[F.tid], idx = e * CAP + lbase[e] + rec_l[F.tid], t = grp * 64 + (F.tid >> 1);
            STOK[idx] = t; SW[idx] = rec_w[F.tid]; TIDX[t * 2 + (F.tid & 1)] = idx; }
        __syncthreads();
    }
}

__device__ __forceinline__ int moe_setup(Frame& F, int ncol_log2, bool tables, bool scale_is_rs) {
    const unsigned* gcnt = F.ctl + CW_GCNT;
    LAS int* lcnt = (LAS int*)(F.lds + L_CNT); LAS int* tst = (LAS int*)(F.lds + L_TST); LAS int* utab = (LAS int*)(F.lds + L_UTAB);
    LAS unsigned* rowt = (LAS unsigned*)(F.lds + L_ROWT); LAS float* wt = (LAS float*)(F.lds + L_WT);
    const int* STOK = (const int*)(F.ws + WS_STOK); const float* SW = (const float*)(F.ws + WS_SW); const float* RS = (const float*)(F.ws + WS_RS);
    if (F.tid < 32) lcnt[F.tid] = (int)__hip_atomic_load(gcnt + F.tid, __ATOMIC_RELAXED, __HIP_MEMORY_SCOPE_AGENT);
    __syncthreads();
    if (F.tid == 0) { int s = 0; for (int e = 0; e < 32; ++e) { tst[e] = s; s += (lcnt[e] + 255) >> 8; } tst[32] = s; }
    __syncthreads();
    if (!tables) return 0;
    const int total = tst[32] << ncol_log2; int nu = 0;
    for (int ui = 0; ui < 5; ++ui) {
        const int L = ui * F.G + F.vcu; if (L >= total) break;
        const int rb = L >> ncol_log2, pn = L & ((1 << ncol_log2) - 1);
        int e = 0;
        for (int j = 1; j < 32; ++j) e += (tst[j] <= rb) ? 1 : 0;
        const int r0 = (rb - tst[e]) * 256; int rows = lcnt[e] - r0; rows = rows > 256 ? 256 : rows;
        if (F.tid < 256) { const bool ok = F.tid < rows; const int idx = e * CAP + r0 + F.tid;
            const int tok = ok ? STOK[idx] : 0; rowt[ui * 256 + F.tid] = (unsigned)tok * (unsigned)DM;     wt[ui * 256 + F.tid] = ok ? (scale_is_rs ? RS[tok] : SW[idx]) : 0.f; }
        if (F.tid == 0) { utab[ui * 4 + 0] = rb; utab[ui * 4 + 1] = pn; utab[ui * 4 + 2] = e; utab[ui * 4 + 3] = rows; }
        ++nu;
    }
    __syncthreads();
    return nu;
}

__device__ __forceinline__ void p9_final(Frame& F, const Args& a) {
    const LAS int* tst = (const LAS int*)(F.lds + L_TST);
    const int* TIDX = (const int*)(F.ws + WS_TIDX); const bf16_t* YB = (const bf16_t*)(F.ws + WS_YB); const float* gain = a.in[23];
    const int gw = F.vcu * NWAVES + F.wave, NGW = F.G * NWAVES;
    for (int t = gw; t < NTOK; t += NGW) {
        const int i1 = TIDX[t * 2], i2 = TIDX[t * 2 + 1];
        const size_t s1 = (size_t)tst[i1 >> 14] * 256 + (i1 & (CAP - 1)), s2 = (size_t)tst[i2 >> 14] * 256 + (i2 & (CAP - 1));
        f32x4* xr = (f32x4*)(F.out + (size_t)t * DM) + F.lane; const f32x4* gr = (const f32x4*)gain + F.lane;
        const u32x2* y1 = (const u32x2*)(YB + s1 * DM) + F.lane; const u32x2* y2 = (const u32x2*)(YB + s2 * DM) + F.lane;
        f32x4 v[4]; float s = 0.f;
#pragma unroll
        for (int q = 0; q < 4; ++q) { v[q] = xr[64 * q]; const u32x2 p = y1[64 * q], r = y2[64 * q];
            v[q].x += bf2f(p.x & 0xffffu) + bf2f(r.x & 0xffffu); v[q].y += bf2f(p.x >> 16) + bf2f(r.x >> 16); v[q].z += bf2f(p.y & 0xffffu) + bf2f(r.y & 0xffffu); v[q].w += bf2f(p.y >> 16) + bf2f(r.y >> 16);
            s += (v[q].x * v[q].x + v[q].y * v[q].y) + (v[q].z * v[q].z + v[q].w * v[q].w); }
        const float rs = 1.f / sqrtf(wave_sum(s) * (1.f / DM) + EPS);
#pragma unroll
        for (int q = 0; q < 4; ++q) { const f32x4 g = gr[64 * q]; xr[64 * q] = v[q] * rs * g; }
    }
}

__global__ void __launch_bounds__(NTHR, 2) fwd(Args args) {
    extern __shared__ __attribute__((aligned(16))) unsigned char lds_raw[];
    Frame F;
    F.lds = (LAS unsigned char*)lds_raw;
    F.tid = threadIdx.x; F.lane = F.tid & 63; F.wave = __builtin_amdgcn_readfirstlane(F.tid >> 6);
    F.G = gridDim.x; { const int bx = blockIdx.x; F.vcu = (F.G % 8 == 0) ? (bx % 8) * (F.G / 8) + bx / 8 : bx; }
    F.ws = args.ws; F.out = args.out; F.ctl = (unsigned*)(args.ws + WS_CTL);
    const int lo = args.ph_lo, hi = args.ph_hi;
    if (F.tid < 32) ((LAS unsigned*)(F.lds + L_MISC))[F.tid] = 0u;
    __syncthreads();
    XcdBarrier bar; bar.bar = F.ctl + CW_BAR; bar.x = 0; bar.st = nullptr;
    if (hi - lo > 1) bar = xcd_barrier_post(F.ctl + CW_BAR, (volatile LAS unsigned*)(F.lds + L_MISC) + 8);
#define SEAM(k) do { if (IN(k) && IN((k) + 1)) xcd_barrier(bar); } while (0)
#ifndef PHMASK
#define PHMASK 0x3ff
#endif
#define IN(k) (((PHMASK >> (k)) & 1) && lo <= (k) && (k) < hi)

    if (IN(0)) { for (int rep = 0; rep < 1 + (int)((REP_MASK >> 0) & 1u); ++rep) p0_prologue(F, args); }
    SEAM(0);
    if (IN(1)) for (int rep = 0; rep < 1 + (int)((REP_MASK >> 1) & 1u); ++rep) {
        pg8::StaticOrder S; S.init(NTOK, LDP, F.G, (int)blockIdx.x);
        pg8::EpiBf16 E{(bf16_t*)(F.ws + WS_PROJ), LDP};
        pg8::gemm_phase<pg8::EpiBf16, pg8::StaticOrder, true, false, false>(F.lds, (const bf16_t*)(F.ws + WS_HN), (const bf16_t*)(F.ws + WS_WIN), DM, S, E);
    }
    SEAM(1);
    if (IN(2)) for (int rep = 0; rep < 1 + (int)((REP_MASK >> 2) & 1u); ++rep) { for (int ck = blockIdx.x; ck < NTOK / 64; ck += F.G) mixer_chunk<false>(F, args, ck); }
    SEAM(2);
    if (IN(3)) { for (int rep = 0; rep < 1 + (int)((REP_MASK >> 3) & 1u); ++rep) m3_scan(F); }
    SEAM(3);
    if (IN(4)) for (int rep = 0; rep < 1 + (int)((REP_MASK >> 4) & 1u); ++rep) { for (int ck = blockIdx.x; ck < NTOK / 64; ck += F.G) mixer_chunk<true>(F, args, ck); }
    SEAM(4);
    if (IN(5)) for (int rep = 0; rep < 1 + (int)((REP_MASK >> 5) & 1u); ++rep) {
        pg8::StaticOrder S; S.init(NTOK, DM, F.G, (int)blockIdx.x);
        pg8::EpiResF32 E{args.in[0], F.out, DM};
        pg8::gemm_phase<pg8::EpiResF32, pg8::StaticOrder, false, false, false>(F.lds, (const bf16_t*)(F.ws + WS_HN), (const bf16_t*)(F.ws + WS_WOUT), DM, S, E);
    }
    SEAM(5);
    if (IN(6)) { p6_router(F, args); }
    SEAM(6);
    if (IN(7)) for (int rep = 0; rep < 1 + (int)((REP_MASK >> 7) & 1u); ++rep) {
        const int nu = moe_setup(F, 3, true, true);
        pg8::MoeOrder S{(const LAS int*)(F.lds + L_UTAB), (const LAS unsigned*)(F.lds + L_ROWT), nu, 8};
        pg8::EpiGeglu E{F.ws + WS_H};
        pg8::gemm_phase<pg8::EpiGeglu, pg8::MoeOrder, true, true, true>(F.lds, (const bf16_t*)(F.ws + WS_HN), (const bf16_t*)(F.ws + WS_WGU), DM / 2, S, E);
    }
    SEAM(7);
    if (IN(8)) for (int rep = 0; rep < 1 + (int)((REP_MASK >> 8) & 1u); ++rep) {
        const int nu = moe_setup(F, 2, true, false);
        pg8::MoeOrder S{(const LAS int*)(F.lds + L_UTAB), (const LAS unsigned*)(F.lds + L_ROWT), nu, 4};
        pg8::EpiScaleBf16 E{(bf16_t*)(F.ws + WS_YB)};
        pg8::gemm_phase<pg8::EpiScaleBf16, pg8::MoeOrder, true, false, true>(F.lds, (const bf16_t*)(F.ws + WS_H), (const bf16_t*)(F.ws + WS_WD), DM / 2, S, E);
    }
    SEAM(8);
    if (IN(9)) { moe_setup(F, 0, false, false); p9_final(F, args); }
#undef IN
#undef SEAM
}

extern "C" void kernel_launch(void* const* d_in, const int* in_sizes, int n_in, void* d_out, int out_size, void* d_ws, size_t ws_size, hipStream_t stream) {
    static int grid = 0;
    if (grid == 0) {
        if (n_in != 24 || out_size != NTOK * DM || ws_size < WS_END) { fprintf(stderr, "kernel_launch: unexpected shapes (n_in %d, out %d, ws %zu); nothing launched\n", n_in, out_size, ws_size); grid = -1; return; }
        int dev = 0, cus = 0;
        if (hipGetDevice(&dev) != hipSuccess || hipDeviceGetAttribute(&cus, hipDeviceAttributeMultiprocessorCount, dev) != hipSuccess) { grid = -1; return; }
        if (hipFuncSetAttribute((const void*)fwd, hipFuncAttributeMaxDynamicSharedMemorySize, LDS_BYTES) != hipSuccess) { fprintf(stderr, "kernel_launch: hipFuncSetAttribute failed\n"); grid = -1; return; }
        (void)hipGetLastError();
        grid = cus;
    }
    if (grid < 0) return;
    (void)hipMemsetAsync((char*)d_ws + WS_CTL, 0, CTL_ZERO_BYTES, stream);
    Args a{};
    for (int i = 0; i < 24; ++i) a.in[i] = (const float*)d_in[i];
    a.out = (float*)d_out; a.ws = (unsigned char*)d_ws;
#ifndef N_LAUNCHES
#define N_LAUNCHES 1
#endif
    if (N_LAUNCHES == 1) { a.ph_lo = 0; a.ph_hi = NPHASE; hipLaunchKernelGGL(fwd, dim3(grid), dim3(NTHR), LDS_BYTES, stream, a); }
    else for (int p = 0; p < NPHASE; ++p) { a.ph_lo = p; a.ph_hi = p + 1; hipLaunchKernelGGL(fwd, dim3(grid), dim3(NTHR), LDS_BYTES, stream, a); }
}
```

```cpp
#include <hip/hip_runtime.h>
#include <cstdio>
#include <cstdint>

#define LAS __attribute__((address_space(3)))
#define GAS __attribute__((address_space(1)))
typedef unsigned short bf16_t;
typedef short bf16x8 __attribute__((ext_vector_type(8)));
typedef float f32x4 __attribute__((ext_vector_type(4)));
typedef float f32x2 __attribute__((ext_vector_type(2)));
typedef unsigned u32x4 __attribute__((ext_vector_type(4)));
typedef unsigned u32x2 __attribute__((ext_vector_type(2)));
typedef int v4i __attribute__((ext_vector_type(4)));
typedef int v8i __attribute__((ext_vector_type(8)));

constexpr int NTOK = 16384, SEQ = 8192, DM = 1024;
constexpr int RGW = 512, NPROJ = 2576, LDP = 2816;
constexpr int C_XR = 0, C_YR = 512, C_Q = 1024, C_K = 1280, C_V = 1536, C_G = 2048, C_AL = 2560;
constexpr int NEXP = 32, CAP = 16384;
constexpr float EPS = 1e-6f;
constexpr int NWAVES = 8, NTHR = 512;
constexpr int NPHASE = 10;
constexpr unsigned REP_MASK = 0x000;
constexpr int TP_PHASE = -1;
constexpr bool TP_BODY = false;

constexpr size_t MiB = 1u << 20;
constexpr size_t WS_CTL = 0, CTL_ZERO_BYTES = 64 * 1024;
constexpr size_t WS_WRT = 1 * MiB;
constexpr size_t WS_RS = 1 * MiB + 512 * 1024;
constexpr size_t WS_WIN = 2 * MiB;
constexpr size_t WS_WOUT = 8 * MiB;
constexpr size_t WS_WGU = 16 * MiB;
constexpr size_t WS_WD = 80 * MiB;
constexpr float WSCALE = 32.f, WUNSCALE = 1.f / 32.f, YSCALE = 16.f, YUNSCALE = 1.f / 16.f;
constexpr size_t WS_HN = 208 * MiB;
constexpr size_t WS_PROJ = 240 * MiB;
constexpr size_t WS_SMALL = 10 * MiB;
constexpr size_t WS_KVT = 328 * MiB;
constexpr size_t WS_ST = 360 * MiB;
constexpr size_t WS_DEC = 376 * MiB, WS_RGSA = 377 * MiB, WS_RGSH = 377 * MiB + 512 * 1024, WS_RGC = 378 * MiB;
constexpr size_t WS_H = 240 * MiB;
constexpr size_t WS_YB = 320 * MiB;
constexpr size_t WS_HB = 400 * MiB;
constexpr size_t WS_STOK = 480 * MiB, WS_SW = 482 * MiB, WS_TIDX = 484 * MiB;
constexpr size_t WS_END = 512 * MiB;
constexpr int CW_BAR = 4096;
constexpr int CW_GCNT = 8192;

constexpr int RING_BYTES = 131072;
constexpr int CTRL_BASE = 143360;
constexpr int L_MISC = CTRL_BASE;
constexpr int L_CNT = CTRL_BASE + 128;
constexpr int L_TST = CTRL_BASE + 256;
constexpr int L_UTAB = CTRL_BASE + 512;
constexpr int MAXU = 8;
constexpr int L_ROWT = CTRL_BASE + 1024;
constexpr int L_WT = L_ROWT + MAXU * 1024;
constexpr int LDS_BYTES = L_WT + MAXU * 1024;
static_assert(LDS_BYTES <= 163840 && LDS_BYTES % 16 == 0, "LDS map");

__device__ __forceinline__ unsigned f2bf(float f) { unsigned u = __builtin_bit_cast(unsigned, f); return (u + 0x7fffu + ((u >> 16) & 1u)) >> 16; }
__device__ __forceinline__ unsigned pk2(float lo, float hi) { return f2bf(lo) | (f2bf(hi) << 16); }
__device__ __forceinline__ unsigned pk4_fp8(float a, float b, float c, float d) { int w = 0; w = __builtin_amdgcn_cvt_pk_fp8_f32(a, b, w, false); w = __builtin_amdgcn_cvt_pk_fp8_f32(c, d, w, true); return (unsigned)w; }
__device__ __forceinline__ float bf2f(unsigned b) { return __builtin_bit_cast(float, b << 16); }
__device__ __forceinline__ float wave_sum(float v) {
#pragma unroll
    for (int o = 1; o < 64; o <<= 1) v += __shfl_xor(v, o);
    return v;
}
__device__ __forceinline__ float frsq(float x) { return __builtin_amdgcn_rsqf(x); }
__device__ __forceinline__ float frcp(float x) { return __builtin_amdgcn_rcpf(x); }
__device__ __forceinline__ float sigmoidf_(float x) { return frcp(1.f + __expf(-x)); }
__device__ __forceinline__ float gelu_tanh(float x) { const float z2 = 1.5957691216057308f * (x + 0.044715f * x * x * x); return x * frcp(1.f + __expf(-z2)); }

struct TpAcc { unsigned long long t0, d; };
#define TPS2(T, id) do { if (TP_PHASE == (id)) (T).t0 = __builtin_amdgcn_s_memrealtime(); } while (0)
#define TPE2(T, id) do { if (TP_PHASE == (id)) (T).d += __builtin_amdgcn_s_memrealtime() - (T).t0; } while (0)
namespace pg8 {
constexpr int BM = 256, BK = 64, HALF = 128, HTB = HALF * BK * 2, NXCD = 8, WGM = 8;
__host__ __device__ __forceinline__ int lds_byte(int r, int c) { const int st = (r >> 4) * 2 + (c >> 5), rr = r & 15, cc = c & 31, ob = rr * 64 + cc * 2; return st * 1024 + (ob ^ (((ob >> 9) & 1) << 5)); }
__host__ __device__ __forceinline__ void stage_rc(int b, int& R, int& C) { const int st = b / 1024, sb = b % 1024, swz = sb ^ (((sb >> 9) & 1) << 5); R = (st >> 1) * 16 + swz / 64; C = (st & 1) * 32 + (swz % 64) / 2; }
__host__ __device__ __forceinline__ int perm32(int rho) { const int n = rho >> 4, i = rho & 15; return 8 * (i >> 2) + 4 * n + (i & 3); }

struct Unit { int pm, pn, bt, ui, e, rows; };

struct StaticOrder {
    int nM, nN, nwg, G, c;
    __device__ void init(int M, int N, int G_, int c_) { nM = M / BM; nN = N / BM; nwg = nM * nN; G = G_; c = c_; }
    __device__ bool next(int i, Unit& u) const {
        const long L = (long)i * G + c; if (L >= nwg) return false;
        int wgid = (int)L; { const int q = nwg / NXCD, r = nwg % NXCD, xcd = wgid % NXCD, off = wgid / NXCD; wgid = (xcd < r ? xcd * (q + 1) : r * (q + 1) + (xcd - r) * q) + off; }
        const int nig = WGM * nN, gid = wgid / nig, fm = gid * WGM, gsz = (nM - fm) < WGM ? (nM - fm) : WGM;
        u.pm = fm + ((wgid % nig) % gsz); u.pn = (wgid % nig) / gsz; u.bt = u.pn; u.ui = i; u.e = 0; u.rows = 256; return true;
    }
    __device__ __forceinline__ unsigned row_byte(const Unit&, int) const { return 0u; }
};

struct MoeOrder {
    const LAS int* utab; const LAS unsigned* rowt; int nu, ncol;
    __device__ bool next(int i, Unit& u) const {
        if (i >= nu) return false;
        u.pm = __builtin_amdgcn_readfirstlane(utab[i * 8 + 0]); u.pn = __builtin_amdgcn_readfirstlane(utab[i * 8 + 1]); u.e = __builtin_amdgcn_readfirstlane(utab[i * 8 + 2]); u.rows = __builtin_amdgcn_readfirstlane(utab[i * 8 + 3]); u.ui = i; u.bt = u.e * ncol + u.pn; return true;
    }
    __device__ __forceinline__ unsigned row_byte(const Unit& u, int r) const { return rowt[u.ui * 256 + r]; }
};

__device__ __forceinline__ unsigned cvt_pk_bf16(float lo, float hi) { unsigned r; asm volatile("v_cvt_pk_bf16_f32 %0, %1, %2" : "=v"(r) : "v"(lo), "v"(hi)); return r; }

struct EpiBf16 {
    static constexpr bool PERM = true; static constexpr int TPID = 210;
    bf16_t* O; int ldc;
    __device__ __forceinline__ void operator()(const f32x4 (&acc)[2][2][4][2], const Unit& u, int wr, int wc, int fr, int fq, const LAS unsigned char*) const {
        const int row0 = u.pm * BM + wr * 64 + fr, col0 = u.pn * BM + wc * 32 + 8 * fq;
#pragma unroll
        for (int ai = 0; ai < 2; ++ai)
#pragma unroll
            for (int m = 0; m < 4; ++m) { bf16_t* rowp = O + (size_t)(row0 + ai * HALF + m * 16) * ldc + col0;
#pragma unroll
                for (int bj = 0; bj < 2; ++bj) { const f32x4 v0 = acc[ai][bj][m][0], v1 = acc[ai][bj][m][1];
                    u32x4 w; w.x = cvt_pk_bf16(v0[0], v0[1]); w.y = cvt_pk_bf16(v0[2], v0[3]); w.z = cvt_pk_bf16(v1[0], v1[1]); w.w = cvt_pk_bf16(v1[2], v1[3]);
                    *(u32x4*)(rowp + bj * HALF) = w; } }
    }
};
struct EpiResBf16 {
    static constexpr bool PERM = true; static constexpr int TPID = 250;
    const float* base; bf16_t* out; int ldc;
    __device__ __forceinline__ void operator()(const f32x4 (&acc)[2][2][4][2], const Unit& u, int wr, int wc, int fr, int fq, const LAS unsigned char*) const {
        const int col0 = u.pn * BM + wc * 32 + 8 * fq;
#pragma unroll
        for (int ai = 0; ai < 2; ++ai)
#pragma unroll
            for (int m = 0; m < 4; ++m) { const size_t off = (size_t)(u.pm * BM + ai * HALF + wr * 64 + m * 16 + fr) * ldc + col0;
#pragma unroll
                for (int bj = 0; bj < 2; ++bj) { const f32x4 b0 = *(const f32x4*)(base + off + bj * HALF), b1 = *(const f32x4*)(base + off + bj * HALF + 4);
                    const f32x4 v0 = acc[ai][bj][m][0] + b0, v1 = acc[ai][bj][m][1] + b1;
                    u32x4 w; w.x = cvt_pk_bf16(v0[0], v0[1]); w.y = cvt_pk_bf16(v0[2], v0[3]); w.z = cvt_pk_bf16(v1[0], v1[1]); w.w = cvt_pk_bf16(v1[2], v1[3]);
                    *(u32x4*)(out + off + bj * HALF) = w; } }
    }
};
struct EpiGeglu {
    static constexpr bool PERM = true; static constexpr int TPID = 270;
    unsigned char* H;
    __device__ __forceinline__ void operator()(const f32x4 (&acc)[2][2][4][2], const Unit& u, int wr, int wc, int fr, int fq, const LAS unsigned char* lds) const {
        const int col0 = u.pn * HALF + wc * 32 + 8 * fq; const LAS float* wt = (const LAS float*)(lds + L_WT) + u.ui * 256;
#pragma unroll
        for (int ai = 0; ai < 2; ++ai)
#pragma unroll
            for (int m = 0; m < 4; ++m) { const int r = ai * HALF + wr * 64 + m * 16 + fr;
                if (r < u.rows) { const float s = wt[r] * WUNSCALE;
                    const f32x4 g0 = acc[ai][0][m][0] * s, g1 = acc[ai][0][m][1] * s, u0 = acc[ai][1][m][0] * s, u1 = acc[ai][1][m][1] * s;
                    u32x2 w;
                    w.x = pk4_fp8(gelu_tanh(g0[0]) * u0[0], gelu_tanh(g0[1]) * u0[1], gelu_tanh(g0[2]) * u0[2], gelu_tanh(g0[3]) * u0[3]);
                    w.y = pk4_fp8(gelu_tanh(g1[0]) * u1[0], gelu_tanh(g1[1]) * u1[1], gelu_tanh(g1[2]) * u1[2], gelu_tanh(g1[3]) * u1[3]);
                    *(u32x2*)(H + (size_t)(u.pm * BM + r) * 1024 + col0) = w; } }
    }
};
struct EpiScaleFp8 {
    static constexpr bool PERM = true; static constexpr int TPID = 280;
    unsigned char* Y;
    __device__ __forceinline__ void operator()(const f32x4 (&acc)[2][2][4][2], const Unit& u, int wr, int wc, int fr, int fq, const LAS unsigned char* lds) const {
        const int col0 = u.pn * BM + wc * 32 + 8 * fq; const LAS float* wt = (const LAS float*)(lds + L_WT) + u.ui * 256;
#pragma unroll
        for (int ai = 0; ai < 2; ++ai)
#pragma unroll
            for (int m = 0; m < 4; ++m) { const int r = ai * HALF + wr * 64 + m * 16 + fr;
                if (r < u.rows) { const float s = wt[r] * (WUNSCALE * YSCALE); unsigned char* rowp = Y + (size_t)(u.pm * BM + r) * 1024 + col0;
#pragma unroll
                    for (int bj = 0; bj < 2; ++bj) { const f32x4 v0 = acc[ai][bj][m][0] * s, v1 = acc[ai][bj][m][1] * s;
                        u32x2 w; w.x = pk4_fp8(v0[0], v0[1], v0[2], v0[3]); w.y = pk4_fp8(v1[0], v1[1], v1[2], v1[3]);
                        *(u32x2*)(rowp + bj * HALF) = w; } } }
    }
};

template <class Epi, class Sched, bool ALIGN_EPI, bool GATHER, bool FP8>
__device__ __forceinline__ void gemm_phase(LAS unsigned char* lds, const bf16_t* Ab, const bf16_t* Bb, const int K, const Sched& S, const Epi& E, TpAcc& T) {
    const int tid = threadIdx.x, wid = __builtin_amdgcn_readfirstlane(tid >> 6), lane = tid & 63, wr = wid >> 2, wc = wid & 3, fr = lane & 15, fq = lane >> 4;
    const int nt = K / BK;
    int Rr[2], Cc[2]; unsigned voffB[2];
#pragma unroll
    for (int i = 0; i < 2; ++i) { int R, C; stage_rc(tid * 16 + i * 8192, R, C); Rr[i] = R; Cc[i] = C; const int Rb = Epi::PERM ? ((R & ~31) + perm32(R & 31)) : R; voffB[i] = (unsigned)(Rb * K + C) * 2u; }
    const size_t kstep = (size_t)(BK * 2);
    const size_t hstep = (size_t)HALF * K * 2;
    const size_t tstep = 2 * hstep;
    const unsigned ldsw = (unsigned)wid * 1024u;
    const int aoff = lds_byte(wr * 64 + fr, fq * 8), boff = lds_byte(wc * 32 + fr, fq * 8);
#define PG8_SA(b, h) (((b) * 2 + (h)) * HTB)
#define PG8_SB(b, h) ((4 + (b) * 2 + (h)) * HTB)
#define PG8_STAGE2X(bufoff, gbase, o0, o1, AUX) do { unsigned _o0 = (o0), _o1 = (o1); asm volatile("" : "+v"(_o0), "+v"(_o1));     \
        __builtin_amdgcn_global_load_lds((const unsigned*)((const char*)(gbase) + _o0), (LAS unsigned*)(lds + (bufoff) + ldsw), 16, 0, AUX); \
        __builtin_amdgcn_global_load_lds((const unsigned*)((const char*)(gbase) + _o1), (LAS unsigned*)(lds + (bufoff) + ldsw + 8192), 16, 0, AUX); } while (0)
#define PG8_STAGE2(bufoff, gbase, o0, o1) PG8_STAGE2X(bufoff, gbase, o0, o1, 0)
#define PG8_STAGEB(bufoff, gbase) PG8_STAGE2X(bufoff, gbase, voffB[0], voffB[1], 0)
#define PG8_AH(p) (GATHER ? (p) : (p) + hstep)
#define PG8_V1(i) (GATHER ? vC[1][i] : vC[0][i])
#define PG8_LD8(p) __builtin_shufflevector(*(const LAS v4i*)(p), *(const LAS v4i*)((p) + 1024), 0, 1, 2, 3, 4, 5, 6, 7)
#define PG8_LDA(dst, b, h) do { _Pragma("unroll") for (int m = 0; m < 4; ++m) dst[m] = PG8_LD8(lds + PG8_SA(b, h) + aoff + m * 2048); } while (0)
#define PG8_LDB(dst, b, h) do { _Pragma("unroll") for (int n = 0; n < 2; ++n) dst[n] = PG8_LD8(lds + PG8_SB(b, h) + boff + n * 2048); } while (0)
#define PG8_LO(x) __builtin_bit_cast(bf16x8, __builtin_shufflevector(x, x, 0, 1, 2, 3))
#define PG8_HI(x) __builtin_bit_cast(bf16x8, __builtin_shufflevector(x, x, 4, 5, 6, 7))
#define PG8_MMA(ai, bj, At, Bt) do { __builtin_amdgcn_s_setprio(1); _Pragma("unroll") for (int m = 0; m < 4; ++m) _Pragma("unroll") for (int n = 0; n < 2; ++n) { \
        if constexpr (FP8) acc[ai][bj][m][n] = __builtin_amdgcn_mfma_scale_f32_16x16x128_f8f6f4(Bt[n], At[m], acc[ai][bj][m][n], 0, 0, 0, 0x7f7f7f7f, 0, 0x7f7f7f7f); \
        else { acc[ai][bj][m][n] = __builtin_amdgcn_mfma_f32_16x16x32_bf16(PG8_LO(Bt[n]), PG8_LO(At[m]), acc[ai][bj][m][n], 0, 0, 0); \
               acc[ai][bj][m][n] = __builtin_amdgcn_mfma_f32_16x16x32_bf16(PG8_HI(Bt[n]), PG8_HI(At[m]), acc[ai][bj][m][n], 0, 0, 0); } } __builtin_amdgcn_s_setprio(0); } while (0)
#define PG8_WAIT_V(n) asm volatile("s_waitcnt vmcnt(" #n ")" ::: "memory")
#define PG8_WAIT_L(n) asm volatile("s_waitcnt lgkmcnt(" #n ")" ::: "memory")
#define PG8_BAR __builtin_amdgcn_s_barrier()
#define PG8_SCHED __builtin_amdgcn_sched_barrier(0)
    Unit cur, nxt; int ui = 0;
    if (!S.next(0, cur)) return;
    f32x4 acc[2][2][4][2];
#pragma unroll
    for (int a = 0; a < 2; ++a)
#pragma unroll
        for (int b = 0; b < 2; ++b)
#pragma unroll
            for (int m = 0; m < 4; ++m)
#pragma unroll
                for (int n = 0; n < 2; ++n) acc[a][b][m][n] = (f32x4){0.f, 0.f, 0.f, 0.f};
    v8i At[4], B0[2], B1[2];
    unsigned vC[2][2];
#pragma unroll
    for (int h = 0; h < 2; ++h)
#pragma unroll
        for (int i = 0; i < 2; ++i) vC[h][i] = GATHER ? (S.row_byte(cur, h * HALF + Rr[i]) + (unsigned)Cc[i] * 2u) : (unsigned)(Rr[i] * K + Cc[i]) * 2u;
    const char* cA = GATHER ? (const char*)Ab : (const char*)Ab + (size_t)cur.pm * tstep; const char* cB = (const char*)Bb + (size_t)cur.bt * tstep;
    PG8_STAGEB(PG8_SB(0, 0), cB); PG8_STAGEB(PG8_SB(0, 1), cB + hstep); PG8_STAGE2(PG8_SA(0, 0), cA, vC[0][0], vC[0][1]); PG8_STAGE2(PG8_SA(0, 1), PG8_AH(cA), PG8_V1(0), PG8_V1(1));
    if (wr == 1) PG8_BAR;
    PG8_WAIT_V(2); PG8_BAR;
    PG8_STAGEB(PG8_SB(1, 0), cB + kstep); PG8_STAGE2(PG8_SA(1, 0), cA + kstep, vC[0][0], vC[0][1]); PG8_STAGEB(PG8_SB(1, 1), cB + hstep + kstep);
    PG8_WAIT_V(6); PG8_BAR;
    for (;;) {
        const bool has_next = S.next(ui + 1, nxt);
        const char* nA = has_next ? (GATHER ? (const char*)Ab : (const char*)Ab + (size_t)nxt.pm * tstep) : cA; const char* nB = has_next ? (const char*)Bb + (size_t)nxt.bt * tstep : cB;
        TPS2(T, Epi::TPID + 1);
#pragma unroll 1
        for (int t = 0; t < nt; t += 2) {
            const bool last = (t == nt - 2);
            const char* a1 = cA + (size_t)(t + 1) * kstep;
            const char* a2 = last ? nA : cA + (size_t)(t + 2) * kstep; const char* b2 = last ? nB : cB + (size_t)(t + 2) * kstep;
            const char* a3 = a2 + kstep; const char* b3 = b2 + kstep;
            PG8_LDB(B0, 0, 0); PG8_LDB(B1, 0, 1); PG8_SCHED; PG8_LDA(At, 0, 0); PG8_STAGE2(PG8_SA(1, 1), PG8_AH(a1), PG8_V1(0), PG8_V1(1));
            if constexpr (GATHER) {
                if (last && has_next) {
                    int ln_ = (int)__builtin_amdgcn_mbcnt_hi(~0u, __builtin_amdgcn_mbcnt_lo(~0u, 0u)); asm volatile("" : "+v"(ln_));
#pragma unroll
                    for (int i = 0; i < 2; ++i) { int R, C; stage_rc((wid * 64 + ln_) * 16 + i * 8192, R, C);
#pragma unroll
                        for (int h = 0; h < 2; ++h) vC[h][i] = S.row_byte(nxt, h * HALF + R) + (unsigned)C * 2u; }
                }
            }
            const unsigned w00 = vC[0][0], w01 = vC[0][1], w10 = PG8_V1(0), w11 = PG8_V1(1);
            PG8_WAIT_V(8); PG8_WAIT_L(0); PG8_BAR; PG8_MMA(0, 0, At, B0); PG8_MMA(0, 1, At, B1); PG8_BAR; PG8_SCHED;
            PG8_LDA(At, 0, 1); PG8_STAGEB(PG8_SB(0, 0), b2); PG8_STAGEB(PG8_SB(0, 1), b2 + hstep); PG8_STAGE2(PG8_SA(0, 0), a2, w00, w01);
            PG8_WAIT_V(8); PG8_WAIT_L(0); PG8_BAR; PG8_MMA(1, 0, At, B0); PG8_MMA(1, 1, At, B1); PG8_BAR; PG8_SCHED;
            PG8_LDB(B0, 1, 0); PG8_LDB(B1, 1, 1); PG8_SCHED; PG8_LDA(At, 1, 0); PG8_STAGE2(PG8_SA(0, 1), PG8_AH(a2), w10, w11);
            PG8_WAIT_V(8); PG8_WAIT_L(0); PG8_BAR; PG8_MMA(0, 0, At, B0); PG8_MMA(0, 1, At, B1); PG8_BAR; PG8_SCHED;
            PG8_LDA(At, 1, 1); PG8_STAGEB(PG8_SB(1, 0), b3); PG8_STAGEB(PG8_SB(1, 1), b3 + hstep); PG8_STAGE2(PG8_SA(1, 0), a3, w00, w01);
            PG8_WAIT_V(8); PG8_WAIT_L(0); PG8_BAR; PG8_MMA(1, 0, At, B0); PG8_MMA(1, 1, At, B1); PG8_BAR; PG8_SCHED;
        }
        TPE2(T, Epi::TPID + 1);
        if constexpr (ALIGN_EPI) { if (wr == 0) PG8_BAR; }
        TPS2(T, Epi::TPID);
        { int ln_ = (int)__builtin_amdgcn_mbcnt_hi(~0u, __builtin_amdgcn_mbcnt_lo(~0u, 0u)); asm volatile("" : "+v"(ln_));
          E(acc, cur, wr, wc, ln_ & 15, ln_ >> 4, lds); }
        asm volatile("" ::: "memory"); TPE2(T, Epi::TPID);
        if (!has_next) break;
#pragma unroll
        for (int a = 0; a < 2; ++a)
#pragma unroll
            for (int b = 0; b < 2; ++b)
#pragma unroll
                for (int m = 0; m < 4; ++m)
#pragma unroll
                    for (int n = 0; n < 2; ++n) acc[a][b][m][n] = (f32x4){0.f, 0.f, 0.f, 0.f};
        cur = nxt; cA = nA; cB = nB; ++ui;
        if constexpr (ALIGN_EPI) { if (wr == 1) PG8_BAR; }
    }
    PG8_WAIT_V(0);
    if constexpr (!ALIGN_EPI) { if (wr == 0) PG8_BAR; }
    PG8_BAR;
#undef PG8_SA
#undef PG8_SB
#undef PG8_STAGE2
#undef PG8_STAGE2X
#undef PG8_STAGEB
#undef PG8_AH
#undef PG8_V1
#undef PG8_LDA
#undef PG8_LDB
#undef PG8_MMA
#undef PG8_LD8
#undef PG8_LO
#undef PG8_HI
#undef PG8_WAIT_V
#undef PG8_WAIT_L
#undef PG8_BAR
#undef PG8_SCHED
}
}


#define XB_TMO      128
#define XB_XCNT(j)  (256  + 64 * (j))
#define XB_XSUB(j)  (1280 + 64 * (j))
#define XB_XGEN(j)  (2304 + 64 * (j))
#define XB_TOP      3328
#define XB_TOPGEN   3392
#define XCD_BAR_WORDS 3456
#define XB_SPIN_CAP (1u << 18)

__device__ __forceinline__ unsigned xb_ld(unsigned* p)              { return __hip_atomic_load(p, __ATOMIC_RELAXED, __HIP_MEMORY_SCOPE_AGENT); }
__device__ __forceinline__ unsigned xb_add(unsigned* p, unsigned v) { return __hip_atomic_fetch_add(p, v, __ATOMIC_RELAXED, __HIP_MEMORY_SCOPE_AGENT); }
__device__ __forceinline__ unsigned xb_xcc_id() { return (unsigned)__builtin_amdgcn_s_getreg((3 << 11) | 20) & 0xFu; }
#define XB_SPIN(cond, bar) do { unsigned _sp = 0; while (cond) { __builtin_amdgcn_s_sleep(1); \
    if ((++_sp & 255u) == 0u) { if (xb_ld(&(bar)[XB_TMO])) break; if (_sp > XB_SPIN_CAP) { atomicAdd(&(bar)[XB_TMO], 1u); break; } } } } while (0)

struct XcdBarrier {
    unsigned* bar; unsigned x;
    volatile LAS unsigned* st;
};
__device__ __forceinline__ XcdBarrier xcd_barrier_post(unsigned* bar, volatile LAS unsigned* st) {
    XcdBarrier b; b.bar = bar; b.x = xb_xcc_id(); b.st = st;
    if (threadIdx.x == 0) (void)xb_add(&bar[XB_XCNT(b.x)], 1u);
    return b;
}
__device__ __forceinline__ void xcd_barrier_complete(unsigned* bar, unsigned x, unsigned& nloc, unsigned& nx) {
    const unsigned G = gridDim.x * gridDim.y * gridDim.z;
    unsigned sum, cnt, mine, sp = 0u;
    for (;;) {
        sum = 0u; cnt = 0u; mine = 0u;
#pragma unroll
        for (unsigned j = 0; j < 16; ++j) { const unsigned c = xb_ld(&bar[XB_XCNT(j)]); sum += c; cnt += (c > 0u) ? 1u : 0u; mine = (j == x) ? c : mine; }
        if (sum == G) break;
        __builtin_amdgcn_s_sleep(1);
        if ((++sp & 255u) == 0u) { if (xb_ld(&bar[XB_TMO])) break; if (sp > XB_SPIN_CAP) { atomicAdd(&bar[XB_TMO], 1u); break; } }
    }
    nloc = mine > 0u ? mine : 1u; nx = cnt > 0u ? cnt : 1u;
}
__device__ __forceinline__ void xcd_barrier(const XcdBarrier& b) {
    asm volatile("s_waitcnt vmcnt(0)" ::: "memory");
    __syncthreads();
    if (threadIdx.x == 0) {
        unsigned* bar = b.bar;
        __builtin_amdgcn_s_waitcnt(0);
        unsigned nloc = b.st[0], nx = b.st[1];
        if (nloc == 0u) { xcd_barrier_complete(bar, b.x, nloc, nx); b.st[0] = nloc; b.st[1] = nx; }
        const unsigned old = xb_add(&bar[XB_XSUB(b.x)], 1u);
        const unsigned gen = old / nloc;
        if (old + 1u == (gen + 1u) * nloc) {
            __builtin_amdgcn_fence(__ATOMIC_RELEASE, "agent");
            asm volatile("s_waitcnt vmcnt(0)" ::: "memory");
            const unsigned og = xb_add(&bar[XB_TOP], 1u);
            const unsigned tg = og / nx;
            if (og + 1u == (tg + 1u) * nx) xb_add(&bar[XB_TOPGEN], 1u);
            else XB_SPIN(xb_ld(&bar[XB_TOPGEN]) == tg, bar);
            __builtin_amdgcn_fence(__ATOMIC_ACQUIRE, "agent");
            xb_add(&bar[XB_XGEN(b.x)], 1u);
            asm volatile("s_waitcnt vmcnt(0)" ::: "memory");
        } else {
            XB_SPIN(xb_ld(&bar[XB_XGEN(b.x)]) == gen, bar);
            __builtin_amdgcn_fence(__ATOMIC_ACQUIRE, "agent");
            asm volatile("s_waitcnt vmcnt(0)" ::: "memory");
        }
    }
    __syncthreads();
}

struct Args { const float* in[24]; float* out; unsigned char* ws; int ph_lo, ph_hi; };

struct Frame {
    LAS unsigned char* lds;
    unsigned* ctl;
    int tid, lane, wave, vcu, G;
    unsigned char* ws; float* out;
    unsigned long long tp0, tpd;
};
#define TPS(F, id) do { if (TP_PHASE == (id)) (F).tp0 = __builtin_amdgcn_s_memrealtime(); } while (0)
#define TPE(F, id) do { if (TP_PHASE == (id)) (F).tpd += __builtin_amdgcn_s_memrealtime() - (F).tp0; } while (0)

struct TTile { const float* src; unsigned char* dst; int Nsrc, k0, n0, orow0, fp8; };
__device__ __forceinline__ TTile p0_tile(const Args& a, unsigned char* ws, int it) {
    constexpr int I_IN = 16 * 44, I_OUT = 16 * 16, I_E = 16 * 16;
    TTile t;
    if (it < I_IN) { const int kb = it / 44, nb = it % 44; t.fp8 = 0; t.src = a.in[2]; t.dst = ws + WS_WIN; t.Nsrc = NPROJ; t.k0 = 64 * kb; t.n0 = 64 * nb; t.orow0 = 64 * nb; return t; }
    it -= I_IN;
    if (it < I_OUT) { const int kb = it >> 4, nb = it & 15; t.fp8 = 0; t.src = a.in[14]; t.dst = ws + WS_WOUT; t.Nsrc = DM; t.k0 = 64 * kb; t.n0 = 64 * nb; t.orow0 = 64 * nb; return t; }
    it -= I_OUT;
    const int e = it / (3 * I_E), w = (it / I_E) % 3, q = it % I_E, kb = q >> 4, nb = q & 15, n0 = 64 * nb;
    t.Nsrc = DM; t.k0 = 64 * kb; t.n0 = n0; t.fp8 = 1;
    if (w == 0) { t.src = a.in[20] + (size_t)e * DM * DM; t.dst = ws + WS_WGU + (size_t)e * 2048 * DM; t.orow0 = (n0 >> 7) * 256 + (n0 & 127); }
    else if (w == 1) { t.src = a.in[21] + (size_t)e * DM * DM; t.dst = ws + WS_WGU + (size_t)e * 2048 * DM; t.orow0 = (n0 >> 7) * 256 + 128 + (n0 & 127); }
    else { t.src = a.in[22] + (size_t)e * DM * DM; t.dst = ws + WS_WD + (size_t)e * DM * DM; t.orow0 = n0; }
    return t;
}
__device__ __forceinline__ void p0_load(f32x4 (&v)[16], const TTile& t, int lane) {
    int n = t.n0 + 4 * (lane & 15); n = n < t.Nsrc ? n : t.Nsrc - 4; const float* p = t.src + (size_t)(t.k0 + (lane >> 4)) * t.Nsrc + n;
#pragma unroll
    for (int i = 0; i < 16; ++i) v[i] = __builtin_nontemporal_load((const f32x4*)(p + (size_t)(4 * i) * t.Nsrc));
}
__device__ __forceinline__ void p0_store(const f32x4 (&v)[16], const TTile& t, LAS float* scr, int lane) {
    const float keep = (t.n0 + 4 * (lane & 15)) < t.Nsrc ? 1.f : 0.f;
#pragma unroll
    for (int i = 0; i < 16; ++i) { LAS float* d = scr + ((lane >> 4) + 4 * i) * 65 + 4 * (lane & 15); d[0] = v[i].x * keep; d[1] = v[i].y * keep; d[2] = v[i].z * keep; d[3] = v[i].w * keep; }
    asm volatile("s_waitcnt lgkmcnt(0)" ::: "memory");
    const int c = lane & 7;
#pragma unroll
    for (int j = 0; j < 8; ++j) { const int n = (lane >> 3) + 8 * j; const LAS float* sp = scr + (8 * c) * 65 + n;
        if (t.fp8) { u32x2 o; o.x = pk4_fp8(sp[0 * 65] * WSCALE, sp[1 * 65] * WSCALE, sp[2 * 65] * WSCALE, sp[3 * 65] * WSCALE); o.y = pk4_fp8(sp[4 * 65] * WSCALE, sp[5 * 65] * WSCALE, sp[6 * 65] * WSCALE, sp[7 * 65] * WSCALE);
            __builtin_nontemporal_store(o, (u32x2*)(t.dst + (size_t)(t.orow0 + n) * DM + t.k0 + 8 * c)); }
        else { u32x4 o; o.x = pk2(sp[0 * 65], sp[1 * 65]); o.y = pk2(sp[2 * 65], sp[3 * 65]); o.z = pk2(sp[4 * 65], sp[5 * 65]); o.w = pk2(sp[6 * 65], sp[7 * 65]);
            *(u32x4*)(t.dst + ((size_t)(t.orow0 + n) * DM + t.k0 + 8 * c) * 2) = o; } }
    asm volatile("s_waitcnt lgkmcnt(0)" ::: "memory");
}
__device__ __forceinline__ void rms_row_to_bf16(const float* xrow, const float* gain, bf16_t* orow, int lane) {
    const f32x4* xr = (const f32x4*)xrow + lane; const f32x4* gr = (const f32x4*)gain + lane;
    f32x4 v[4]; float s = 0.f;
#pragma unroll
    for (int j = 0; j < 4; ++j) { v[j] = xr[64 * j]; s += (v[j].x * v[j].x + v[j].y * v[j].y) + (v[j].z * v[j].z + v[j].w * v[j].w); }
    const float rs = frsq(wave_sum(s) * (1.f / DM) + EPS);
    unsigned long long* o8 = (unsigned long long*)orow + lane;
#pragma unroll
    for (int j = 0; j < 4; ++j) { const f32x4 g = gr[64 * j]; o8[64 * j] = (unsigned long long)pk2(v[j].x * rs * g.x, v[j].y * rs * g.y) | ((unsigned long long)pk2(v[j].z * rs * g.z, v[j].w * rs * g.w) << 32); }
}

__device__ __forceinline__ void rms_row2_to_bf16(const float* x0, const float* x1, const float* gain, bf16_t* o0, bf16_t* o1, int lane) {
    const f32x4* xa = (const f32x4*)x0 + lane; const f32x4* xb = (const f32x4*)x1 + lane; const f32x4* gr = (const f32x4*)gain + lane;
    f32x4 va[4], vb[4]; float sa = 0.f, sb = 0.f;
#pragma unroll
    for (int j = 0; j < 4; ++j) { va[j] = __builtin_nontemporal_load(xa + 64 * j); vb[j] = __builtin_nontemporal_load(xb + 64 * j); }
#pragma unroll
    for (int j = 0; j < 4; ++j) { sa += (va[j].x * va[j].x + va[j].y * va[j].y) + (va[j].z * va[j].z + va[j].w * va[j].w); sb += (vb[j].x * vb[j].x + vb[j].y * vb[j].y) + (vb[j].z * vb[j].z + vb[j].w * vb[j].w); }
    const float ra = frsq(wave_sum(sa) * (1.f / DM) + EPS), rb = frsq(wave_sum(sb) * (1.f / DM) + EPS);
    unsigned long long* pa = (unsigned long long*)o0 + lane; unsigned long long* pb = (unsigned long long*)o1 + lane;
#pragma unroll
    for (int j = 0; j < 4; ++j) { const f32x4 g = gr[64 * j];
        pa[64 * j] = (unsigned long long)pk2(va[j].x * ra * g.x, va[j].y * ra * g.y) | ((unsigned long long)pk2(va[j].z * ra * g.z, va[j].w * ra * g.w) << 32);
        pb[64 * j] = (unsigned long long)pk2(vb[j].x * rb * g.x, vb[j].y * rb * g.y) | ((unsigned long long)pk2(vb[j].z * rb * g.z, vb[j].w * rb * g.w) << 32); }
}
__device__ __forceinline__ void p0_prologue(Frame& F, const Args& a) {
    LAS float* scr = (LAS float*)(F.lds + F.wave * 16640);
    const int gw = F.vcu * NWAVES + F.wave, NGW = F.G * NWAVES;
    constexpr int NT = 16 * 44 + 16 * 16 + NEXP * 3 * 256;
    {
        f32x4 va[16], vb[16];
        int it = gw;
        TTile ta = p0_tile(a, F.ws, it < NT ? it : NT - 1), tb = ta;
        p0_load(va, ta, F.lane);
        while (it < NT) {
            int it2 = it + NGW;
            tb = p0_tile(a, F.ws, it2 < NT ? it2 : NT - 1); p0_load(vb, tb, F.lane);
            p0_store(va, ta, scr, F.lane);
            it = it2; if (it >= NT) break;
            it2 = it + NGW;
            ta = p0_tile(a, F.ws, it2 < NT ? it2 : NT - 1); p0_load(va, ta, F.lane);
            p0_store(vb, tb, scr, F.lane);
            it = it2;
        }
    }
    bf16_t* WRH = (bf16_t*)(F.ws + WS_WRT);
    for (int idx = blockIdx.x * NTHR + F.tid; idx < 48 * DM; idx += F.G * NTHR) { const int j = idx / DM, k = idx % DM; const float wv = j < 4 ? a.in[16][k * 4 + j] : (j < 36 ? a.in[18][k * 32 + (j - 4)] : 0.f); WRH[idx] = (bf16_t)f2bf(wv); }
    {
        bf16_t* WAT = (bf16_t*)(F.ws + WS_SMALL); bf16_t* WXT = WAT + 8 * 64 * 64; bf16_t* WUPT = WXT + 8 * 64 * 64;
        for (int idx = blockIdx.x * NTHR + F.tid; idx < 8 * 64 * 64; idx += F.G * NTHR) { const int h = idx >> 12, j = (idx >> 6) & 63, i = idx & 63;
            WAT[idx] = (bf16_t)f2bf(a.in[5][(h * 64 + i) * 64 + j]); WXT[idx] = (bf16_t)f2bf(a.in[7][(h * 64 + i) * 64 + j]); }
        for (int idx = blockIdx.x * NTHR + F.tid; idx < 256 * 32; idx += F.G * NTHR) { const int n = idx >> 5, k = idx & 31; WUPT[idx] = k < 16 ? (bf16_t)f2bf(a.in[11][k * 256 + n]) : (bf16_t)0; }
    }
    bf16_t* HN = (bf16_t*)(F.ws + WS_HN);
    for (int m = gw; m < NTOK; m += 2 * NGW) rms_row2_to_bf16(a.in[0] + (size_t)m * DM, a.in[0] + (size_t)(m + NGW) * DM, a.in[1], HN + (size_t)m * DM, HN + (size_t)(m + NGW) * DM, F.lane);
}

template <int KS> __device__ __forceinline__ f32x4 mma_ll(f32x4 acc, const LAS unsigned char* A, int lda, const LAS unsigned char* Bt, int ldb, int lane) {
    const LAS unsigned char* ap = A + (lane & 15) * lda + (lane >> 4) * 16; const LAS unsigned char* bp = Bt + (lane & 15) * ldb + (lane >> 4) * 16;
#pragma unroll
    for (int ks = 0; ks < KS; ++ks) acc = __builtin_amdgcn_mfma_f32_16x16x32_bf16(*(const LAS bf16x8*)(ap + ks * 64), *(const LAS bf16x8*)(bp + ks * 64), acc, 0, 0, 0);
    return acc;
}
template <int KS> __device__ __forceinline__ f32x4 mma_lg(f32x4 acc, const LAS unsigned char* A, int lda, const bf16_t* Bt, int ldb_elems, int lane) {
    const LAS unsigned char* ap = A + (lane & 15) * lda + (lane >> 4) * 16; const bf16_t* bp = Bt + (size_t)(lane & 15) * ldb_elems + (lane >> 4) * 8;
#pragma unroll
    for (int ks = 0; ks < KS; ++ks) acc = __builtin_amdgcn_mfma_f32_16x16x32_bf16(*(const LAS bf16x8*)(ap + ks * 64), *(const bf16x8*)(bp + ks * 32), acc, 0, 0, 0);
    return acc;
}
#define WAVE_LDS_FENCE() asm volatile("s_waitcnt lgkmcnt(0)" ::: "memory")
__device__ __forceinline__ float logsigmoidf_(float g) { return fminf(g, 0.f) - __logf(1.f + __expf(-fabsf(g))); }
__device__ __forceinline__ void unpack8(const u32x4 w, float (&f)[8]) { f[0] = bf2f(w.x & 0xffffu); f[1] = bf2f(w.x >> 16); f[2] = bf2f(w.y & 0xffffu); f[3] = bf2f(w.y >> 16); f[4] = bf2f(w.z & 0xffffu); f[5] = bf2f(w.z >> 16); f[6] = bf2f(w.w & 0xffffu); f[7] = bf2f(w.w >> 16); }
__device__ __forceinline__ u32x4 pack8(const float (&f)[8]) { u32x4 w; w.x = pk2(f[0], f[1]); w.y = pk2(f[2], f[3]); w.z = pk2(f[4], f[5]); w.w = pk2(f[6], f[7]); return w; }

constexpr int XS = 144;
constexpr int RG_AU = 8 * 64 * XS;
constexpr int GL_AL = 0, GL_BT = 5120, GL_T1 = 21504, GL_T2 = 30720, GL_T3 = 39936, GL_VT4 = 49152, GL_REGION = 67584;
static_assert(RG_AU + 8 * 8192 <= 143360 && 2 * GL_REGION <= 143360, "mixer LDS");

struct RgPre { bf16x8 ba0, ba1, bx0, bx1; float bias_a, bias_x, lamv, rgc; };
struct GlaPre { u32x4 al, v[4], k[2], q[2]; bf16x8 wup[4]; float bal[4]; };
template <bool FIN> __device__ __forceinline__ RgPre rg_pre(const unsigned char* ws, const Args& a, int chunk, int w, int nt, int c16, int g4) {
    const bf16_t* WAT = (const bf16_t*)(ws + WS_SMALL); const bf16_t* WXT = WAT + 8 * 64 * 64; const int ch = 64 * w + 16 * nt + c16;
    const bf16_t* wa = WAT + (size_t)ch * 64 + g4 * 8; const bf16_t* wx = WXT + (size_t)ch * 64 + g4 * 8;
    RgPre p; p.ba0 = *(const bf16x8*)wa; p.ba1 = *(const bf16x8*)(wa + 32); p.bx0 = *(const bf16x8*)wx; p.bx1 = *(const bf16x8*)(wx + 32);
    p.bias_a = a.in[6][ch]; p.bias_x = a.in[8][ch]; p.lamv = a.in[9][ch]; p.rgc = FIN ? ((const float*)(ws + WS_RGC))[(size_t)chunk * RGW + ch] : 0.f; return p;
}
template <bool FIN> __device__ __forceinline__ GlaPre gla_pre(const unsigned char* ws, const Args& a, int t0, int hh, int ht, int c16, int g4) {
    const bf16_t* PROJ = (const bf16_t*)(ws + WS_PROJ); const bf16_t* WUPT = (const bf16_t*)(ws + WS_SMALL) + 2 * 8 * 64 * 64;
    GlaPre p; asm volatile("" : "+v"(ht), "+v"(c16));
    { const int tok = (ht & 127) >> 1, half = ht & 1; p.al = *(const u32x4*)(PROJ + (size_t)(t0 + tok) * LDP + C_AL + 8 * half); }
#pragma unroll
    for (int i = 0; i < 2; ++i) { const int idx = ht + 256 * i, ec = idx >> 5, tp = idx & 31;
        p.v[2 * i] = *(const u32x4*)(PROJ + (size_t)(t0 + 2 * tp) * LDP + C_V + hh * 128 + 8 * ec); p.v[2 * i + 1] = *(const u32x4*)(PROJ + (size_t)(t0 + 2 * tp + 1) * LDP + C_V + hh * 128 + 8 * ec); }
    if (FIN) {
#pragma unroll
        for (int i = 0; i < 2; ++i) { const int idx = ht + 256 * i, tok = idx >> 3, dc = idx & 7;
            p.k[i] = *(const u32x4*)(PROJ + (size_t)(t0 + tok) * LDP + C_K + hh * 64 + 8 * dc); p.q[i] = *(const u32x4*)(PROJ + (size_t)(t0 + tok) * LDP + C_Q + hh * 64 + 8 * dc); }
    } else { const int dc = ht >> 5, tp = ht & 31;
        p.k[0] = *(const u32x4*)(PROJ + (size_t)(t0 + 2 * tp) * LDP + C_K + hh * 64 + 8 * dc); p.k[1] = *(const u32x4*)(PROJ + (size_t)(t0 + 2 * tp + 1) * LDP + C_K + hh * 64 + 8 * dc);
        p.q[0] = (u32x4){0u, 0u, 0u, 0u}; p.q[1] = p.q[0]; }
#pragma unroll
    for (int nt = 0; nt < 4; ++nt) { p.wup[nt] = *(const bf16x8*)(WUPT + (size_t)(hh * 64 + 16 * nt + c16) * 32 + g4 * 8); p.bal[nt] = a.in[12][hh * 64 + 16 * nt + c16]; }
    return p;
}
__device__ __forceinline__ void ld8f(const LAS float* p, float (&f)[8]) { const f32x4 x = *(const LAS f32x4*)p, y = *(const LAS f32x4*)(p + 4); f[0] = x.x; f[1] = x.y; f[2] = x.z; f[3] = x.w; f[4] = y.x; f[5] = y.y; f[6] = y.z; f[7] = y.w; }

template <bool FIN> __device__ __forceinline__ void mixer_chunk(Frame& F, const Args& a, const int chunk) {
    const bf16_t* PROJ = (const bf16_t*)(F.ws + WS_PROJ); bf16_t* Y = (bf16_t*)(F.ws + WS_HN);
    const int t0 = chunk * 64, nloc = chunk & 127, lane = F.lane, w = F.wave, c16 = lane & 15, g4 = lane >> 4;
    LAS unsigned char* L = F.lds;
    const int s = w >> 2, q4 = w & 3, ht = F.tid & 255;
    GlaPre gp;
    if (FIN) { TPS(F, 100); TPS(F, 110); } else { TPS(F, 120); TPS(F, 130); }
    {
        LAS unsigned char* slab = L + w * (64 * XS);
        LAS float* au_a = (LAS float*)(L + RG_AU + w * 8192); LAS float* au_u = au_a + 1024;
        const int cg = lane & 7, gq = lane >> 3, ch0 = 64 * w + 8 * cg;
        u32x4 xrow[11];
#pragma unroll
        for (int r = 0; r < 11; ++r) { const int tl = nloc * 64 + 8 * gq - 3 + r; xrow[r] = (tl >= 0) ? *(const u32x4*)(PROJ + (size_t)(t0 + 8 * gq - 3 + r) * LDP + C_XR + ch0) : (u32x4){0u, 0u, 0u, 0u}; }
        f32x4 cwv[4][2], cbv[2];
#pragma unroll
        for (int j = 0; j < 4; ++j) { cwv[j][0] = *(const f32x4*)(a.in[3] + j * RGW + ch0); cwv[j][1] = *(const f32x4*)(a.in[3] + j * RGW + ch0 + 4); }
        cbv[0] = *(const f32x4*)(a.in[4] + ch0); cbv[1] = *(const f32x4*)(a.in[4] + ch0 + 4);
        RgPre cur = rg_pre<FIN>(F.ws, a, chunk, w, 0, c16, g4);
#pragma unroll
        for (int it = 0; it < 8; ++it) {
            float xc[8] = {cbv[0].x, cbv[0].y, cbv[0].z, cbv[0].w, cbv[1].x, cbv[1].y, cbv[1].z, cbv[1].w};
#pragma unroll
            for (int j = 0; j < 4; ++j) { float xv[8]; unpack8(xrow[it + j], xv);
                xc[0] += cwv[j][0].x * xv[0]; xc[1] += cwv[j][0].y * xv[1]; xc[2] += cwv[j][0].z * xv[2]; xc[3] += cwv[j][0].w * xv[3];
                xc[4] += cwv[j][1].x * xv[4]; xc[5] += cwv[j][1].y * xv[5]; xc[6] += cwv[j][1].z * xv[6]; xc[7] += cwv[j][1].w * xv[7]; }
            *(LAS u32x4*)(slab + (8 * gq + it) * XS + cg * 16) = pack8(xc);
        }
        u32x4 yrv[8]; f32x4 gnv[2];
        if (FIN) {
#pragma unroll
            for (int i = 0; i < 8; ++i) yrv[i] = *(const u32x4*)(PROJ + (size_t)(t0 + 8 * w + i) * LDP + C_YR + 8 * lane);
            gnv[0] = *(const f32x4*)(a.in[10] + 8 * lane); gnv[1] = *(const f32x4*)(a.in[10] + 8 * lane + 4);
        }
        WAVE_LDS_FENCE();
        bf16x8 af[4][2];
#pragma unroll
        for (int mt = 0; mt < 4; ++mt)
#pragma unroll
            for (int ks = 0; ks < 2; ++ks) af[mt][ks] = *(const LAS bf16x8*)(slab + (16 * mt + c16) * XS + ks * 64 + g4 * 16);
        float* RGSA = (float*)(F.ws + WS_RGSA); float* RGSH = (float*)(F.ws + WS_RGSH);
        if (FIN) { TPE(F, 100); TPS(F, 101); } else { TPE(F, 120); TPS(F, 121); }
#pragma unroll 1
        for (int nt = 0; nt < 4; ++nt) {
            const RgPre nxt = rg_pre<FIN>(F.ws, a, chunk, w, nt < 3 ? nt + 1 : 3, c16, g4);
            const int ch = 64 * w + 16 * nt + c16;
            const float sp8 = 8.f * log1pf(__expf(-cur.lamv));
            float xcq[4][4];
#pragma unroll
            for (int mt = 0; mt < 4; ++mt)
#pragma unroll
                for (int r = 0; r < 4; ++r) xcq[mt][r] = bf2f(*(const LAS unsigned short*)(slab + (16 * mt + 4 * g4 + r) * XS + (16 * nt + c16) * 2));
#pragma unroll
            for (int mt = 0; mt < 4; ++mt) {
                f32x4 R = {0.f, 0.f, 0.f, 0.f}, I = {0.f, 0.f, 0.f, 0.f};
                R = __builtin_amdgcn_mfma_f32_16x16x32_bf16(af[mt][0], cur.ba0, R, 0, 0, 0); R = __builtin_amdgcn_mfma_f32_16x16x32_bf16(af[mt][1], cur.ba1, R, 0, 0, 0);
                I = __builtin_amdgcn_mfma_f32_16x16x32_bf16(af[mt][0], cur.bx0, I, 0, 0, 0); I = __builtin_amdgcn_mfma_f32_16x16x32_bf16(af[mt][1], cur.bx1, I, 0, 0, 0);
#pragma unroll
                for (int r = 0; r < 4; ++r) { const int tok = 16 * mt + 4 * g4 + r;
                    const float rr = sigmoidf_(R[r] + cur.bias_a), ii = sigmoidf_(I[r] + cur.bias_x);
                    const float x2 = -2.f * sp8 * rr;
                    const float av = __expf(0.5f * x2);
                    const float om = (x2 > -0.1f) ? -x2 * (1.f + x2 * (0.5f + x2 * (0.16666667f + x2 * 0.041666668f))) : 1.f - __expf(x2);
                    const float xcv = xcq[mt][r];
                    au_a[tok * 16 + c16] = av; au_u[tok * 16 + c16] = __builtin_amdgcn_sqrtf(om) * (ii * xcv); }
            }
            WAVE_LDS_FENCE();
            {
                float av[16], uv[16]; float P = 1.f, H = 0.f;
#pragma unroll
                for (int i = 0; i < 16; ++i) { av[i] = au_a[(16 * g4 + i) * 16 + c16]; uv[i] = au_u[(16 * g4 + i) * 16 + c16]; }
#pragma unroll
                for (int i = 0; i < 16; ++i) { H = av[i] * H + uv[i]; P *= av[i]; }
                float hin = cur.rgc, Pall = 1.f;
#pragma unroll
                for (int j = 0; j < 4; ++j) { const float Pj = __shfl(P, c16 + 16 * j), Hj = __shfl(H, c16 + 16 * j); if (j < g4) hin = Pj * hin + Hj; Pall *= Pj; }
                if (FIN) { float h = hin;
#pragma unroll
                    for (int i = 0; i < 16; ++i) { h = av[i] * h + uv[i]; *(LAS unsigned short*)(slab + (16 * g4 + i) * XS + (16 * nt + c16) * 2) = (unsigned short)f2bf(h); } }
                else if (g4 == 3) { RGSA[(size_t)chunk * RGW + ch] = Pall; RGSH[(size_t)chunk * RGW + ch] = P * hin + H; }
            }
            WAVE_LDS_FENCE();
            cur = nxt;
        }
        if (FIN) { TPE(F, 101); TPS(F, 102); } else { TPE(F, 121); }
        gp = gla_pre<FIN>(F.ws, a, t0, s, ht, c16, g4);
        if (FIN) {
            __syncthreads();
            int lq = lane; asm volatile("" : "+v"(lq));
#pragma unroll 2
            for (int i = 0; i < 8; ++i) { const int tok = 8 * w + i;
                float hv[8], yv[8]; unpack8(*(const LAS u32x4*)(L + (lq >> 3) * (64 * XS) + tok * XS + (lq & 7) * 16), hv); unpack8(yrv[i], yv);
                float ss = 0.f;
#pragma unroll
                for (int j = 0; j < 8; ++j) { hv[j] *= gelu_tanh(yv[j]); ss += hv[j] * hv[j]; }
                const float rs = frsq(wave_sum(ss) * (1.f / 512.f) + EPS);
                hv[0] *= rs * gnv[0].x; hv[1] *= rs * gnv[0].y; hv[2] *= rs * gnv[0].z; hv[3] *= rs * gnv[0].w; hv[4] *= rs * gnv[1].x; hv[5] *= rs * gnv[1].y; hv[6] *= rs * gnv[1].z; hv[7] *= rs * gnv[1].w;
                *(u32x4*)(Y + (size_t)(t0 + tok) * DM + 8 * lq) = pack8(hv); }
        }
        __syncthreads();
    }
    if (FIN) { TPE(F, 102); TPE(F, 110); TPS(F, 103); } else { TPE(F, 130); TPS(F, 123); }
    bf16_t* KVT = (bf16_t*)(F.ws + WS_KVT); float* DEC = (float*)(F.ws + WS_DEC); const bf16_t* ST = (const bf16_t*)(F.ws + WS_ST);
#pragma unroll
    for (int pass = 0; pass < 2; ++pass) {
        const int hh = 2 * pass + s;
        LAS unsigned char* R = L + s * GL_REGION;
        LAS float* BT = (LAS float*)(R + GL_BT);
        LAS unsigned char* VT = R + (FIN ? GL_VT4 : GL_T2);
        if (FIN) TPS(F, 140);
        if (ht < 128) { const int tok = ht >> 1, half = ht & 1; *(LAS u32x4*)(R + GL_AL + tok * 80 + half * 16) = gp.al; *(LAS u32x4*)(R + GL_AL + tok * 80 + 32 + half * 16) = (u32x4){0u, 0u, 0u, 0u}; }
#pragma unroll
        for (int i = 0; i < 2; ++i) { const int idx = ht + 256 * i, ec = idx >> 5, tp = idx & 31; const u32x4 v0 = gp.v[2 * i], v1 = gp.v[2 * i + 1];
            LAS unsigned* vt = (LAS unsigned*)(VT + (8 * ec) * XS + tp * 4);
            vt[0 * (XS / 4)] = (v0.x & 0xffffu) | (v1.x << 16); vt[1 * (XS / 4)] = (v0.x >> 16) | (v1.x & 0xffff0000u); vt[2 * (XS / 4)] = (v0.y & 0xffffu) | (v1.y << 16); vt[3 * (XS / 4)] = (v0.y >> 16) | (v1.y & 0xffff0000u);
            vt[4 * (XS / 4)] = (v0.z & 0xffffu) | (v1.z << 16); vt[5 * (XS / 4)] = (v0.z >> 16) | (v1.z & 0xffff0000u); vt[6 * (XS / 4)] = (v0.w & 0xffffu) | (v1.w << 16); vt[7 * (XS / 4)] = (v0.w >> 16) | (v1.w & 0xffff0000u); }
        __syncthreads();
        if (FIN) { TPE(F, 140); TPS(F, 141); }
        { const bf16x8 afr = *(const LAS bf16x8*)(R + GL_AL + (16 * q4 + c16) * 80 + g4 * 16);
#pragma unroll
          for (int nt = 0; nt < 4; ++nt) { f32x4 acc = {0.f, 0.f, 0.f, 0.f}; acc = __builtin_amdgcn_mfma_f32_16x16x32_bf16(afr, gp.wup[nt], acc, 0, 0, 0);
#pragma unroll
            for (int r = 0; r < 4; ++r) BT[(16 * q4 + 4 * g4 + r) * 64 + 16 * nt + c16] = logsigmoidf_(acc[r] + gp.bal[nt]) * (1.f / 16.f); } }
        __syncthreads();
        if (FIN) { TPE(F, 141); TPS(F, 142); }
        if (q4 == 0) { float cv[64];
#pragma unroll
            for (int tok = 0; tok < 64; ++tok) cv[tok] = BT[tok * 64 + lane];
#pragma unroll
            for (int tok = 1; tok < 64; ++tok) cv[tok] += cv[tok - 1];
#pragma unroll
            for (int tok = 0; tok < 64; ++tok) BT[tok * 64 + lane] = cv[tok]; }
        bf16x8 stf[8][2]; u32x4 gv4[4]; float gnl[8];
        if (FIN) { int htq = ht, c16q = c16; asm volatile("" : "+v"(htq), "+v"(c16q));
            const bf16_t* st = ST + (size_t)(chunk * 4 + hh) * 128 * 64;
#pragma unroll
            for (int nt = 0; nt < 8; ++nt) { stf[nt][0] = *(const bf16x8*)(st + (size_t)(16 * nt + c16q) * 64 + g4 * 8); stf[nt][1] = *(const bf16x8*)(st + (size_t)(16 * nt + c16q) * 64 + g4 * 8 + 32); gnl[nt] = a.in[13][16 * nt + c16q]; }
#pragma unroll
            for (int i = 0; i < 4; ++i) { const int idx = htq + 256 * i, tok = idx >> 4, ec = idx & 15; gv4[i] = *(const u32x4*)(PROJ + (size_t)(t0 + tok) * LDP + C_G + hh * 128 + 8 * ec); } }
        __syncthreads();
        if (FIN) { TPE(F, 142); TPS(F, 143); }
        if (!FIN) { const int dc = ht >> 5, tp = ht & 31;
            float b0[8], b1[8], bl[8], k0[8], k1[8]; ld8f(BT + (2 * tp) * 64 + 8 * dc, b0); ld8f(BT + (2 * tp + 1) * 64 + 8 * dc, b1); ld8f(BT + 63 * 64 + 8 * dc, bl); unpack8(gp.k[0], k0); unpack8(gp.k[1], k1);
            LAS unsigned* ke = (LAS unsigned*)(R + GL_T1 + (8 * dc) * XS + tp * 4);
#pragma unroll
            for (int j = 0; j < 8; ++j) ke[j * (XS / 4)] = pk2(k0[j] * __expf(bl[j] - b0[j]), k1[j] * __expf(bl[j] - b1[j]));
            if (ht < 64) DEC[(size_t)(chunk * 4 + hh) * 64 + ht] = __expf(BT[63 * 64 + ht]);
        } else {
#pragma unroll
            for (int i = 0; i < 2; ++i) { const int idx = ht + 256 * i, tok = idx >> 3, dc = idx & 7;
                float bv[8], kv[8], qv[8]; ld8f(BT + tok * 64 + 8 * dc, bv); unpack8(gp.k[i], kv); unpack8(gp.q[i], qv);
#pragma unroll
                for (int j = 0; j < 8; ++j) { const float eb = __expf(bv[j]); qv[j] *= 0.125f * eb; kv[j] *= __expf(-bv[j]); }
                *(LAS u32x4*)(R + GL_T1 + tok * XS + dc * 16) = pack8(qv); *(LAS u32x4*)(R + GL_T2 + tok * XS + dc * 16) = pack8(kv); }
        }
        if (pass == 0) gp = gla_pre<FIN>(F.ws, a, t0, 2 + s, ht, c16, g4);
        __syncthreads();
        if (FIN) { TPE(F, 143); TPS(F, 144); }
        if (FIN) TPS(F, 105);
        if (!FIN) {
#pragma unroll
            for (int mi = 0; mi < 2; ++mi) { const int mt = 2 * q4 + mi;
#pragma unroll
                for (int nt = 0; nt < 4; ++nt) { f32x4 acc = {0.f, 0.f, 0.f, 0.f}; acc = mma_ll<2>(acc, VT + (16 * mt) * XS, XS, R + GL_T1 + (16 * nt) * XS, XS, lane);
#pragma unroll
                    for (int r = 0; r < 4; ++r) KVT[((size_t)(chunk * 4 + hh) * 128 + 16 * mt + 4 * g4 + r) * 64 + 16 * nt + c16] = (bf16_t)f2bf(acc[r]); } }
        } else {
#pragma unroll
            for (int nt = 0; nt < 4; ++nt) { f32x4 acc = {0.f, 0.f, 0.f, 0.f}; acc = mma_ll<2>(acc, R + GL_T2 + (16 * q4) * XS, XS, R + GL_T1 + (16 * nt) * XS, XS, lane);
                const int i = 16 * nt + c16, j0 = 16 * q4 + 4 * g4;
                u32x2 pw; pw.x = pk2(j0 <= i ? acc[0] : 0.f, j0 + 1 <= i ? acc[1] : 0.f); pw.y = pk2(j0 + 2 <= i ? acc[2] : 0.f, j0 + 3 <= i ? acc[3] : 0.f);
                *(LAS u32x2*)(R + GL_T3 + i * XS + j0 * 2) = pw; }
            __syncthreads();
            if (FIN) { TPE(F, 144); TPS(F, 145); }
            f32x4 o[8];
            { const bf16x8 qa0 = *(const LAS bf16x8*)(R + GL_T1 + (16 * q4 + c16) * XS + g4 * 16), qa1 = *(const LAS bf16x8*)(R + GL_T1 + (16 * q4 + c16) * XS + 64 + g4 * 16);
#pragma unroll
              for (int nt = 0; nt < 8; ++nt) { f32x4 acc = {0.f, 0.f, 0.f, 0.f};
                acc = mma_ll<2>(acc, R + GL_T3 + (16 * q4) * XS, XS, VT + (16 * nt) * XS, XS, lane);
                acc = __builtin_amdgcn_mfma_f32_16x16x32_bf16(qa0, stf[nt][0], acc, 0, 0, 0); acc = __builtin_amdgcn_mfma_f32_16x16x32_bf16(qa1, stf[nt][1], acc, 0, 0, 0);
                o[nt] = acc; } }
            float rs[4];
#pragma unroll
            for (int r = 0; r < 4; ++r) { float ss = 0.f;
#pragma unroll
                for (int nt = 0; nt < 8; ++nt) ss += o[nt][r] * o[nt][r];
                ss += __shfl_xor(ss, 1); ss += __shfl_xor(ss, 2); ss += __shfl_xor(ss, 4); ss += __shfl_xor(ss, 8);
                rs[r] = frsq(ss * (1.f / 128.f) + EPS); }
            LAS unsigned short* OY = (LAS unsigned short*)(R + GL_BT);
#pragma unroll
            for (int nt = 0; nt < 8; ++nt)
#pragma unroll
                for (int r = 0; r < 4; ++r) OY[(16 * q4 + 4 * g4 + r) * 128 + 16 * nt + c16] = (unsigned short)f2bf(o[nt][r] * rs[r] * gnl[nt]);
            __syncthreads();
            if (FIN) { TPE(F, 145); TPS(F, 146); }
            int hts = ht; asm volatile("" : "+v"(hts));
#pragma unroll
            for (int i = 0; i < 4; ++i) { const int idx = hts + 256 * i, tok = idx >> 4, ec = idx & 15;
                float ov[8], gv[8]; unpack8(*(const LAS u32x4*)(OY + tok * 128 + 8 * ec), ov); unpack8(gv4[i], gv);
#pragma unroll
                for (int j = 0; j < 8; ++j) ov[j] *= gv[j] * sigmoidf_(gv[j]);
                *(u32x4*)(Y + (size_t)(t0 + tok) * DM + 512 + hh * 128 + 8 * ec) = pack8(ov); }
        }
        __syncthreads();
        if (FIN) TPE(F, 146);
        if (FIN) TPE(F, 105);
    }
    if (FIN) TPE(F, 103); else TPE(F, 123);
}

__device__ __forceinline__ void m3_scan(Frame& F) {
    const bf16_t* KVT = (const bf16_t*)(F.ws + WS_KVT); const float* DEC = (const float*)(F.ws + WS_DEC); bf16_t* ST = (bf16_t*)(F.ws + WS_ST);
    const float* RGSA = (const float*)(F.ws + WS_RGSA); const float* RGSH = (const float*)(F.ws + WS_RGSH); float* RGC = (float*)(F.ws + WS_RGC);
    const int bx = blockIdx.x;
    if (F.tid < 256) {
        for (int id = bx * 256 + F.tid; id < 65536; id += F.G * 256) {
            const int d = id & 63, e = (id >> 6) & 127, bh = id >> 13, b = bh >> 2, hh = bh & 3;
            float sv = 0.f;
            for (int n = 0; n < 128; n += 16) {
                float kv[16], dc[16];
#pragma unroll
                for (int q = 0; q < 16; ++q) { const size_t ch = (size_t)((b * 128 + n + q) * 4 + hh); kv[q] = bf2f(__builtin_nontemporal_load(KVT + (ch * 128 + e) * 64 + d)); dc[q] = DEC[ch * 64 + d]; }
#pragma unroll
                for (int q = 0; q < 16; ++q) { const size_t ch = (size_t)((b * 128 + n + q) * 4 + hh); ST[(ch * 128 + e) * 64 + d] = (bf16_t)f2bf(sv); sv = dc[q] * sv + kv[q]; }
            }
        }
    } else if (bx < 4) {
        const int id = bx * 256 + (F.tid - 256), b = id >> 9, ch = id & 511;
        float h = 0.f;
        for (int n = 0; n < 128; n += 16) {
            float av[16], hv[16];
#pragma unroll
            for (int q = 0; q < 16; ++q) { const size_t o = (size_t)(b * 128 + n + q) * RGW + ch; av[q] = RGSA[o]; hv[q] = RGSH[o]; }
#pragma unroll
            for (int q = 0; q < 16; ++q) { const size_t o = (size_t)(b * 128 + n + q) * RGW + ch; RGC[o] = h; h = av[q] * h + hv[q]; }
        }
    }
}

__device__ __forceinline__ void p6_router(Frame& F, const Args& a) {
    const bf16_t* Hb = (const bf16_t*)(F.ws + WS_HB); unsigned char* HN8 = F.ws + WS_HN; const bf16_t* WRH = (const bf16_t*)(F.ws + WS_WRT);
    const float* gain = a.in[15]; const float* bg = a.in[17]; const float* be = a.in[19];
    int* STOK = (int*)(F.ws + WS_STOK); float* SW = (float*)(F.ws + WS_SW); int* TIDX = (int*)(F.ws + WS_TIDX); float* RS = (float*)(F.ws + WS_RS);
    unsigned* gcnt = F.ctl + CW_GCNT;
    LAS float* part = (LAS float*)F.lds;
    LAS float* ssp = part + 8 * 64 * 48;
    LAS int* lcnt = (LAS int*)(ssp + 512); LAS int* lbase = lcnt + 32; LAS int* rec_e = lbase + 32; LAS int* rec_l = rec_e + 128; LAS float* rec_w = (LAS float*)(rec_l + 128);
    const int lane = F.lane, c16 = lane & 15, g4 = lane >> 4, kq = F.wave;
    for (int grp = blockIdx.x; grp < NTOK / 64; grp += F.G) {
        if (F.tid < 32) lcnt[F.tid] = 0;
        TPS(F, 160);
        for (int rep = 0; rep < 1 + (int)((REP_MASK >> 6) & 1u); ++rep) {
            if (rep) __syncthreads();
            bf16x8 wh[4][3]; f32x4 gk[4][2]; u32x4 hq[4], hn[4];
#pragma unroll
            for (int ks = 0; ks < 4; ++ks) hq[ks] = *(const u32x4*)(Hb + (size_t)(grp * 64 + c16) * DM + 128 * kq + 32 * ks + 8 * g4);
#pragma unroll
            for (int ks = 0; ks < 4; ++ks) { const int k0 = 128 * kq + 32 * ks + 8 * g4; gk[ks][0] = *(const f32x4*)(gain + k0); gk[ks][1] = *(const f32x4*)(gain + k0 + 4);
#pragma unroll
                for (int nt = 0; nt < 3; ++nt) wh[ks][nt] = *(const bf16x8*)(WRH + (size_t)(16 * nt + c16) * DM + k0); }
#pragma unroll 1
            for (int mt = 0; mt < 4; ++mt) {
                int c16 = lane & 15, g4 = lane >> 4; asm volatile("" : "+v"(c16), "+v"(g4));
                const int t = grp * 64 + 16 * mt + c16;
                { const int mn = mt < 3 ? mt + 1 : 3;
#pragma unroll
                  for (int ks = 0; ks < 4; ++ks) hn[ks] = *(const u32x4*)(Hb + (size_t)(grp * 64 + 16 * mn + c16) * DM + 128 * kq + 32 * ks + 8 * g4); }
                f32x4 acc[3] = {{0.f, 0.f, 0.f, 0.f}, {0.f, 0.f, 0.f, 0.f}, {0.f, 0.f, 0.f, 0.f}}; float ss = 0.f;
#pragma unroll
                for (int ks = 0; ks < 4; ++ks) {
                    const int k0 = 128 * kq + 32 * ks + 8 * g4; const f32x4 g0 = gk[ks][0], g1 = gk[ks][1]; float hf[8]; unpack8(hq[ks], hf);
                    ss += (hf[0] * hf[0] + hf[1] * hf[1]) + (hf[2] * hf[2] + hf[3] * hf[3]) + (hf[4] * hf[4] + hf[5] * hf[5]) + (hf[6] * hf[6] + hf[7] * hf[7]);
                    float v[8] = {hf[0] * g0.x, hf[1] * g0.y, hf[2] * g0.z, hf[3] * g0.w, hf[4] * g1.x, hf[5] * g1.y, hf[6] * g1.z, hf[7] * g1.w};
                    bf16x8 ahi, alo;
#pragma unroll
                    for (int j = 0; j < 8; ++j) { const unsigned hi = f2bf(v[j]); ahi[j] = (short)hi; alo[j] = (short)f2bf(v[j] - bf2f(hi)); }
                    { u32x2 p8; p8.x = pk4_fp8(v[0], v[1], v[2], v[3]); p8.y = pk4_fp8(v[4], v[5], v[6], v[7]); *(u32x2*)(HN8 + (size_t)t * DM + k0) = p8; }
#pragma unroll
                    for (int nt = 0; nt < 3; ++nt) {
                        acc[nt] = __builtin_amdgcn_mfma_f32_16x16x32_bf16(ahi, wh[ks][nt], acc[nt], 0, 0, 0); acc[nt] = __builtin_amdgcn_mfma_f32_16x16x32_bf16(alo, wh[ks][nt], acc[nt], 0, 0, 0); }
                }
                ss += __shfl_xor(ss, 16); ss += __shfl_xor(ss, 32);
                if (g4 == 0) ssp[kq * 64 + 16 * mt + c16] = ss;
#pragma unroll
                for (int nt = 0; nt < 3; ++nt)
#pragma unroll
                    for (int r = 0; r < 4; ++r) part[(kq * 64 + 16 * mt + 4 * g4 + r) * 48 + 16 * nt + c16] = acc[nt][r];
#pragma unroll
                for (int ks = 0; ks < 4; ++ks) hq[ks] = hn[ks];
            }
        }
        __syncthreads();
        TPE(F, 160); TPS(F, 161);
        if (F.tid < 64) {
            const int tl = F.tid, t = grp * 64 + tl;
            float ssq = 0.f;
#pragma unroll
            for (int q = 0; q < 8; ++q) ssq += ssp[q * 64 + tl];
            const float rs = frsq(ssq * (1.f / DM) + EPS);
            RS[t] = rs;
            float lg[36];
#pragma unroll
            for (int o = 0; o < 36; ++o) lg[o] = 0.f;
#pragma unroll 1
            for (int q = 0; q < 8; ++q) { const LAS float* pp = part + (q * 64 + tl) * 48;
#pragma unroll
                for (int o = 0; o < 36; ++o) lg[o] += pp[o]; }
#pragma unroll
            for (int o = 0; o < 36; ++o) lg[o] *= rs;
            float gl[4];
#pragma unroll
            for (int q = 0; q < 4; ++q) gl[q] = lg[q] + bg[q];
            int gi = 0; float gm = gl[0];
#pragma unroll
            for (int q = 1; q < 4; ++q) if (gl[q] > gm) { gm = gl[q]; gi = q; }
            float gs = 0.f;
#pragma unroll
            for (int q = 0; q < 4; ++q) gs += expf(gl[q] - gm);
            const float gwt = 1.f / gs;
            float le[8];
#pragma unroll
            for (int q = 0; q < 8; ++q) { float x = lg[4 + q] + be[q];
#pragma unroll
                for (int g2 = 1; g2 < 4; ++g2) x = (gi == g2) ? (lg[4 + g2 * 8 + q] + be[g2 * 8 + q]) : x;
                le[q] = x; }
            int i1 = 0; float m1 = le[0];
#pragma unroll
            for (int q = 1; q < 8; ++q) if (le[q] > m1) { m1 = le[q]; i1 = q; }
            int i2 = -1; float m2 = -3.0e38f;
#pragma unroll
            for (int q = 0; q < 8; ++q) if (q != i1 && le[q] > m2) { m2 = le[q]; i2 = q; }
            const float e2 = expf(m2 - m1), inv = 1.f / (1.f + e2);
            const int ea = gi * 8 + i1, eb = gi * 8 + i2;
            const int la_ = __hip_atomic_fetch_add(lcnt + ea, 1, __ATOMIC_RELAXED, __HIP_MEMORY_SCOPE_WORKGROUP), lb_ = __hip_atomic_fetch_add(lcnt + eb, 1, __ATOMIC_RELAXED, __HIP_MEMORY_SCOPE_WORKGROUP);
            rec_e[tl * 2] = ea; rec_l[tl * 2] = la_; rec_w[tl * 2] = gwt * inv; rec_e[tl * 2 + 1] = eb; rec_l[tl * 2 + 1] = lb_; rec_w[tl * 2 + 1] = gwt * e2 * inv;
        }
        __syncthreads();
        TPE(F, 161); TPS(F, 162);
        if (F.tid < 32) { const int cnum = lcnt[F.tid]; lbase[F.tid] = cnum ? (int)__hip_atomic_fetch_add(gcnt + F.tid, (unsigned)cnum, __ATOMIC_RELAXED, __HIP_MEMORY_SCOPE_AGENT) : 0; }
        __syncthreads();
        if (F.tid < 128) { const int e = rec_e[F.tid], idx = e * CAP + lbase[e] + rec_l[F.tid], t = grp * 64 + (F.tid >> 1);
            STOK[idx] = t; SW[idx] = rec_w[F.tid]; TIDX[t * 2 + (F.tid & 1)] = idx; }
        __syncthreads();
        TPE(F, 162);
    }
}

__device__ __forceinline__ int moe_setup(Frame& F, int ncol_log2, bool tables, bool scale_is_rs) {
    const unsigned* gcnt = F.ctl + CW_GCNT;
    LAS int* lcnt = (LAS int*)(F.lds + L_CNT); LAS int* tst = (LAS int*)(F.lds + L_TST); LAS int* utab = (LAS int*)(F.lds + L_UTAB);
    LAS unsigned* rowt = (LAS unsigned*)(F.lds + L_ROWT); LAS float* wt = (LAS float*)(F.lds + L_WT);
    const int* STOK = (const int*)(F.ws + WS_STOK); const float* SW = (const float*)(F.ws + WS_SW); const float* RS = (const float*)(F.ws + WS_RS);
    if (F.tid < 32) lcnt[F.tid] = (int)__hip_atomic_load(gcnt + F.tid, __ATOMIC_RELAXED, __HIP_MEMORY_SCOPE_AGENT);
    __syncthreads();
    if (F.tid == 0) { int s = 0; for (int e = 0; e < 32; ++e) { tst[e] = s; s += (lcnt[e] + 255) >> 8; } tst[32] = s; }
    __syncthreads();
    if (!tables) return 0;
    const int total = tst[32] << ncol_log2;
    int nu = 0;
    for (int ui = 0; ui < MAXU; ++ui) if (ui * F.G + F.vcu < total) ++nu;
    if (F.tid < nu) { const int ui = F.tid, Lq = ui * F.G + F.vcu, rb = Lq >> ncol_log2, pn = Lq & ((1 << ncol_log2) - 1);
        int e = 0;
        for (int j = 1; j < 32; ++j) e += (tst[j] <= rb) ? 1 : 0;
        const int r0 = (rb - tst[e]) * 256; int rows = lcnt[e] - r0; rows = rows > 256 ? 256 : rows;
        utab[ui * 8 + 0] = rb; utab[ui * 8 + 1] = pn; utab[ui * 8 + 2] = e; utab[ui * 8 + 3] = rows; utab[ui * 8 + 4] = r0; }
    __syncthreads();
    constexpr int NE = MAXU / 2;
    int tok[NE], idx[NE]; bool ok[NE]; float sc[NE];
#pragma unroll
    for (int j = 0; j < NE; ++j) { const int ent = F.tid + 512 * j, ui = ent >> 8, r = ent & 255; ok[j] = false; tok[j] = 0; idx[j] = 0;
        if (ui < nu) { const int e = utab[ui * 8 + 2], rows = utab[ui * 8 + 3], r0 = utab[ui * 8 + 4]; ok[j] = r < rows; idx[j] = e * CAP + r0 + r; } }
#pragma unroll
    for (int j = 0; j < NE; ++j) { tok[j] = ok[j] ? STOK[idx[j]] : 0; sc[j] = (ok[j] && !scale_is_rs) ? SW[idx[j]] : 0.f; }
    if (scale_is_rs) {
#pragma unroll
        for (int j = 0; j < NE; ++j) sc[j] = ok[j] ? RS[tok[j]] : 0.f;
    }
#pragma unroll
    for (int j = 0; j < NE; ++j) { const int ent = F.tid + 512 * j; if ((ent >> 8) < nu) { rowt[ent] = (unsigned)tok[j] * (unsigned)DM;     wt[ent] = sc[j]; } }
    __syncthreads();
    return nu;
}

__device__ __forceinline__ void p9_final(Frame& F, const Args& a) {
    const LAS int* tst = (const LAS int*)(F.lds + L_TST);
    const int* TIDX = (const int*)(F.ws + WS_TIDX); const unsigned char* YB = F.ws + WS_YB; const bf16_t* HB = (const bf16_t*)(F.ws + WS_HB); const float* gain = a.in[23];
    const int gw = F.vcu * NWAVES + F.wave, NGW = F.G * NWAVES, lane = F.lane;
    const f32x4* gr = (const f32x4*)gain + lane;
    f32x4 gq[4];
#pragma unroll
    for (int q = 0; q < 4; ++q) gq[q] = gr[64 * q];
    for (int tb = gw; tb < NTOK; tb += 8 * NGW) {
        int myidx = 0; { const int t = tb + NGW * (lane >> 1); if (lane < 16 && t < NTOK) myidx = TIDX[t * 2 + (lane & 1)]; }
        const int mys = tst[myidx >> 14] * 256 + (myidx & (CAP - 1));
#pragma unroll 1
        for (int jp = 0; jp < 8; jp += 2) {
            const int ta = tb + NGW * jp, tc = ta + NGW; if (ta >= NTOK) break;
            const bool two = tc < NTOK;
            const size_t sa1 = (size_t)__shfl(mys, 2 * jp), sa2 = (size_t)__shfl(mys, 2 * jp + 1), sc1 = (size_t)__shfl(mys, 2 * jp + 2), sc2 = (size_t)__shfl(mys, 2 * jp + 3);
            f32x4* xa = (f32x4*)(F.out + (size_t)ta * DM) + lane; f32x4* xc = (f32x4*)(F.out + (size_t)(two ? tc : ta) * DM) + lane;
            const u32x2* ha = (const u32x2*)(HB + (size_t)ta * DM) + lane; const u32x2* hc = (const u32x2*)(HB + (size_t)(two ? tc : ta) * DM) + lane;
            const unsigned* ya1 = (const unsigned*)(YB + sa1 * DM) + lane; const unsigned* ya2 = (const unsigned*)(YB + sa2 * DM) + lane;
            const unsigned* yc1 = (const unsigned*)(YB + (two ? sc1 : sa1) * DM) + lane; const unsigned* yc2 = (const unsigned*)(YB + (two ? sc2 : sa2) * DM) + lane;
            f32x4 va[4], vc[4]; unsigned pa[4], ra[4], pc[4], rc[4]; u32x2 qa[4], qc[4];
#pragma unroll
            for (int q = 0; q < 4; ++q) { qa[q] = __builtin_nontemporal_load(ha + 64 * q); pa[q] = __builtin_nontemporal_load(ya1 + 64 * q); ra[q] = __builtin_nontemporal_load(ya2 + 64 * q); qc[q] = __builtin_nontemporal_load(hc + 64 * q); pc[q] = __builtin_nontemporal_load(yc1 + 64 * q); rc[q] = __builtin_nontemporal_load(yc2 + 64 * q); }
#pragma unroll
            for (int q = 0; q < 4; ++q) { va[q] = (f32x4){bf2f(qa[q].x & 0xffffu), bf2f(qa[q].x >> 16), bf2f(qa[q].y & 0xffffu), bf2f(qa[q].y >> 16)}; vc[q] = (f32x4){bf2f(qc[q].x & 0xffffu), bf2f(qc[q].x >> 16), bf2f(qc[q].y & 0xffffu), bf2f(qc[q].y >> 16)}; }
            float sa = 0.f, sc = 0.f;
#pragma unroll
            for (int q = 0; q < 4; ++q) {
                const f32x2 a0 = __builtin_amdgcn_cvt_pk_f32_fp8((int)pa[q], false), a1 = __builtin_amdgcn_cvt_pk_f32_fp8((int)pa[q], true), b0 = __builtin_amdgcn_cvt_pk_f32_fp8((int)ra[q], false), b1 = __builtin_amdgcn_cvt_pk_f32_fp8((int)ra[q], true);
                const f32x2 c0 = __builtin_amdgcn_cvt_pk_f32_fp8((int)pc[q], false), c1 = __builtin_amdgcn_cvt_pk_f32_fp8((int)pc[q], true), d0 = __builtin_amdgcn_cvt_pk_f32_fp8((int)rc[q], false), d1 = __builtin_amdgcn_cvt_pk_f32_fp8((int)rc[q], true);
                va[q].x += (a0.x + b0.x) * YUNSCALE; va[q].y += (a0.y + b0.y) * YUNSCALE; va[q].z += (a1.x + b1.x) * YUNSCALE; va[q].w += (a1.y + b1.y) * YUNSCALE;
                vc[q].x += (c0.x + d0.x) * YUNSCALE; vc[q].y += (c0.y + d0.y) * YUNSCALE; vc[q].z += (c1.x + d1.x) * YUNSCALE; vc[q].w += (c1.y + d1.y) * YUNSCALE;
                sa += (va[q].x * va[q].x + va[q].y * va[q].y) + (va[q].z * va[q].z + va[q].w * va[q].w); sc += (vc[q].x * vc[q].x + vc[q].y * vc[q].y) + (vc[q].z * vc[q].z + vc[q].w * vc[q].w); }
            const float rsa = frsq(wave_sum(sa) * (1.f / DM) + EPS), rsc = frsq(wave_sum(sc) * (1.f / DM) + EPS);
#pragma unroll
            for (int q = 0; q < 4; ++q) __builtin_nontemporal_store(va[q] * rsa * gq[q], xa + 64 * q);
            if (two) {
#pragma unroll
                for (int q = 0; q < 4; ++q) __builtin_nontemporal_store(vc[q] * rsc * gq[q], xc + 64 * q); }
        }
    }
}

__global__ void __launch_bounds__(NTHR, 2) fwd(Args args) {
    extern __shared__ __attribute__((aligned(16))) unsigned char lds_raw[];
    Frame F;
    F.lds = (LAS unsigned char*)lds_raw;
    F.tid = threadIdx.x; F.lane = F.tid & 63; F.wave = __builtin_amdgcn_readfirstlane(F.tid >> 6);
    F.G = gridDim.x; { const int bx = blockIdx.x; F.vcu = (F.G % 8 == 0) ? (bx % 8) * (F.G / 8) + bx / 8 : bx; }
    F.ws = args.ws; F.out = args.out; F.ctl = (unsigned*)(args.ws + WS_CTL); F.tp0 = 0ull; F.tpd = 0ull;
    const int lo = args.ph_lo, hi = args.ph_hi;
    if (F.tid < 32) ((LAS unsigned*)(F.lds + L_MISC))[F.tid] = 0u;
    __syncthreads();
    XcdBarrier bar; bar.bar = F.ctl + CW_BAR; bar.x = 0; bar.st = nullptr;
    if (hi - lo > 1) bar = xcd_barrier_post(F.ctl + CW_BAR, (volatile LAS unsigned*)(F.lds + L_MISC) + 8);
    unsigned long long tp_t0 = 0ull, tp_d = 0ull; TpAcc tpa{0ull, 0ull};
#define TP_BEGIN(k) do { if (TP_PHASE == (k)) tp_t0 = __builtin_amdgcn_s_memrealtime(); } while (0)
#define TP_STOP(k, body) do { if (TP_PHASE == (k) && TP_BODY == (body)) tp_d = __builtin_amdgcn_s_memrealtime() - tp_t0; } while (0)
#define SEAM(k) do { TP_STOP(k, true); if (IN(k) && IN((k) + 1)) { xcd_barrier(bar); if ((REP_MASK >> 10) & 1u) xcd_barrier(bar); } TP_STOP(k, false); TP_BEGIN((k) + 1); } while (0)
#ifndef PHMASK
#define PHMASK 0x3ff
#endif
#define IN(k) (((PHMASK >> (k)) & 1) && lo <= (k) && (k) < hi)

    TP_BEGIN(0);
    if (IN(0)) { for (int rep = 0; rep < 1 + (int)((REP_MASK >> 0) & 1u); ++rep) p0_prologue(F, args); }
    SEAM(0);
    if (IN(1)) for (int rep = 0; rep < 1 + (int)((REP_MASK >> 1) & 1u); ++rep) {
        pg8::StaticOrder S; S.init(NTOK, LDP, F.G, (int)blockIdx.x);
        pg8::EpiBf16 E{(bf16_t*)(F.ws + WS_PROJ), LDP};
        pg8::gemm_phase<pg8::EpiBf16, pg8::StaticOrder, true, false, false>(F.lds, (const bf16_t*)(F.ws + WS_HN), (const bf16_t*)(F.ws + WS_WIN), DM, S, E, tpa);
    }
    SEAM(1);
    if (IN(2)) for (int rep = 0; rep < 1 + (int)((REP_MASK >> 2) & 1u); ++rep) { for (int ck = blockIdx.x; ck < NTOK / 64; ck += F.G) mixer_chunk<false>(F, args, ck); }
    SEAM(2);
    if (IN(3)) { for (int rep = 0; rep < 1 + (int)((REP_MASK >> 3) & 1u); ++rep) m3_scan(F); }
    SEAM(3);
    if (IN(4)) for (int rep = 0; rep < 1 + (int)((REP_MASK >> 4) & 1u); ++rep) { for (int ck = blockIdx.x; ck < NTOK / 64; ck += F.G) mixer_chunk<true>(F, args, ck); }
    SEAM(4);
    if (IN(5)) for (int rep = 0; rep < 1 + (int)((REP_MASK >> 5) & 1u); ++rep) {
        pg8::StaticOrder S; S.init(NTOK, DM, F.G, (int)blockIdx.x);
        pg8::EpiResBf16 E{args.in[0], (bf16_t*)(F.ws + WS_HB), DM};
        pg8::gemm_phase<pg8::EpiResBf16, pg8::StaticOrder, false, false, false>(F.lds, (const bf16_t*)(F.ws + WS_HN), (const bf16_t*)(F.ws + WS_WOUT), DM, S, E, tpa);
    }
    SEAM(5);
    if (IN(6)) { p6_router(F, args); }
    SEAM(6);
    if (IN(7)) for (int rep = 0; rep < 1 + (int)((REP_MASK >> 7) & 1u); ++rep) {
        const int nu = moe_setup(F, 3, true, true);
        pg8::MoeOrder S{(const LAS int*)(F.lds + L_UTAB), (const LAS unsigned*)(F.lds + L_ROWT), nu, 8};
        pg8::EpiGeglu E{F.ws + WS_H};
        pg8::gemm_phase<pg8::EpiGeglu, pg8::MoeOrder, true, true, true>(F.lds, (const bf16_t*)(F.ws + WS_HN), (const bf16_t*)(F.ws + WS_WGU), DM / 2, S, E, tpa);
    }
    SEAM(7);
    if (IN(8)) for (int rep = 0; rep < 1 + (int)((REP_MASK >> 8) & 1u); ++rep) {
        const int nu = moe_setup(F, 2, true, false);
        pg8::MoeOrder S{(const LAS int*)(F.lds + L_UTAB), (const LAS unsigned*)(F.lds + L_ROWT), nu, 4};
        pg8::EpiScaleFp8 E{F.ws + WS_YB};
        pg8::gemm_phase<pg8::EpiScaleFp8, pg8::MoeOrder, true, false, true>(F.lds, (const bf16_t*)(F.ws + WS_H), (const bf16_t*)(F.ws + WS_WD), DM / 2, S, E, tpa);
    }
    SEAM(8);
    if (IN(9)) { moe_setup(F, 0, false, false); p9_final(F, args); }
    TP_STOP(9, true); TP_STOP(9, false);
    if (TP_PHASE >= 100) tp_d = F.tpd;
    if (TP_PHASE >= 200) tp_d = tpa.d;
    if (TP_PHASE >= 0) { const unsigned long long te = __builtin_amdgcn_s_memrealtime(); while (__builtin_amdgcn_s_memrealtime() - te < tp_d) __builtin_amdgcn_s_sleep(8); }
#undef IN
#undef SEAM
#undef TP_BEGIN
#undef TP_STOP
}

extern "C" void kernel_launch(void* const* d_in, const int* in_sizes, int n_in, void* d_out, int out_size, void* d_ws, size_t ws_size, hipStream_t stream) {
    static int grid = 0;
    if (grid == 0) {
        if (n_in != 24 || out_size != NTOK * DM || ws_size < WS_END) { fprintf(stderr, "kernel_launch: unexpected shapes (n_in %d, out %d, ws %zu); nothing launched\n", n_in, out_size, ws_size); grid = -1; return; }
        int dev = 0, cus = 0;
        if (hipGetDevice(&dev) != hipSuccess || hipDeviceGetAttribute(&cus, hipDeviceAttributeMultiprocessorCount, dev) != hipSuccess) { grid = -1; return; }
        if (hipFuncSetAttribute((const void*)fwd, hipFuncAttributeMaxDynamicSharedMemorySize, LDS_BYTES) != hipSuccess) { fprintf(stderr, "kernel_launch: hipFuncSetAttribute failed\n"); grid = -1; return; }
        (void)hipGetLastError();
        grid = cus;
        if ((160 * 8 + grid - 1) / grid > MAXU) { fprintf(stderr, "kernel_launch: %d workgroups cannot hold the MoE unit tables (MAXU %d); nothing launched\n", grid, MAXU); grid = -1; return; }
    }
    if (grid < 0) return;
    (void)hipMemsetAsync((char*)d_ws + WS_CTL, 0, CTL_ZERO_BYTES, stream);
    Args a{};
    for (int i = 0; i < 24; ++i) a.in[i] = (const float*)d_in[i];
    a.out = (float*)d_out; a.ws = (unsigned char*)d_ws;
#ifndef N_LAUNCHES
#define N_LAUNCHES 1
#endif
    if (N_LAUNCHES == 1) { a.ph_lo = 0; a.ph_hi = NPHASE; hipLaunchKernelGGL(fwd, dim3(grid), dim3(NTHR), LDS_BYTES, stream, a); }
    else for (int p = 0; p < NPHASE; ++p) { a.ph_lo = p; a.ph_hi = p + 1; hipLaunchKernelGGL(fwd, dim3(grid), dim3(NTHR), LDS_BYTES, stream, a); }
}
```

```cpp
#include <hip/hip_runtime.h>
#include <cstdio>
#include <cstdint>

#define LAS __attribute__((address_space(3)))
#define GAS __attribute__((address_space(1)))
typedef unsigned short bf16_t;
typedef short bf16x8 __attribute__((ext_vector_type(8)));
typedef float f32x4 __attribute__((ext_vector_type(4)));
typedef float f32x2 __attribute__((ext_vector_type(2)));
typedef unsigned u32x4 __attribute__((ext_vector_type(4)));
typedef unsigned u32x2 __attribute__((ext_vector_type(2)));
typedef int v4i __attribute__((ext_vector_type(4)));
typedef int v8i __attribute__((ext_vector_type(8)));

constexpr int NTOK = 16384, SEQ = 8192, DM = 1024;
constexpr int RGW = 512, NPROJ = 2576, LDP = 2816;
constexpr int C_XR = 0, C_YR = 512, C_Q = 1024, C_K = 1280, C_V = 1536, C_G = 2048, C_AL = 2560;
constexpr int NEXP = 32, CAP = 16384;
constexpr float EPS = 1e-6f;
constexpr int NWAVES = 8, NTHR = 512;
constexpr int NPHASE = 10;
constexpr unsigned REP_MASK = 0x000;
constexpr int TP_PHASE = -1;
constexpr bool TP_BODY = false;

constexpr size_t MiB = 1u << 20;
constexpr size_t WS_CTL = 0, CTL_ZERO_BYTES = 64 * 1024;
constexpr size_t WS_WRT = 1 * MiB;
constexpr size_t WS_RS = 1 * MiB + 512 * 1024;
constexpr size_t WS_WIN = 2 * MiB;
constexpr size_t WS_WOUT = 8 * MiB;
constexpr size_t WS_WGU = 16 * MiB;
constexpr size_t WS_WD = 80 * MiB;
constexpr float WSCALE = 32.f, WUNSCALE = 1.f / 32.f, YSCALE = 16.f, YUNSCALE = 1.f / 16.f;
constexpr size_t WS_HN = 208 * MiB;
constexpr size_t WS_PROJ = 240 * MiB;
constexpr size_t WS_SMALL = 10 * MiB;
constexpr size_t WS_KVT = 328 * MiB;
constexpr size_t WS_ST = 360 * MiB;
constexpr size_t WS_DEC = 376 * MiB, WS_RGSA = 377 * MiB, WS_RGSH = 377 * MiB + 512 * 1024, WS_RGC = 378 * MiB;
constexpr size_t WS_H = 240 * MiB;
constexpr size_t WS_YB = 320 * MiB;
constexpr size_t WS_HB = 400 * MiB;
constexpr size_t WS_STOK = 480 * MiB, WS_SW = 482 * MiB, WS_TIDX = 484 * MiB;
constexpr size_t WS_END = 512 * MiB;
constexpr int CW_BAR = 4096;
constexpr int CW_GCNT = 8192;

constexpr int RING_BYTES = 131072;
constexpr int CTRL_BASE = 143360;
constexpr int L_MISC = CTRL_BASE;
constexpr int L_CNT = CTRL_BASE + 128;
constexpr int L_TST = CTRL_BASE + 256;
constexpr int L_UTAB = CTRL_BASE + 512;
constexpr int MAXU = 8;
constexpr int L_ROWT = CTRL_BASE + 1024;
constexpr int L_WT = L_ROWT + MAXU * 1024;
constexpr int LDS_BYTES = L_WT + MAXU * 1024;
static_assert(LDS_BYTES <= 163840 && LDS_BYTES % 16 == 0, "LDS map");

__device__ __forceinline__ unsigned f2bf(float f) { unsigned u = __builtin_bit_cast(unsigned, f); return (u + 0x7fffu + ((u >> 16) & 1u)) >> 16; }
__device__ __forceinline__ unsigned pk2(float lo, float hi) { return f2bf(lo) | (f2bf(hi) << 16); }
__device__ __forceinline__ unsigned pk4_fp8(float a, float b, float c, float d) { int w = 0; w = __builtin_amdgcn_cvt_pk_fp8_f32(a, b, w, false); w = __builtin_amdgcn_cvt_pk_fp8_f32(c, d, w, true); return (unsigned)w; }
__device__ __forceinline__ float bf2f(unsigned b) { return __builtin_bit_cast(float, b << 16); }
__device__ __forceinline__ float wave_sum(float v) {
#pragma unroll
    for (int o = 1; o < 64; o <<= 1) v += __shfl_xor(v, o);
    return v;
}
__device__ __forceinline__ float frsq(float x) { return __builtin_amdgcn_rsqf(x); }
__device__ __forceinline__ float frcp(float x) { return __builtin_amdgcn_rcpf(x); }
__device__ __forceinline__ float sigmoidf_(float x) { return frcp(1.f + __expf(-x)); }
__device__ __forceinline__ f32x2 geglu_pk(f32x2 g, f32x2 u) {
    const f32x2 g2 = g * g, p = g2 * 0.044715f + 1.0f, z2 = (g * p) * (-1.5957691216057308f * 1.4426950408889634f);
    f32x2 e; e.x = __builtin_amdgcn_exp2f(z2.x); e.y = __builtin_amdgcn_exp2f(z2.y);
    const f32x2 d = e + 1.0f; f32x2 r; r.x = __builtin_amdgcn_rcpf(d.x); r.y = __builtin_amdgcn_rcpf(d.y);
    return (g * u) * r;
}
__device__ __forceinline__ float gelu_tanh(float x) { const float z2 = 1.5957691216057308f * (x + 0.044715f * x * x * x); return x * frcp(1.f + __expf(-z2)); }

struct TpAcc { unsigned long long t0, d; };
#define TPS2(T, id) do { if (TP_PHASE == (id)) (T).t0 = __builtin_amdgcn_s_memrealtime(); } while (0)
#define TPE2(T, id) do { if (TP_PHASE == (id)) (T).d += __builtin_amdgcn_s_memrealtime() - (T).t0; } while (0)
namespace pg8 {
constexpr int BM = 256, BK = 64, HALF = 128, HTB = HALF * BK * 2, NXCD = 8, WGM = 8;
__host__ __device__ __forceinline__ int lds_byte(int r, int c) { const int st = (r >> 4) * 2 + (c >> 5), rr = r & 15, cc = c & 31, ob = rr * 64 + cc * 2; return st * 1024 + (ob ^ (((ob >> 9) & 1) << 5)); }
__host__ __device__ __forceinline__ void stage_rc(int b, int& R, int& C) { const int st = b / 1024, sb = b % 1024, swz = sb ^ (((sb >> 9) & 1) << 5); R = (st >> 1) * 16 + swz / 64; C = (st & 1) * 32 + (swz % 64) / 2; }
__host__ __device__ __forceinline__ int perm32(int rho) { const int n = rho >> 4, i = rho & 15; return 8 * (i >> 2) + 4 * n + (i & 3); }

struct Unit { int pm, pn, bt, ui, e, rows; };

struct StaticOrder {
    int nM, nN, nwg, G, c;
    __device__ void init(int M, int N, int G_, int c_) { nM = M / BM; nN = N / BM; nwg = nM * nN; G = G_; c = c_; }
    __device__ bool next(int i, Unit& u) const {
        const long L = (long)i * G + c; if (L >= nwg) return false;
        int wgid = (int)L; { const int q = nwg / NXCD, r = nwg % NXCD, xcd = wgid % NXCD, off = wgid / NXCD; wgid = (xcd < r ? xcd * (q + 1) : r * (q + 1) + (xcd - r) * q) + off; }
        const int nig = WGM * nN, gid = wgid / nig, fm = gid * WGM, gsz = (nM - fm) < WGM ? (nM - fm) : WGM;
        u.pm = fm + ((wgid % nig) % gsz); u.pn = (wgid % nig) / gsz; u.bt = u.pn; u.ui = i; u.e = 0; u.rows = 256; return true;
    }
    __device__ __forceinline__ unsigned row_byte(const Unit&, int) const { return 0u; }
};

struct MoeOrder {
    const LAS int* utab; const LAS unsigned* rowt; int nu, ncol;
    __device__ bool next(int i, Unit& u) const {
        if (i >= nu) return false;
        u.pm = __builtin_amdgcn_readfirstlane(utab[i * 8 + 0]); u.pn = __builtin_amdgcn_readfirstlane(utab[i * 8 + 1]); u.e = __builtin_amdgcn_readfirstlane(utab[i * 8 + 2]); u.rows = __builtin_amdgcn_readfirstlane(utab[i * 8 + 3]); u.ui = i; u.bt = u.e * ncol + u.pn; return true;
    }
    __device__ __forceinline__ unsigned row_byte(const Unit& u, int r) const { return rowt[u.ui * 256 + r]; }
};

__device__ __forceinline__ unsigned cvt_pk_bf16(float lo, float hi) { unsigned r; asm volatile("v_cvt_pk_bf16_f32 %0, %1, %2" : "=v"(r) : "v"(lo), "v"(hi)); return r; }

struct EpiBf16 {
    static constexpr bool PERM = true; static constexpr int TPID = 210;
    bf16_t* O; int ldc;
    __device__ __forceinline__ void operator()(const f32x4 (&acc)[2][2][4][2], const Unit& u, int wr, int wc, int fr, int fq, const LAS unsigned char*) const {
        const int row0 = u.pm * BM + wr * 64 + fr, col0 = u.pn * BM + wc * 32 + 8 * fq;
#pragma unroll
        for (int ai = 0; ai < 2; ++ai)
#pragma unroll
            for (int m = 0; m < 4; ++m) { bf16_t* rowp = O + (size_t)(row0 + ai * HALF + m * 16) * ldc + col0;
#pragma unroll
                for (int bj = 0; bj < 2; ++bj) { const f32x4 v0 = acc[ai][bj][m][0], v1 = acc[ai][bj][m][1];
                    u32x4 w; w.x = cvt_pk_bf16(v0[0], v0[1]); w.y = cvt_pk_bf16(v0[2], v0[3]); w.z = cvt_pk_bf16(v1[0], v1[1]); w.w = cvt_pk_bf16(v1[2], v1[3]);
                    *(u32x4*)(rowp + bj * HALF) = w; } }
    }
};
struct EpiResBf16 {
    static constexpr bool PERM = true; static constexpr int TPID = 250;
    const float* base; bf16_t* out; int ldc;
    __device__ __forceinline__ void operator()(const f32x4 (&acc)[2][2][4][2], const Unit& u, int wr, int wc, int fr, int fq, const LAS unsigned char*) const {
        const int col0 = u.pn * BM + wc * 32 + 8 * fq;
#pragma unroll
        for (int ai = 0; ai < 2; ++ai)
#pragma unroll
            for (int m = 0; m < 4; ++m) { const size_t off = (size_t)(u.pm * BM + ai * HALF + wr * 64 + m * 16 + fr) * ldc + col0;
#pragma unroll
                for (int bj = 0; bj < 2; ++bj) { const f32x4 b0 = *(const f32x4*)(base + off + bj * HALF), b1 = *(const f32x4*)(base + off + bj * HALF + 4);
                    const f32x4 v0 = acc[ai][bj][m][0] + b0, v1 = acc[ai][bj][m][1] + b1;
                    u32x4 w; w.x = cvt_pk_bf16(v0[0], v0[1]); w.y = cvt_pk_bf16(v0[2], v0[3]); w.z = cvt_pk_bf16(v1[0], v1[1]); w.w = cvt_pk_bf16(v1[2], v1[3]);
                    *(u32x4*)(out + off + bj * HALF) = w; } }
    }
};
struct EpiGeglu {
    static constexpr bool PERM = true; static constexpr int TPID = 270;
    unsigned char* H;
    __device__ __forceinline__ void operator()(const f32x4 (&acc)[2][2][4][2], const Unit& u, int wr, int wc, int fr, int fq, const LAS unsigned char* lds) const {
        const int col0 = u.pn * HALF + wc * 32 + 8 * fq; const LAS float* wt = (const LAS float*)(lds + L_WT) + u.ui * 256;
#pragma unroll
        for (int ai = 0; ai < 2; ++ai)
#pragma unroll
            for (int m = 0; m < 4; ++m) { const int r = ai * HALF + wr * 64 + m * 16 + fr;
                if (r < u.rows) { const float s = wt[r] * WUNSCALE;
                    const f32x4 g0 = acc[ai][0][m][0] * s, g1 = acc[ai][0][m][1] * s, u0 = acc[ai][1][m][0] * s, u1 = acc[ai][1][m][1] * s;
                    const f32x2 h0 = geglu_pk((f32x2){g0[0], g0[1]}, (f32x2){u0[0], u0[1]}), h1 = geglu_pk((f32x2){g0[2], g0[3]}, (f32x2){u0[2], u0[3]});
                    const f32x2 h2 = geglu_pk((f32x2){g1[0], g1[1]}, (f32x2){u1[0], u1[1]}), h3 = geglu_pk((f32x2){g1[2], g1[3]}, (f32x2){u1[2], u1[3]});
                    u32x2 w;
                    w.x = pk4_fp8(h0.x, h0.y, h1.x, h1.y);
                    w.y = pk4_fp8(h2.x, h2.y, h3.x, h3.y);
                    *(u32x2*)(H + (size_t)(u.pm * BM + r) * 1024 + col0) = w; } }
    }
};
struct EpiScaleFp8 {
    static constexpr bool PERM = true; static constexpr int TPID = 280;
    unsigned char* Y;
    __device__ __forceinline__ void operator()(const f32x4 (&acc)[2][2][4][2], const Unit& u, int wr, int wc, int fr, int fq, const LAS unsigned char* lds) const {
        const int col0 = u.pn * BM + wc * 32 + 8 * fq; const LAS float* wt = (const LAS float*)(lds + L_WT) + u.ui * 256;
#pragma unroll
        for (int ai = 0; ai < 2; ++ai)
#pragma unroll
            for (int m = 0; m < 4; ++m) { const int r = ai * HALF + wr * 64 + m * 16 + fr;
                if (r < u.rows) { const float s = wt[r] * (WUNSCALE * YSCALE); unsigned char* rowp = Y + (size_t)(u.pm * BM + r) * 1024 + col0;
#pragma unroll
                    for (int bj = 0; bj < 2; ++bj) { const f32x4 v0 = acc[ai][bj][m][0] * s, v1 = acc[ai][bj][m][1] * s;
                        u32x2 w; w.x = pk4_fp8(v0[0], v0[1], v0[2], v0[3]); w.y = pk4_fp8(v1[0], v1[1], v1[2], v1[3]);
                        *(u32x2*)(rowp + bj * HALF) = w; } } }
    }
};

template <class Epi, class Sched, bool ALIGN_EPI, bool GATHER, bool FP8>
__device__ __forceinline__ void gemm_phase(LAS unsigned char* lds, const bf16_t* Ab, const bf16_t* Bb, const int K, const Sched& S, const Epi& E, TpAcc& T) {
    const int tid = threadIdx.x, wid = __builtin_amdgcn_readfirstlane(tid >> 6), lane = tid & 63, wr = wid >> 2, wc = wid & 3, fr = lane & 15, fq = lane >> 4;
    const int nt = K / BK;
    int Rr[2], Cc[2]; unsigned voffB[2];
#pragma unroll
    for (int i = 0; i < 2; ++i) { int R, C; stage_rc(tid * 16 + i * 8192, R, C); Rr[i] = R; Cc[i] = C; const int Rb = Epi::PERM ? ((R & ~31) + perm32(R & 31)) : R; voffB[i] = (unsigned)(Rb * K + C) * 2u; }
    const size_t kstep = (size_t)(BK * 2);
    const size_t hstep = (size_t)HALF * K * 2;
    const size_t tstep = 2 * hstep;
    const unsigned ldsw = (unsigned)wid * 1024u;
    const int aoff = lds_byte(wr * 64 + fr, fq * 8), boff = lds_byte(wc * 32 + fr, fq * 8);
#define PG8_SA(b, h) (((b) * 2 + (h)) * HTB)
#define PG8_SB(b, h) ((4 + (b) * 2 + (h)) * HTB)
#define PG8_STAGE2X(bufoff, gbase, o0, o1, AUX) do { unsigned _o0 = (o0), _o1 = (o1); asm volatile("" : "+v"(_o0), "+v"(_o1));     \
        __builtin_amdgcn_global_load_lds((const unsigned*)((const char*)(gbase) + _o0), (LAS unsigned*)(lds + (bufoff) + ldsw), 16, 0, AUX); \
        __builtin_amdgcn_global_load_lds((const unsigned*)((const char*)(gbase) + _o1), (LAS unsigned*)(lds + (bufoff) + ldsw + 8192), 16, 0, AUX); } while (0)
#define PG8_STAGE2(bufoff, gbase, o0, o1) PG8_STAGE2X(bufoff, gbase, o0, o1, 0)
#define PG8_STAGEB(bufoff, gbase) PG8_STAGE2X(bufoff, gbase, voffB[0], voffB[1], 0)
#define PG8_AH(p) (GATHER ? (p) : (p) + hstep)
#define PG8_V1(i) (GATHER ? vC[1][i] : vC[0][i])
#define PG8_LD8(p) __builtin_shufflevector(*(const LAS v4i*)(p), *(const LAS v4i*)((p) + 1024), 0, 1, 2, 3, 4, 5, 6, 7)
#define PG8_LDA(dst, b, h) do { _Pragma("unroll") for (int m = 0; m < 4; ++m) dst[m] = PG8_LD8(lds + PG8_SA(b, h) + aoff + m * 2048); } while (0)
#define PG8_LDB(dst, b, h) do { _Pragma("unroll") for (int n = 0; n < 2; ++n) dst[n] = PG8_LD8(lds + PG8_SB(b, h) + boff + n * 2048); } while (0)
#define PG8_LO(x) __builtin_bit_cast(bf16x8, __builtin_shufflevector(x, x, 0, 1, 2, 3))
#define PG8_HI(x) __builtin_bit_cast(bf16x8, __builtin_shufflevector(x, x, 4, 5, 6, 7))
#define PG8_MMA(ai, bj, At, Bt) do { __builtin_amdgcn_s_setprio(1); _Pragma("unroll") for (int m = 0; m < 4; ++m) _Pragma("unroll") for (int n = 0; n < 2; ++n) { \
        if constexpr (FP8) acc[ai][bj][m][n] = __builtin_amdgcn_mfma_scale_f32_16x16x128_f8f6f4(Bt[n], At[m], acc[ai][bj][m][n], 0, 0, 0, 0x7f7f7f7f, 0, 0x7f7f7f7f); \
        else { acc[ai][bj][m][n] = __builtin_amdgcn_mfma_f32_16x16x32_bf16(PG8_LO(Bt[n]), PG8_LO(At[m]), acc[ai][bj][m][n], 0, 0, 0); \
               acc[ai][bj][m][n] = __builtin_amdgcn_mfma_f32_16x16x32_bf16(PG8_HI(Bt[n]), PG8_HI(At[m]), acc[ai][bj][m][n], 0, 0, 0); } } __builtin_amdgcn_s_setprio(0); } while (0)
#define PG8_WAIT_V(n) asm volatile("s_waitcnt vmcnt(" #n ")" ::: "memory")
#define PG8_WAIT_L(n) asm volatile("s_waitcnt lgkmcnt(" #n ")" ::: "memory")
#define PG8_BAR __builtin_amdgcn_s_barrier()
#define PG8_SCHED __builtin_amdgcn_sched_barrier(0)
    Unit cur, nxt; int ui = 0;
    if (!S.next(0, cur)) return;
    f32x4 acc[2][2][4][2];
#pragma unroll
    for (int a = 0; a < 2; ++a)
#pragma unroll
        for (int b = 0; b < 2; ++b)
#pragma unroll
            for (int m = 0; m < 4; ++m)
#pragma unroll
                for (int n = 0; n < 2; ++n) acc[a][b][m][n] = (f32x4){0.f, 0.f, 0.f, 0.f};
    v8i At[4], B0[2], B1[2];
    unsigned vC[2][2];
#pragma unroll
    for (int h = 0; h < 2; ++h)
#pragma unroll
        for (int i = 0; i < 2; ++i) vC[h][i] = GATHER ? (S.row_byte(cur, h * HALF + Rr[i]) + (unsigned)Cc[i] * 2u) : (unsigned)(Rr[i] * K + Cc[i]) * 2u;
    const char* cA = GATHER ? (const char*)Ab : (const char*)Ab + (size_t)cur.pm * tstep; const char* cB = (const char*)Bb + (size_t)cur.bt * tstep;
    PG8_STAGEB(PG8_SB(0, 0), cB); PG8_STAGEB(PG8_SB(0, 1), cB + hstep); PG8_STAGE2(PG8_SA(0, 0), cA, vC[0][0], vC[0][1]); PG8_STAGE2(PG8_SA(0, 1), PG8_AH(cA), PG8_V1(0), PG8_V1(1));
    if (wr == 1) PG8_BAR;
    PG8_WAIT_V(2); PG8_BAR;
    PG8_STAGEB(PG8_SB(1, 0), cB + kstep); PG8_STAGE2(PG8_SA(1, 0), cA + kstep, vC[0][0], vC[0][1]); PG8_STAGEB(PG8_SB(1, 1), cB + hstep + kstep);
    PG8_WAIT_V(6); PG8_BAR;
    for (;;) {
        const bool has_next = S.next(ui + 1, nxt);
        const char* nA = has_next ? (GATHER ? (const char*)Ab : (const char*)Ab + (size_t)nxt.pm * tstep) : cA; const char* nB = has_next ? (const char*)Bb + (size_t)nxt.bt * tstep : cB;
        TPS2(T, Epi::TPID + 1);
#pragma unroll 1
        for (int t = 0; t < nt; t += 2) {
            const bool last = (t == nt - 2);
            const char* a1 = cA + (size_t)(t + 1) * kstep;
            const char* a2 = last ? nA : cA + (size_t)(t + 2) * kstep; const char* b2 = last ? nB : cB + (size_t)(t + 2) * kstep;
            const char* a3 = a2 + kstep; const char* b3 = b2 + kstep;
            PG8_LDB(B0, 0, 0); PG8_LDB(B1, 0, 1); PG8_SCHED; PG8_LDA(At, 0, 0); PG8_STAGE2(PG8_SA(1, 1), PG8_AH(a1), PG8_V1(0), PG8_V1(1));
            if constexpr (GATHER) {
                if (last && has_next) {
                    int ln_ = (int)__builtin_amdgcn_mbcnt_hi(~0u, __builtin_amdgcn_mbcnt_lo(~0u, 0u)); asm volatile("" : "+v"(ln_));
#pragma unroll
                    for (int i = 0; i < 2; ++i) { int R, C; stage_rc((wid * 64 + ln_) * 16 + i * 8192, R, C);
#pragma unroll
                        for (int h = 0; h < 2; ++h) vC[h][i] = S.row_byte(nxt, h * HALF + R) + (unsigned)C * 2u; }
                }
            }
            const unsigned w00 = vC[0][0], w01 = vC[0][1], w10 = PG8_V1(0), w11 = PG8_V1(1);
            PG8_WAIT_V(8); PG8_WAIT_L(0); PG8_BAR; PG8_MMA(0, 0, At, B0); PG8_MMA(0, 1, At, B1); PG8_BAR; PG8_SCHED;
            PG8_LDA(At, 0, 1); PG8_STAGEB(PG8_SB(0, 0), b2); PG8_STAGEB(PG8_SB(0, 1), b2 + hstep); PG8_STAGE2(PG8_SA(0, 0), a2, w00, w01);
            PG8_WAIT_V(8); PG8_WAIT_L(0); PG8_BAR; PG8_MMA(1, 0, At, B0); PG8_MMA(1, 1, At, B1); PG8_BAR; PG8_SCHED;
            PG8_LDB(B0, 1, 0); PG8_LDB(B1, 1, 1); PG8_SCHED; PG8_LDA(At, 1, 0); PG8_STAGE2(PG8_SA(0, 1), PG8_AH(a2), w10, w11);
            PG8_WAIT_V(8); PG8_WAIT_L(0); PG8_BAR; PG8_MMA(0, 0, At, B0); PG8_MMA(0, 1, At, B1); PG8_BAR; PG8_SCHED;
            PG8_LDA(At, 1, 1); PG8_STAGEB(PG8_SB(1, 0), b3); PG8_STAGEB(PG8_SB(1, 1), b3 + hstep); PG8_STAGE2(PG8_SA(1, 0), a3, w00, w01);
            PG8_WAIT_V(8); PG8_WAIT_L(0); PG8_BAR; PG8_MMA(1, 0, At, B0); PG8_MMA(1, 1, At, B1); PG8_BAR; PG8_SCHED;
        }
        TPE2(T, Epi::TPID + 1);
        if constexpr (ALIGN_EPI) { if (wr == 0) PG8_BAR; }
        TPS2(T, Epi::TPID);
        { int ln_ = (int)__builtin_amdgcn_mbcnt_hi(~0u, __builtin_amdgcn_mbcnt_lo(~0u, 0u)); asm volatile("" : "+v"(ln_));
          E(acc, cur, wr, wc, ln_ & 15, ln_ >> 4, lds); }
        asm volatile("" ::: "memory"); TPE2(T, Epi::TPID);
        if (!has_next) break;
#pragma unroll
        for (int a = 0; a < 2; ++a)
#pragma unroll
            for (int b = 0; b < 2; ++b)
#pragma unroll
                for (int m = 0; m < 4; ++m)
#pragma unroll
                    for (int n = 0; n < 2; ++n) acc[a][b][m][n] = (f32x4){0.f, 0.f, 0.f, 0.f};
        cur = nxt; cA = nA; cB = nB; ++ui;
        if constexpr (ALIGN_EPI) { if (wr == 1) PG8_BAR; }
    }
    PG8_WAIT_V(0);
    if constexpr (!ALIGN_EPI) { if (wr == 0) PG8_BAR; }
    PG8_BAR;
#undef PG8_SA
#undef PG8_SB
#undef PG8_STAGE2
#undef PG8_STAGE2X
#undef PG8_STAGEB
#undef PG8_AH
#undef PG8_V1
#undef PG8_LDA
#undef PG8_LDB
#undef PG8_MMA
#undef PG8_LD8
#undef PG8_LO
#undef PG8_HI
#undef PG8_WAIT_V
#undef PG8_WAIT_L
#undef PG8_BAR
#undef PG8_SCHED
}
}


#define XB_TMO      128
#define XB_XCNT(j)  (256  + 64 * (j))
#define XB_XSUB(j)  (1280 + 64 * (j))
#define XB_XGEN(j)  (2304 + 64 * (j))
#define XB_TOP      3328
#define XB_TOPGEN   3392
#define XCD_BAR_WORDS 3456
#define XB_SPIN_CAP (1u << 18)

__device__ __forceinline__ unsigned xb_ld(unsigned* p)              { return __hip_atomic_load(p, __ATOMIC_RELAXED, __HIP_MEMORY_SCOPE_AGENT); }
__device__ __forceinline__ unsigned xb_add(unsigned* p, unsigned v) { return __hip_atomic_fetch_add(p, v, __ATOMIC_RELAXED, __HIP_MEMORY_SCOPE_AGENT); }
__device__ __forceinline__ unsigned xb_xcc_id() { return (unsigned)__builtin_amdgcn_s_getreg((3 << 11) | 20) & 0xFu; }
#define XB_SPIN(cond, bar) do { unsigned _sp = 0; while (cond) { __builtin_amdgcn_s_sleep(1); \
    if ((++_sp & 255u) == 0u) { if (xb_ld(&(bar)[XB_TMO])) break; if (_sp > XB_SPIN_CAP) { atomicAdd(&(bar)[XB_TMO], 1u); break; } } } } while (0)

struct XcdBarrier {
    unsigned* bar; unsigned x;
    volatile LAS unsigned* st;
};
__device__ __forceinline__ XcdBarrier xcd_barrier_post(unsigned* bar, volatile LAS unsigned* st) {
    XcdBarrier b; b.bar = bar; b.x = xb_xcc_id(); b.st = st;
    if (threadIdx.x == 0) (void)xb_add(&bar[XB_XCNT(b.x)], 1u);
    return b;
}
__device__ __forceinline__ void xcd_barrier_complete(unsigned* bar, unsigned x, unsigned& nloc, unsigned& nx) {
    const unsigned G = gridDim.x * gridDim.y * gridDim.z;
    unsigned sum, cnt, mine, sp = 0u;
    for (;;) {
        sum = 0u; cnt = 0u; mine = 0u;
#pragma unroll
        for (unsigned j = 0; j < 16; ++j) { const unsigned c = xb_ld(&bar[XB_XCNT(j)]); sum += c; cnt += (c > 0u) ? 1u : 0u; mine = (j == x) ? c : mine; }
        if (sum == G) break;
        __builtin_amdgcn_s_sleep(1);
        if ((++sp & 255u) == 0u) { if (xb_ld(&bar[XB_TMO])) break; if (sp > XB_SPIN_CAP) { atomicAdd(&bar[XB_TMO], 1u); break; } }
    }
    nloc = mine > 0u ? mine : 1u; nx = cnt > 0u ? cnt : 1u;
}
__device__ __forceinline__ void xcd_barrier(const XcdBarrier& b) {
    asm volatile("s_waitcnt vmcnt(0)" ::: "memory");
    __syncthreads();
    if (threadIdx.x == 0) {
        unsigned* bar = b.bar;
        __builtin_amdgcn_s_waitcnt(0);
        unsigned nloc = b.st[0], nx = b.st[1];
        if (nloc == 0u) { xcd_barrier_complete(bar, b.x, nloc, nx); b.st[0] = nloc; b.st[1] = nx; }
        const unsigned old = xb_add(&bar[XB_XSUB(b.x)], 1u);
        const unsigned gen = old / nloc;
        if (old + 1u == (gen + 1u) * nloc) {
            __builtin_amdgcn_fence(__ATOMIC_RELEASE, "agent");
            asm volatile("s_waitcnt vmcnt(0)" ::: "memory");
            const unsigned og = xb_add(&bar[XB_TOP], 1u);
            const unsigned tg = og / nx;
            if (og + 1u == (tg + 1u) * nx) xb_add(&bar[XB_TOPGEN], 1u);
            else XB_SPIN(xb_ld(&bar[XB_TOPGEN]) == tg, bar);
            __builtin_amdgcn_fence(__ATOMIC_ACQUIRE, "agent");
            xb_add(&bar[XB_XGEN(b.x)], 1u);
            asm volatile("s_waitcnt vmcnt(0)" ::: "memory");
        } else {
            XB_SPIN(xb_ld(&bar[XB_XGEN(b.x)]) == gen, bar);
            __builtin_amdgcn_fence(__ATOMIC_ACQUIRE, "agent");
            asm volatile("s_waitcnt vmcnt(0)" ::: "memory");
        }
    }
    __syncthreads();
}

struct Args { const float* in[24]; float* out; unsigned char* ws; int ph_lo, ph_hi; };

struct Frame {
    LAS unsigned char* lds;
    unsigned* ctl;
    int tid, lane, wave, vcu, G;
    unsigned char* ws; float* out;
    unsigned long long tp0, tpd;
};
#define TPS(F, id) do { if (TP_PHASE == (id)) (F).tp0 = __builtin_amdgcn_s_memrealtime(); } while (0)
#define TPE(F, id) do { if (TP_PHASE == (id)) (F).tpd += __builtin_amdgcn_s_memrealtime() - (F).tp0; } while (0)

struct TTile { const float* src; unsigned char* dst; int Nsrc, k0, n0, orow0, fp8; };
__device__ __forceinline__ TTile p0_tile(const Args& a, unsigned char* ws, int it) {
    constexpr int I_IN = 16 * 44, I_OUT = 16 * 16, I_E = 16 * 16;
    TTile t;
    if (it < I_IN) { const int kb = it / 44, nb = it % 44; t.fp8 = 0; t.src = a.in[2]; t.dst = ws + WS_WIN; t.Nsrc = NPROJ; t.k0 = 64 * kb; t.n0 = 64 * nb; t.orow0 = 64 * nb; return t; }
    it -= I_IN;
    if (it < I_OUT) { const int kb = it >> 4, nb = it & 15; t.fp8 = 0; t.src = a.in[14]; t.dst = ws + WS_WOUT; t.Nsrc = DM; t.k0 = 64 * kb; t.n0 = 64 * nb; t.orow0 = 64 * nb; return t; }
    it -= I_OUT;
    const int e = it / (3 * I_E), w = (it / I_E) % 3, q = it % I_E, kb = q & 15, nb = q >> 4, n0 = 64 * nb;
    t.Nsrc = DM; t.k0 = 64 * kb; t.n0 = n0; t.fp8 = 1;
    if (w == 0) { t.src = a.in[20] + (size_t)e * DM * DM; t.dst = ws + WS_WGU + (size_t)e * 2048 * DM; t.orow0 = (n0 >> 7) * 256 + (n0 & 127); }
    else if (w == 1) { t.src = a.in[21] + (size_t)e * DM * DM; t.dst = ws + WS_WGU + (size_t)e * 2048 * DM; t.orow0 = (n0 >> 7) * 256 + 128 + (n0 & 127); }
    else { t.src = a.in[22] + (size_t)e * DM * DM; t.dst = ws + WS_WD + (size_t)e * DM * DM; t.orow0 = n0; }
    return t;
}
__device__ __forceinline__ void p0_load(f32x4 (&v)[16], const TTile& t, int lane) {
    int n = t.n0 + 4 * (lane & 15); n = n < t.Nsrc ? n : t.Nsrc - 4; const float* p = t.src + (size_t)(t.k0 + (lane >> 4)) * t.Nsrc + n;
#pragma unroll
    for (int i = 0; i < 16; ++i) v[i] = __builtin_nontemporal_load((const f32x4*)(p + (size_t)(4 * i) * t.Nsrc));
}
__device__ __forceinline__ void p0_store(const f32x4 (&v)[16], const TTile& t, LAS float* scr, int lane) {
    const float keep = (t.n0 + 4 * (lane & 15)) < t.Nsrc ? 1.f : 0.f;
#pragma unroll
    for (int i = 0; i < 16; ++i) { LAS float* d = scr + ((lane >> 4) + 4 * i) * 65 + 4 * (lane & 15); d[0] = v[i].x * keep; d[1] = v[i].y * keep; d[2] = v[i].z * keep; d[3] = v[i].w * keep; }
    asm volatile("s_waitcnt lgkmcnt(0)" ::: "memory");
    const int c = lane & 7;
#pragma unroll
    for (int j = 0; j < 8; ++j) { const int n = (lane >> 3) + 8 * j; const LAS float* sp = scr + (8 * c) * 65 + n;
        if (t.fp8) { u32x2 o; o.x = pk4_fp8(sp[0 * 65] * WSCALE, sp[1 * 65] * WSCALE, sp[2 * 65] * WSCALE, sp[3 * 65] * WSCALE); o.y = pk4_fp8(sp[4 * 65] * WSCALE, sp[5 * 65] * WSCALE, sp[6 * 65] * WSCALE, sp[7 * 65] * WSCALE);
            __builtin_nontemporal_store(o, (u32x2*)(t.dst + (size_t)(t.orow0 + n) * DM + t.k0 + 8 * c)); }
        else { u32x4 o; o.x = pk2(sp[0 * 65], sp[1 * 65]); o.y = pk2(sp[2 * 65], sp[3 * 65]); o.z = pk2(sp[4 * 65], sp[5 * 65]); o.w = pk2(sp[6 * 65], sp[7 * 65]);
            *(u32x4*)(t.dst + ((size_t)(t.orow0 + n) * DM + t.k0 + 8 * c) * 2) = o; } }
    asm volatile("s_waitcnt lgkmcnt(0)" ::: "memory");
}
__device__ __forceinline__ void rms_row_to_bf16(const float* xrow, const float* gain, bf16_t* orow, int lane) {
    const f32x4* xr = (const f32x4*)xrow + lane; const f32x4* gr = (const f32x4*)gain + lane;
    f32x4 v[4]; float s = 0.f;
#pragma unroll
    for (int j = 0; j < 4; ++j) { v[j] = xr[64 * j]; s += (v[j].x * v[j].x + v[j].y * v[j].y) + (v[j].z * v[j].z + v[j].w * v[j].w); }
    const float rs = frsq(wave_sum(s) * (1.f / DM) + EPS);
    unsigned long long* o8 = (unsigned long long*)orow + lane;
#pragma unroll
    for (int j = 0; j < 4; ++j) { const f32x4 g = gr[64 * j]; o8[64 * j] = (unsigned long long)pk2(v[j].x * rs * g.x, v[j].y * rs * g.y) | ((unsigned long long)pk2(v[j].z * rs * g.z, v[j].w * rs * g.w) << 32); }
}

__device__ __forceinline__ void rms_row2_to_bf16(const float* x0, const float* x1, const float* gain, bf16_t* o0, bf16_t* o1, int lane) {
    const f32x4* xa = (const f32x4*)x0 + lane; const f32x4* xb = (const f32x4*)x1 + lane; const f32x4* gr = (const f32x4*)gain + lane;
    f32x4 va[4], vb[4]; float sa = 0.f, sb = 0.f;
#pragma unroll
    for (int j = 0; j < 4; ++j) { va[j] = __builtin_nontemporal_load(xa + 64 * j); vb[j] = __builtin_nontemporal_load(xb + 64 * j); }
#pragma unroll
    for (int j = 0; j < 4; ++j) { sa += (va[j].x * va[j].x + va[j].y * va[j].y) + (va[j].z * va[j].z + va[j].w * va[j].w); sb += (vb[j].x * vb[j].x + vb[j].y * vb[j].y) + (vb[j].z * vb[j].z + vb[j].w * vb[j].w); }
    const float ra = frsq(wave_sum(sa) * (1.f / DM) + EPS), rb = frsq(wave_sum(sb) * (1.f / DM) + EPS);
    unsigned long long* pa = (unsigned long long*)o0 + lane; unsigned long long* pb = (unsigned long long*)o1 + lane;
#pragma unroll
    for (int j = 0; j < 4; ++j) { const f32x4 g = gr[64 * j];
        pa[64 * j] = (unsigned long long)pk2(va[j].x * ra * g.x, va[j].y * ra * g.y) | ((unsigned long long)pk2(va[j].z * ra * g.z, va[j].w * ra * g.w) << 32);
        pb[64 * j] = (unsigned long long)pk2(vb[j].x * rb * g.x, vb[j].y * rb * g.y) | ((unsigned long long)pk2(vb[j].z * rb * g.z, vb[j].w * rb * g.w) << 32); }
}
__device__ __forceinline__ void p0_prologue(Frame& F, const Args& a) {
    LAS float* scr = (LAS float*)(F.lds + F.wave * 16640);
    const int gw = F.vcu * NWAVES + F.wave, NGW = F.G * NWAVES;
    constexpr int NT = 16 * 44 + 16 * 16 + NEXP * 3 * 256;
    {
        f32x4 va[16], vb[16];
        int it = gw;
        TTile ta = p0_tile(a, F.ws, it < NT ? it : NT - 1), tb = ta;
        p0_load(va, ta, F.lane);
        while (it < NT) {
            int it2 = it + NGW;
            tb = p0_tile(a, F.ws, it2 < NT ? it2 : NT - 1); p0_load(vb, tb, F.lane);
            p0_store(va, ta, scr, F.lane);
            it = it2; if (it >= NT) break;
            it2 = it + NGW;
            ta = p0_tile(a, F.ws, it2 < NT ? it2 : NT - 1); p0_load(va, ta, F.lane);
            p0_store(vb, tb, scr, F.lane);
            it = it2;
        }
    }
    bf16_t* WRH = (bf16_t*)(F.ws + WS_WRT);
    for (int idx = blockIdx.x * NTHR + F.tid; idx < 48 * DM; idx += F.G * NTHR) { const int j = idx / DM, k = idx % DM; const float wv = j < 4 ? a.in[16][k * 4 + j] : (j < 36 ? a.in[18][k * 32 + (j - 4)] : 0.f); WRH[idx] = (bf16_t)f2bf(wv); }
    {
        bf16_t* WAT = (bf16_t*)(F.ws + WS_SMALL); bf16_t* WXT = WAT + 8 * 64 * 64; bf16_t* WUPT = WXT + 8 * 64 * 64;
        for (int idx = blockIdx.x * NTHR + F.tid; idx < 8 * 64 * 64; idx += F.G * NTHR) { const int h = idx >> 12, j = (idx >> 6) & 63, i = idx & 63;
            WAT[idx] = (bf16_t)f2bf(a.in[5][(h * 64 + i) * 64 + j]); WXT[idx] = (bf16_t)f2bf(a.in[7][(h * 64 + i) * 64 + j]); }
        for (int idx = blockIdx.x * NTHR + F.tid; idx < 256 * 32; idx += F.G * NTHR) { const int n = idx >> 5, k = idx & 31; WUPT[idx] = k < 16 ? (bf16_t)f2bf(a.in[11][k * 256 + n]) : (bf16_t)0; }
    }
    bf16_t* HN = (bf16_t*)(F.ws + WS_HN);
    for (int m = gw; m < NTOK; m += 2 * NGW) rms_row2_to_bf16(a.in[0] + (size_t)m * DM, a.in[0] + (size_t)(m + NGW) * DM, a.in[1], HN + (size_t)m * DM, HN + (size_t)(m + NGW) * DM, F.lane);
}

template <int KS> __device__ __forceinline__ f32x4 mma_ll(f32x4 acc, const LAS unsigned char* A, int lda, const LAS unsigned char* Bt, int ldb, int lane) {
    const LAS unsigned char* ap = A + (lane & 15) * lda + (lane >> 4) * 16; const LAS unsigned char* bp = Bt + (lane & 15) * ldb + (lane >> 4) * 16;
#pragma unroll
    for (int ks = 0; ks < KS; ++ks) acc = __builtin_amdgcn_mfma_f32_16x16x32_bf16(*(const LAS bf16x8*)(ap + ks * 64), *(const LAS bf16x8*)(bp + ks * 64), acc, 0, 0, 0);
    return acc;
}
template <int KS> __device__ __forceinline__ f32x4 mma_lg(f32x4 acc, const LAS unsigned char* A, int lda, const bf16_t* Bt, int ldb_elems, int lane) {
    const LAS unsigned char* ap = A + (lane & 15) * lda + (lane >> 4) * 16; const bf16_t* bp = Bt + (size_t)(lane & 15) * ldb_elems + (lane >> 4) * 8;
#pragma unroll
    for (int ks = 0; ks < KS; ++ks) acc = __builtin_amdgcn_mfma_f32_16x16x32_bf16(*(const LAS bf16x8*)(ap + ks * 64), *(const bf16x8*)(bp + ks * 32), acc, 0, 0, 0);
    return acc;
}
#define WAVE_LDS_FENCE() asm volatile("s_waitcnt lgkmcnt(0)" ::: "memory")
__device__ __forceinline__ float logsigmoidf_(float g) { return fminf(g, 0.f) - __logf(1.f + __expf(-fabsf(g))); }
__device__ __forceinline__ void unpack8(const u32x4 w, float (&f)[8]) { f[0] = bf2f(w.x & 0xffffu); f[1] = bf2f(w.x >> 16); f[2] = bf2f(w.y & 0xffffu); f[3] = bf2f(w.y >> 16); f[4] = bf2f(w.z & 0xffffu); f[5] = bf2f(w.z >> 16); f[6] = bf2f(w.w & 0xffffu); f[7] = bf2f(w.w >> 16); }
__device__ __forceinline__ u32x4 pack8(const float (&f)[8]) { u32x4 w; w.x = pk2(f[0], f[1]); w.y = pk2(f[2], f[3]); w.z = pk2(f[4], f[5]); w.w = pk2(f[6], f[7]); return w; }

constexpr int XS = 144;
constexpr int RG_AU = 8 * 64 * XS;
constexpr int GL_AL = 0, GL_BT = 5120, GL_T1 = 21504, GL_T2 = 30720, GL_T3 = 39936, GL_VT4 = 49152, GL_REGION = 67584;
static_assert(RG_AU + 8 * 8192 <= 143360 && 2 * GL_REGION <= 143360, "mixer LDS");

struct RgPre { bf16x8 ba0, ba1, bx0, bx1; float bias_a, bias_x, lamv, rgc; };
struct GlaPre { u32x4 al, v[4], k[2], q[2]; bf16x8 wup[4]; float bal[4]; };
template <bool FIN> __device__ __forceinline__ RgPre rg_pre(const unsigned char* ws, const Args& a, int chunk, int w, int nt, int c16, int g4) {
    const bf16_t* WAT = (const bf16_t*)(ws + WS_SMALL); const bf16_t* WXT = WAT + 8 * 64 * 64; const int ch = 64 * w + 16 * nt + c16;
    const bf16_t* wa = WAT + (size_t)ch * 64 + g4 * 8; const bf16_t* wx = WXT + (size_t)ch * 64 + g4 * 8;
    RgPre p; p.ba0 = *(const bf16x8*)wa; p.ba1 = *(const bf16x8*)(wa + 32); p.bx0 = *(const bf16x8*)wx; p.bx1 = *(const bf16x8*)(wx + 32);
    p.bias_a = a.in[6][ch]; p.bias_x = a.in[8][ch]; p.lamv = a.in[9][ch]; p.rgc = FIN ? ((const float*)(ws + WS_RGC))[(size_t)chunk * RGW + ch] : 0.f; return p;
}
template <bool FIN> __device__ __forceinline__ GlaPre gla_pre(const unsigned char* ws, const Args& a, int t0, int hh, int ht, int c16, int g4) {
    const bf16_t* PROJ = (const bf16_t*)(ws + WS_PROJ); const bf16_t* WUPT = (const bf16_t*)(ws + WS_SMALL) + 2 * 8 * 64 * 64;
    GlaPre p; asm volatile("" : "+v"(ht), "+v"(c16));
    { const int tok = (ht & 127) >> 1, half = ht & 1; p.al = *(const u32x4*)(PROJ + (size_t)(t0 + tok) * LDP + C_AL + 8 * half); }
#pragma unroll
    for (int i = 0; i < 2; ++i) { const int idx = ht + 256 * i, ec = idx >> 5, tp = idx & 31;
        p.v[2 * i] = *(const u32x4*)(PROJ + (size_t)(t0 + 2 * tp) * LDP + C_V + hh * 128 + 8 * ec); p.v[2 * i + 1] = *(const u32x4*)(PROJ + (size_t)(t0 + 2 * tp + 1) * LDP + C_V + hh * 128 + 8 * ec); }
    if (FIN) {
#pragma unroll
        for (int i = 0; i < 2; ++i) { const int idx = ht + 256 * i, tok = idx >> 3, dc = idx & 7;
            p.k[i] = *(const u32x4*)(PROJ + (size_t)(t0 + tok) * LDP + C_K + hh * 64 + 8 * dc); p.q[i] = *(const u32x4*)(PROJ + (size_t)(t0 + tok) * LDP + C_Q + hh * 64 + 8 * dc); }
    } else { const int dc = ht >> 5, tp = ht & 31;
        p.k[0] = *(const u32x4*)(PROJ + (size_t)(t0 + 2 * tp) * LDP + C_K + hh * 64 + 8 * dc); p.k[1] = *(const u32x4*)(PROJ + (size_t)(t0 + 2 * tp + 1) * LDP + C_K + hh * 64 + 8 * dc);
        p.q[0] = (u32x4){0u, 0u, 0u, 0u}; p.q[1] = p.q[0]; }
#pragma unroll
    for (int nt = 0; nt < 4; ++nt) { p.wup[nt] = *(const bf16x8*)(WUPT + (size_t)(hh * 64 + 16 * nt + c16) * 32 + g4 * 8); p.bal[nt] = a.in[12][hh * 64 + 16 * nt + c16]; }
    return p;
}
__device__ __forceinline__ void ld8f(const LAS float* p, float (&f)[8]) { const f32x4 x = *(const LAS f32x4*)p, y = *(const LAS f32x4*)(p + 4); f[0] = x.x; f[1] = x.y; f[2] = x.z; f[3] = x.w; f[4] = y.x; f[5] = y.y; f[6] = y.z; f[7] = y.w; }

template <bool FIN> __device__ __forceinline__ void mixer_chunk(Frame& F, const Args& a, const int chunk) {
    const bf16_t* PROJ = (const bf16_t*)(F.ws + WS_PROJ); bf16_t* Y = (bf16_t*)(F.ws + WS_HN);
    const int t0 = chunk * 64, nloc = chunk & 127, lane = F.lane, w = F.wave, c16 = lane & 15, g4 = lane >> 4;
    LAS unsigned char* L = F.lds;
    const int s = w >> 2, q4 = w & 3, ht = F.tid & 255;
    GlaPre gp;
    if (FIN) { TPS(F, 100); TPS(F, 110); } else { TPS(F, 120); TPS(F, 130); }
    {
        LAS unsigned char* slab = L + w * (64 * XS);
        LAS float* au_a = (LAS float*)(L + RG_AU + w * 8192); LAS float* au_u = au_a + 1024;
        const int cg = lane & 7, gq = lane >> 3, ch0 = 64 * w + 8 * cg;
        u32x4 xrow[11];
#pragma unroll
        for (int r = 0; r < 11; ++r) { const int tl = nloc * 64 + 8 * gq - 3 + r; xrow[r] = (tl >= 0) ? *(const u32x4*)(PROJ + (size_t)(t0 + 8 * gq - 3 + r) * LDP + C_XR + ch0) : (u32x4){0u, 0u, 0u, 0u}; }
        f32x4 cwv[4][2], cbv[2];
#pragma unroll
        for (int j = 0; j < 4; ++j) { cwv[j][0] = *(const f32x4*)(a.in[3] + j * RGW + ch0); cwv[j][1] = *(const f32x4*)(a.in[3] + j * RGW + ch0 + 4); }
        cbv[0] = *(const f32x4*)(a.in[4] + ch0); cbv[1] = *(const f32x4*)(a.in[4] + ch0 + 4);
        RgPre cur = rg_pre<FIN>(F.ws, a, chunk, w, 0, c16, g4);
#pragma unroll
        for (int it = 0; it < 8; ++it) {
            float xc[8] = {cbv[0].x, cbv[0].y, cbv[0].z, cbv[0].w, cbv[1].x, cbv[1].y, cbv[1].z, cbv[1].w};
#pragma unroll
            for (int j = 0; j < 4; ++j) { float xv[8]; unpack8(xrow[it + j], xv);
                xc[0] += cwv[j][0].x * xv[0]; xc[1] += cwv[j][0].y * xv[1]; xc[2] += cwv[j][0].z * xv[2]; xc[3] += cwv[j][0].w * xv[3];
                xc[4] += cwv[j][1].x * xv[4]; xc[5] += cwv[j][1].y * xv[5]; xc[6] += cwv[j][1].z * xv[6]; xc[7] += cwv[j][1].w * xv[7]; }
            *(LAS u32x4*)(slab + (8 * gq + it) * XS + cg * 16) = pack8(xc);
        }
        u32x4 yrv[8]; f32x4 gnv[2];
        if (FIN) {
#pragma unroll
            for (int i = 0; i < 8; ++i) yrv[i] = *(const u32x4*)(PROJ + (size_t)(t0 + 8 * w + i) * LDP + C_YR + 8 * lane);
            gnv[0] = *(const f32x4*)(a.in[10] + 8 * lane); gnv[1] = *(const f32x4*)(a.in[10] + 8 * lane + 4);
        }
        WAVE_LDS_FENCE();
        bf16x8 af[4][2];
#pragma unroll
        for (int mt = 0; mt < 4; ++mt)
#pragma unroll
            for (int ks = 0; ks < 2; ++ks) af[mt][ks] = *(const LAS bf16x8*)(slab + (16 * mt + c16) * XS + ks * 64 + g4 * 16);
        float* RGSA = (float*)(F.ws + WS_RGSA); float* RGSH = (float*)(F.ws + WS_RGSH);
        if (FIN) { TPE(F, 100); TPS(F, 101); } else { TPE(F, 120); TPS(F, 121); }
#pragma unroll 1
        for (int nt = 0; nt < 4; ++nt) {
            const RgPre nxt = rg_pre<FIN>(F.ws, a, chunk, w, nt < 3 ? nt + 1 : 3, c16, g4);
            const int ch = 64 * w + 16 * nt + c16;
            const float sp8 = 8.f * log1pf(__expf(-cur.lamv));
            float xcq[4][4];
#pragma unroll
            for (int mt = 0; mt < 4; ++mt)
#pragma unroll
                for (int r = 0; r < 4; ++r) xcq[mt][r] = bf2f(*(const LAS unsigned short*)(slab + (16 * mt + 4 * g4 + r) * XS + (16 * nt + c16) * 2));
#pragma unroll
            for (int mt = 0; mt < 4; ++mt) {
                f32x4 R = {0.f, 0.f, 0.f, 0.f}, I = {0.f, 0.f, 0.f, 0.f};
                R = __builtin_amdgcn_mfma_f32_16x16x32_bf16(af[mt][0], cur.ba0, R, 0, 0, 0); R = __builtin_amdgcn_mfma_f32_16x16x32_bf16(af[mt][1], cur.ba1, R, 0, 0, 0);
                I = __builtin_amdgcn_mfma_f32_16x16x32_bf16(af[mt][0], cur.bx0, I, 0, 0, 0); I = __builtin_amdgcn_mfma_f32_16x16x32_bf16(af[mt][1], cur.bx1, I, 0, 0, 0);
#pragma unroll
                for (int r = 0; r < 4; ++r) { const int tok = 16 * mt + 4 * g4 + r;
                    const float rr = sigmoidf_(R[r] + cur.bias_a), ii = sigmoidf_(I[r] + cur.bias_x);
                    const float x2 = -2.f * sp8 * rr;
                    const float av = __expf(0.5f * x2);
                    const float om = (x2 > -0.1f) ? -x2 * (1.f + x2 * (0.5f + x2 * (0.16666667f + x2 * 0.041666668f))) : 1.f - __expf(x2);
                    const float xcv = xcq[mt][r];
                    au_a[tok * 16 + c16] = av; au_u[tok * 16 + c16] = __builtin_amdgcn_sqrtf(om) * (ii * xcv); }
            }
            WAVE_LDS_FENCE();
            {
                float av[16], uv[16]; float P = 1.f, H = 0.f;
#pragma unroll
                for (int i = 0; i < 16; ++i) { av[i] = au_a[(16 * g4 + i) * 16 + c16]; uv[i] = au_u[(16 * g4 + i) * 16 + c16]; }
#pragma unroll
                for (int i = 0; i < 16; ++i) { H = av[i] * H + uv[i]; P *= av[i]; }
                float hin = cur.rgc, Pall = 1.f;
#pragma unroll
                for (int j = 0; j < 4; ++j) { const float Pj = __shfl(P, c16 + 16 * j), Hj = __shfl(H, c16 + 16 * j); if (j < g4) hin = Pj * hin + Hj; Pall *= Pj; }
                if (FIN) { float h = hin;
#pragma unroll
                    for (int i = 0; i < 16; ++i) { h = av[i] * h + uv[i]; *(LAS unsigned short*)(slab + (16 * g4 + i) * XS + (16 * nt + c16) * 2) = (unsigned short)f2bf(h); } }
                else if (g4 == 3) { RGSA[(size_t)chunk * RGW + ch] = Pall; RGSH[(size_t)chunk * RGW + ch] = P * hin + H; }
            }
            WAVE_LDS_FENCE();
            cur = nxt;
        }
        if (FIN) { TPE(F, 101); TPS(F, 102); } else { TPE(F, 121); }
        gp = gla_pre<FIN>(F.ws, a, t0, s, ht, c16, g4);
        if (FIN) {
            __syncthreads();
            int lq = lane; asm volatile("" : "+v"(lq));
#pragma unroll 2
            for (int i = 0; i < 8; ++i) { const int tok = 8 * w + i;
                float hv[8], yv[8]; unpack8(*(const LAS u32x4*)(L + (lq >> 3) * (64 * XS) + tok * XS + (lq & 7) * 16), hv); unpack8(yrv[i], yv);
                float ss = 0.f;
#pragma unroll
                for (int j = 0; j < 8; ++j) { hv[j] *= gelu_tanh(yv[j]); ss += hv[j] * hv[j]; }
                const float rs = frsq(wave_sum(ss) * (1.f / 512.f) + EPS);
                hv[0] *= rs * gnv[0].x; hv[1] *= rs * gnv[0].y; hv[2] *= rs * gnv[0].z; hv[3] *= rs * gnv[0].w; hv[4] *= rs * gnv[1].x; hv[5] *= rs * gnv[1].y; hv[6] *= rs * gnv[1].z; hv[7] *= rs * gnv[1].w;
                *(u32x4*)(Y + (size_t)(t0 + tok) * DM + 8 * lq) = pack8(hv); }
        }
        __syncthreads();
    }
    if (FIN) { TPE(F, 102); TPE(F, 110); TPS(F, 103); } else { TPE(F, 130); TPS(F, 123); }
    bf16_t* KVT = (bf16_t*)(F.ws + WS_KVT); float* DEC = (float*)(F.ws + WS_DEC); const bf16_t* ST = (const bf16_t*)(F.ws + WS_ST);
#pragma unroll
    for (int pass = 0; pass < 2; ++pass) {
        const int hh = 2 * pass + s;
        LAS unsigned char* R = L + s * GL_REGION;
        LAS float* BT = (LAS float*)(R + GL_BT);
        LAS unsigned char* VT = R + (FIN ? GL_VT4 : GL_T2);
        if (FIN) TPS(F, 140);
        if (ht < 128) { const int tok = ht >> 1, half = ht & 1; *(LAS u32x4*)(R + GL_AL + tok * 80 + half * 16) = gp.al; *(LAS u32x4*)(R + GL_AL + tok * 80 + 32 + half * 16) = (u32x4){0u, 0u, 0u, 0u}; }
#pragma unroll
        for (int i = 0; i < 2; ++i) { const int idx = ht + 256 * i, ec = idx >> 5, tp = idx & 31; const u32x4 v0 = gp.v[2 * i], v1 = gp.v[2 * i + 1];
            LAS unsigned* vt = (LAS unsigned*)(VT + (8 * ec) * XS + tp * 4);
            vt[0 * (XS / 4)] = (v0.x & 0xffffu) | (v1.x << 16); vt[1 * (XS / 4)] = (v0.x >> 16) | (v1.x & 0xffff0000u); vt[2 * (XS / 4)] = (v0.y & 0xffffu) | (v1.y << 16); vt[3 * (XS / 4)] = (v0.y >> 16) | (v1.y & 0xffff0000u);
            vt[4 * (XS / 4)] = (v0.z & 0xffffu) | (v1.z << 16); vt[5 * (XS / 4)] = (v0.z >> 16) | (v1.z & 0xffff0000u); vt[6 * (XS / 4)] = (v0.w & 0xffffu) | (v1.w << 16); vt[7 * (XS / 4)] = (v0.w >> 16) | (v1.w & 0xffff0000u); }
        __syncthreads();
        if (FIN) { TPE(F, 140); TPS(F, 141); }
        { const bf16x8 afr = *(const LAS bf16x8*)(R + GL_AL + (16 * q4 + c16) * 80 + g4 * 16);
#pragma unroll
          for (int nt = 0; nt < 4; ++nt) { f32x4 acc = {0.f, 0.f, 0.f, 0.f}; acc = __builtin_amdgcn_mfma_f32_16x16x32_bf16(afr, gp.wup[nt], acc, 0, 0, 0);
#pragma unroll
            for (int r = 0; r < 4; ++r) BT[(16 * q4 + 4 * g4 + r) * 64 + 16 * nt + c16] = logsigmoidf_(acc[r] + gp.bal[nt]) * (1.f / 16.f); } }
        __syncthreads();
        if (FIN) { TPE(F, 141); TPS(F, 142); }
        if (q4 == 0) { float cv[64];
#pragma unroll
            for (int tok = 0; tok < 64; ++tok) cv[tok] = BT[tok * 64 + lane];
#pragma unroll
            for (int tok = 1; tok < 64; ++tok) cv[tok] += cv[tok - 1];
#pragma unroll
            for (int tok = 0; tok < 64; ++tok) BT[tok * 64 + lane] = cv[tok]; }
        bf16x8 stf[8][2]; u32x4 gv4[4]; float gnl[8];
        if (FIN) { int htq = ht, c16q = c16; asm volatile("" : "+v"(htq), "+v"(c16q));
            const bf16_t* st = ST + (size_t)(chunk * 4 + hh) * 128 * 64;
#pragma unroll
            for (int nt = 0; nt < 8; ++nt) { stf[nt][0] = *(const bf16x8*)(st + (size_t)(16 * nt + c16q) * 64 + g4 * 8); stf[nt][1] = *(const bf16x8*)(st + (size_t)(16 * nt + c16q) * 64 + g4 * 8 + 32); gnl[nt] = a.in[13][16 * nt + c16q]; }
#pragma unroll
            for (int i = 0; i < 4; ++i) { const int idx = htq + 256 * i, tok = idx >> 4, ec = idx & 15; gv4[i] = *(const u32x4*)(PROJ + (size_t)(t0 + tok) * LDP + C_G + hh * 128 + 8 * ec); } }
        __syncthreads();
        if (FIN) { TPE(F, 142); TPS(F, 143); }
        if (!FIN) { const int dc = ht >> 5, tp = ht & 31;
            float b0[8], b1[8], bl[8], k0[8], k1[8]; ld8f(BT + (2 * tp) * 64 + 8 * dc, b0); ld8f(BT + (2 * tp + 1) * 64 + 8 * dc, b1); ld8f(BT + 63 * 64 + 8 * dc, bl); unpack8(gp.k[0], k0); unpack8(gp.k[1], k1);
            LAS unsigned* ke = (LAS unsigned*)(R + GL_T1 + (8 * dc) * XS + tp * 4);
#pragma unroll
            for (int j = 0; j < 8; ++j) ke[j * (XS / 4)] = pk2(k0[j] * __expf(bl[j] - b0[j]), k1[j] * __expf(bl[j] - b1[j]));
            if (ht < 64) DEC[(size_t)(chunk * 4 + hh) * 64 + ht] = __expf(BT[63 * 64 + ht]);
        } else {
#pragma unroll
            for (int i = 0; i < 2; ++i) { const int idx = ht + 256 * i, tok = idx >> 3, dc = idx & 7;
                float bv[8], kv[8], qv[8]; ld8f(BT + tok * 64 + 8 * dc, bv); unpack8(gp.k[i], kv); unpack8(gp.q[i], qv);
#pragma unroll
                for (int j = 0; j < 8; ++j) { const float eb = __expf(bv[j]); qv[j] *= 0.125f * eb; kv[j] *= __expf(-bv[j]); }
                *(LAS u32x4*)(R + GL_T1 + tok * XS + dc * 16) = pack8(qv); *(LAS u32x4*)(R + GL_T2 + tok * XS + dc * 16) = pack8(kv); }
        }
        if (pass == 0) gp = gla_pre<FIN>(F.ws, a, t0, 2 + s, ht, c16, g4);
        __syncthreads();
        if (FIN) { TPE(F, 143); TPS(F, 144); }
        if (FIN) TPS(F, 105);
        if (!FIN) {
#pragma unroll
            for (int mi = 0; mi < 2; ++mi) { const int mt = 2 * q4 + mi;
#pragma unroll
                for (int nt = 0; nt < 4; ++nt) { f32x4 acc = {0.f, 0.f, 0.f, 0.f}; acc = mma_ll<2>(acc, VT + (16 * mt) * XS, XS, R + GL_T1 + (16 * nt) * XS, XS, lane);
#pragma unroll
                    for (int r = 0; r < 4; ++r) KVT[((size_t)(chunk * 4 + hh) * 128 + 16 * mt + 4 * g4 + r) * 64 + 16 * nt + c16] = (bf16_t)f2bf(acc[r]); } }
        } else {
#pragma unroll
            for (int nt = 0; nt < 4; ++nt) { f32x4 acc = {0.f, 0.f, 0.f, 0.f}; acc = mma_ll<2>(acc, R + GL_T2 + (16 * q4) * XS, XS, R + GL_T1 + (16 * nt) * XS, XS, lane);
                const int i = 16 * nt + c16, j0 = 16 * q4 + 4 * g4;
                u32x2 pw; pw.x = pk2(j0 <= i ? acc[0] : 0.f, j0 + 1 <= i ? acc[1] : 0.f); pw.y = pk2(j0 + 2 <= i ? acc[2] : 0.f, j0 + 3 <= i ? acc[3] : 0.f);
                *(LAS u32x2*)(R + GL_T3 + i * XS + j0 * 2) = pw; }
            __syncthreads();
            if (FIN) { TPE(F, 144); TPS(F, 145); }
            f32x4 o[8];
            { const bf16x8 qa0 = *(const LAS bf16x8*)(R + GL_T1 + (16 * q4 + c16) * XS + g4 * 16), qa1 = *(const LAS bf16x8*)(R + GL_T1 + (16 * q4 + c16) * XS + 64 + g4 * 16);
#pragma unroll
              for (int nt = 0; nt < 8; ++nt) { f32x4 acc = {0.f, 0.f, 0.f, 0.f};
                acc = mma_ll<2>(acc, R + GL_T3 + (16 * q4) * XS, XS, VT + (16 * nt) * XS, XS, lane);
                acc = __builtin_amdgcn_mfma_f32_16x16x32_bf16(qa0, stf[nt][0], acc, 0, 0, 0); acc = __builtin_amdgcn_mfma_f32_16x16x32_bf16(qa1, stf[nt][1], acc, 0, 0, 0);
                o[nt] = acc; } }
            float rs[4];
#pragma unroll
            for (int r = 0; r < 4; ++r) { float ss = 0.f;
#pragma unroll
                for (int nt = 0; nt < 8; ++nt) ss += o[nt][r] * o[nt][r];
                ss += __shfl_xor(ss, 1); ss += __shfl_xor(ss, 2); ss += __shfl_xor(ss, 4); ss += __shfl_xor(ss, 8);
                rs[r] = frsq(ss * (1.f / 128.f) + EPS); }
            LAS unsigned short* OY = (LAS unsigned short*)(R + GL_BT);
#pragma unroll
            for (int nt = 0; nt < 8; ++nt)
#pragma unroll
                for (int r = 0; r < 4; ++r) OY[(16 * q4 + 4 * g4 + r) * 128 + 16 * nt + c16] = (unsigned short)f2bf(o[nt][r] * rs[r] * gnl[nt]);
            __syncthreads();
            if (FIN) { TPE(F, 145); TPS(F, 146); }
            int hts = ht; asm volatile("" : "+v"(hts));
#pragma unroll
            for (int i = 0; i < 4; ++i) { const int idx = hts + 256 * i, tok = idx >> 4, ec = idx & 15;
                float ov[8], gv[8]; unpack8(*(const LAS u32x4*)(OY + tok * 128 + 8 * ec), ov); unpack8(gv4[i], gv);
#pragma unroll
                for (int j = 0; j < 8; ++j) ov[j] *= gv[j] * sigmoidf_(gv[j]);
                *(u32x4*)(Y + (size_t)(t0 + tok) * DM + 512 + hh * 128 + 8 * ec) = pack8(ov); }
        }
        __syncthreads();
        if (FIN) TPE(F, 146);
        if (FIN) TPE(F, 105);
    }
    if (FIN) TPE(F, 103); else TPE(F, 123);
}

__device__ __forceinline__ void m3_scan(Frame& F) {
    const bf16_t* KVT = (const bf16_t*)(F.ws + WS_KVT); const float* DEC = (const float*)(F.ws + WS_DEC); bf16_t* ST = (bf16_t*)(F.ws + WS_ST);
    const float* RGSA = (const float*)(F.ws + WS_RGSA); const float* RGSH = (const float*)(F.ws + WS_RGSH); float* RGC = (float*)(F.ws + WS_RGC);
    const int bx = blockIdx.x;
    if (F.tid < 256) {
        for (int id = bx * 256 + F.tid; id < 65536; id += F.G * 256) {
            const int d = id & 63, e = (id >> 6) & 127, bh = id >> 13, b = bh >> 2, hh = bh & 3;
            float sv = 0.f;
            for (int n = 0; n < 128; n += 16) {
                float kv[16], dc[16];
#pragma unroll
                for (int q = 0; q < 16; ++q) { const size_t ch = (size_t)((b * 128 + n + q) * 4 + hh); kv[q] = bf2f(__builtin_nontemporal_load(KVT + (ch * 128 + e) * 64 + d)); dc[q] = DEC[ch * 64 + d]; }
#pragma unroll
                for (int q = 0; q < 16; ++q) { const size_t ch = (size_t)((b * 128 + n + q) * 4 + hh); ST[(ch * 128 + e) * 64 + d] = (bf16_t)f2bf(sv); sv = dc[q] * sv + kv[q]; }
            }
        }
    } else if (bx < 4) {
        const int id = bx * 256 + (F.tid - 256), b = id >> 9, ch = id & 511;
        float h = 0.f;
        for (int n = 0; n < 128; n += 16) {
            float av[16], hv[16];
#pragma unroll
            for (int q = 0; q < 16; ++q) { const size_t o = (size_t)(b * 128 + n + q) * RGW + ch; av[q] = RGSA[o]; hv[q] = RGSH[o]; }
#pragma unroll
            for (int q = 0; q < 16; ++q) { const size_t o = (size_t)(b * 128 + n + q) * RGW + ch; RGC[o] = h; h = av[q] * h + hv[q]; }
        }
    }
}

__device__ __forceinline__ void p6_router(Frame& F, const Args& a) {
    const bf16_t* Hb = (const bf16_t*)(F.ws + WS_HB); unsigned char* HN8 = F.ws + WS_HN; const bf16_t* WRH = (const bf16_t*)(F.ws + WS_WRT);
    const float* gain = a.in[15]; const float* bg = a.in[17]; const float* be = a.in[19];
    int* STOK = (int*)(F.ws + WS_STOK); float* SW = (float*)(F.ws + WS_SW); int* TIDX = (int*)(F.ws + WS_TIDX); float* RS = (float*)(F.ws + WS_RS);
    unsigned* gcnt = F.ctl + CW_GCNT;
    LAS float* part = (LAS float*)F.lds;
    LAS float* ssp = part + 8 * 64 * 48;
    LAS int* lcnt = (LAS int*)(ssp + 512); LAS int* lbase = lcnt + 32; LAS int* rec_e = lbase + 32; LAS int* rec_l = rec_e + 128; LAS float* rec_w = (LAS float*)(rec_l + 128);
    const int lane = F.lane, c16 = lane & 15, g4 = lane >> 4, kq = F.wave;
    for (int grp = blockIdx.x; grp < NTOK / 64; grp += F.G) {
        if (F.tid < 32) lcnt[F.tid] = 0;
        TPS(F, 160);
        for (int rep = 0; rep < 1 + (int)((REP_MASK >> 6) & 1u); ++rep) {
            if (rep) __syncthreads();
            bf16x8 wh[4][3]; f32x4 gk[4][2]; u32x4 hq[4], hn[4];
#pragma unroll
            for (int ks = 0; ks < 4; ++ks) hq[ks] = *(const u32x4*)(Hb + (size_t)(grp * 64 + c16) * DM + 128 * kq + 32 * ks + 8 * g4);
#pragma unroll
            for (int ks = 0; ks < 4; ++ks) { const int k0 = 128 * kq + 32 * ks + 8 * g4; gk[ks][0] = *(const f32x4*)(gain + k0); gk[ks][1] = *(const f32x4*)(gain + k0 + 4);
#pragma unroll
                for (int nt = 0; nt < 3; ++nt) wh[ks][nt] = *(const bf16x8*)(WRH + (size_t)(16 * nt + c16) * DM + k0); }
#pragma unroll 1
            for (int mt = 0; mt < 4; ++mt) {
                int c16 = lane & 15, g4 = lane >> 4; asm volatile("" : "+v"(c16), "+v"(g4));
                const int t = grp * 64 + 16 * mt + c16;
                { const int mn = mt < 3 ? mt + 1 : 3;
#pragma unroll
                  for (int ks = 0; ks < 4; ++ks) hn[ks] = *(const u32x4*)(Hb + (size_t)(grp * 64 + 16 * mn + c16) * DM + 128 * kq + 32 * ks + 8 * g4); }
                f32x4 acc[3] = {{0.f, 0.f, 0.f, 0.f}, {0.f, 0.f, 0.f, 0.f}, {0.f, 0.f, 0.f, 0.f}}; float ss = 0.f;
#pragma unroll
                for (int ks = 0; ks < 4; ++ks) {
                    const int k0 = 128 * kq + 32 * ks + 8 * g4; const f32x4 g0 = gk[ks][0], g1 = gk[ks][1]; float hf[8]; unpack8(hq[ks], hf);
                    ss += (hf[0] * hf[0] + hf[1] * hf[1]) + (hf[2] * hf[2] + hf[3] * hf[3]) + (hf[4] * hf[4] + hf[5] * hf[5]) + (hf[6] * hf[6] + hf[7] * hf[7]);
                    float v[8] = {hf[0] * g0.x, hf[1] * g0.y, hf[2] * g0.z, hf[3] * g0.w, hf[4] * g1.x, hf[5] * g1.y, hf[6] * g1.z, hf[7] * g1.w};
                    bf16x8 ahi, alo;
#pragma unroll
                    for (int j = 0; j < 8; ++j) { const unsigned hi = f2bf(v[j]); ahi[j] = (short)hi; alo[j] = (short)f2bf(v[j] - bf2f(hi)); }
                    { u32x2 p8; p8.x = pk4_fp8(v[0], v[1], v[2], v[3]); p8.y = pk4_fp8(v[4], v[5], v[6], v[7]); *(u32x2*)(HN8 + (size_t)t * DM + k0) = p8; }
#pragma unroll
                    for (int nt = 0; nt < 3; ++nt) {
                        acc[nt] = __builtin_amdgcn_mfma_f32_16x16x32_bf16(ahi, wh[ks][nt], acc[nt], 0, 0, 0); acc[nt] = __builtin_amdgcn_mfma_f32_16x16x32_bf16(alo, wh[ks][nt], acc[nt], 0, 0, 0); }
                }
                ss += __shfl_xor(ss, 16); ss += __shfl_xor(ss, 32);
                if (g4 == 0) ssp[kq * 64 + 16 * mt + c16] = ss;
#pragma unroll
                for (int nt = 0; nt < 3; ++nt)
#pragma unroll
                    for (int r = 0; r < 4; ++r) part[(kq * 64 + 16 * mt + 4 * g4 + r) * 48 + 16 * nt + c16] = acc[nt][r];
#pragma unroll
                for (int ks = 0; ks < 4; ++ks) hq[ks] = hn[ks];
            }
        }
        __syncthreads();
        TPE(F, 160); TPS(F, 161);
        if (F.tid < 64) {
            const int tl = F.tid, t = grp * 64 + tl;
            float ssq = 0.f;
#pragma unroll
            for (int q = 0; q < 8; ++q) ssq += ssp[q * 64 + tl];
            const float rs = frsq(ssq * (1.f / DM) + EPS);
            RS[t] = rs;
            float lg[36];
#pragma unroll
            for (int o = 0; o < 36; ++o) lg[o] = 0.f;
#pragma unroll 1
            for (int q = 0; q < 8; ++q) { const LAS float* pp = part + (q * 64 + tl) * 48;
#pragma unroll
                for (int o = 0; o < 36; ++o) lg[o] += pp[o]; }
#pragma unroll
            for (int o = 0; o < 36; ++o) lg[o] *= rs;
            float gl[4];
#pragma unroll
            for (int q = 0; q < 4; ++q) gl[q] = lg[q] + bg[q];
            int gi = 0; float gm = gl[0];
#pragma unroll
            for (int q = 1; q < 4; ++q) if (gl[q] > gm) { gm = gl[q]; gi = q; }
            float gs = 0.f;
#pragma unroll
            for (int q = 0; q < 4; ++q) gs += expf(gl[q] - gm);
            const float gwt = 1.f / gs;
            float le[8];
#pragma unroll
            for (int q = 0; q < 8; ++q) { float x = lg[4 + q] + be[q];
#pragma unroll
                for (int g2 = 1; g2 < 4; ++g2) x = (gi == g2) ? (lg[4 + g2 * 8 + q] + be[g2 * 8 + q]) : x;
                le[q] = x; }
            int i1 = 0; float m1 = le[0];
#pragma unroll
            for (int q = 1; q < 8; ++q) if (le[q] > m1) { m1 = le[q]; i1 = q; }
            int i2 = -1; float m2 = -3.0e38f;
#pragma unroll
            for (int q = 0; q < 8; ++q) if (q != i1 && le[q] > m2) { m2 = le[q]; i2 = q; }
            const float e2 = expf(m2 - m1), inv = 1.f / (1.f + e2);
            const int ea = gi * 8 + i1, eb = gi * 8 + i2;
            const int la_ = __hip_atomic_fetch_add(lcnt + ea, 1, __ATOMIC_RELAXED, __HIP_MEMORY_SCOPE_WORKGROUP), lb_ = __hip_atomic_fetch_add(lcnt + eb, 1, __ATOMIC_RELAXED, __HIP_MEMORY_SCOPE_WORKGROUP);
            rec_e[tl * 2] = ea; rec_l[tl * 2] = la_; rec_w[tl * 2] = gwt * inv; rec_e[tl * 2 + 1] = eb; rec_l[tl * 2 + 1] = lb_; rec_w[tl * 2 + 1] = gwt * e2 * inv;
        }
        __syncthreads();
        TPE(F, 161); TPS(F, 162);
        if (F.tid < 32) { const int cnum = lcnt[F.tid]; lbase[F.tid] = cnum ? (int)__hip_atomic_fetch_add(gcnt + F.tid, (unsigned)cnum, __ATOMIC_RELAXED, __HIP_MEMORY_SCOPE_AGENT) : 0; }
        __syncthreads();
        if (F.tid < 128) { const int e = rec_e[F.tid], idx = e * CAP + lbase[e] + rec_l[F.tid], t = grp * 64 + (F.tid >> 1);
            STOK[idx] = t; SW[idx] = rec_w[F.tid]; TIDX[t * 2 + (F.tid & 1)] = idx; }
        __syncthreads();
        TPE(F, 162);
    }
}

__device__ __forceinline__ int moe_setup(Frame& F, int ncol_log2, bool tables, bool scale_is_rs) {
    const unsigned* gcnt = F.ctl + CW_GCNT;
    LAS int* lcnt = (LAS int*)(F.lds + L_CNT); LAS int* tst = (LAS int*)(F.lds + L_TST); LAS int* utab = (LAS int*)(F.lds + L_UTAB);
    LAS unsigned* rowt = (LAS unsigned*)(F.lds + L_ROWT); LAS float* wt = (LAS float*)(F.lds + L_WT);
    const int* STOK = (const int*)(F.ws + WS_STOK); const float* SW = (const float*)(F.ws + WS_SW); const float* RS = (const float*)(F.ws + WS_RS);
    if (F.tid < 32) lcnt[F.tid] = (int)__hip_atomic_load(gcnt + F.tid, __ATOMIC_RELAXED, __HIP_MEMORY_SCOPE_AGENT);
    __syncthreads();
    if (F.tid == 0) { int s = 0; for (int e = 0; e < 32; ++e) { tst[e] = s; s += (lcnt[e] + 255) >> 8; } tst[32] = s; }
    __syncthreads();
    if (!tables) return 0;
    const int total = tst[32] << ncol_log2;
    int nu = 0;
    for (int ui = 0; ui < MAXU; ++ui) if (ui * F.G + F.vcu < total) ++nu;
    if (F.tid < nu) { const int ui = F.tid, Lq = ui * F.G + F.vcu, rb = Lq >> ncol_log2, pn = Lq & ((1 << ncol_log2) - 1);
        int e = 0;
        for (int j = 1; j < 32; ++j) e += (tst[j] <= rb) ? 1 : 0;
        const int r0 = (rb - tst[e]) * 256; int rows = lcnt[e] - r0; rows = rows > 256 ? 256 : rows;
        utab[ui * 8 + 0] = rb; utab[ui * 8 + 1] = pn; utab[ui * 8 + 2] = e; utab[ui * 8 + 3] = rows; utab[ui * 8 + 4] = r0; }
    __syncthreads();
    constexpr int NE = MAXU / 2;
    int tok[NE], idx[NE]; bool ok[NE]; float sc[NE];
#pragma unroll
    for (int j = 0; j < NE; ++j) { const int ent = F.tid + 512 * j, ui = ent >> 8, r = ent & 255; ok[j] = false; tok[j] = 0; idx[j] = 0;
        if (ui < nu) { const int e = utab[ui * 8 + 2], rows = utab[ui * 8 + 3], r0 = utab[ui * 8 + 4]; ok[j] = r < rows; idx[j] = e * CAP + r0 + r; } }
#pragma unroll
    for (int j = 0; j < NE; ++j) { tok[j] = ok[j] ? STOK[idx[j]] : 0; sc[j] = (ok[j] && !scale_is_rs) ? SW[idx[j]] : 0.f; }
    if (scale_is_rs) {
#pragma unroll
        for (int j = 0; j < NE; ++j) sc[j] = ok[j] ? RS[tok[j]] : 0.f;
    }
#pragma unroll
    for (int j = 0; j < NE; ++j) { const int ent = F.tid + 512 * j; if ((ent >> 8) < nu) { rowt[ent] = (unsigned)tok[j] * (unsigned)DM;     wt[ent] = sc[j]; } }
    __syncthreads();
    return nu;
}

__device__ __forceinline__ void p9_final(Frame& F, const Args& a) {
    const LAS int* tst = (const LAS int*)(F.lds + L_TST);
    const int* TIDX = (const int*)(F.ws + WS_TIDX); const unsigned char* YB = F.ws + WS_YB; const bf16_t* HB = (const bf16_t*)(F.ws + WS_HB); const float* gain = a.in[23];
    const int gw = F.vcu * NWAVES + F.wave, NGW = F.G * NWAVES, lane = F.lane;
    const f32x4* gr = (const f32x4*)gain + lane;
    f32x4 gq[4];
#pragma unroll
    for (int q = 0; q < 4; ++q) gq[q] = gr[64 * q];
    for (int tb = gw; tb < NTOK; tb += 8 * NGW) {
        int myidx = 0; { const int t = tb + NGW * (lane >> 1); if (lane < 16 && t < NTOK) myidx = TIDX[t * 2 + (lane & 1)]; }
        const int mys = tst[myidx >> 14] * 256 + (myidx & (CAP - 1));
#pragma unroll 1
        for (int jp = 0; jp < 8; jp += 2) {
            const int ta = tb + NGW * jp, tc = ta + NGW; if (ta >= NTOK) break;
            const bool two = tc < NTOK;
            const size_t sa1 = (size_t)__shfl(mys, 2 * jp), sa2 = (size_t)__shfl(mys, 2 * jp + 1), sc1 = (size_t)__shfl(mys, 2 * jp + 2), sc2 = (size_t)__shfl(mys, 2 * jp + 3);
            f32x4* xa = (f32x4*)(F.out + (size_t)ta * DM) + lane; f32x4* xc = (f32x4*)(F.out + (size_t)(two ? tc : ta) * DM) + lane;
            const u32x2* ha = (const u32x2*)(HB + (size_t)ta * DM) + lane; const u32x2* hc = (const u32x2*)(HB + (size_t)(two ? tc : ta) * DM) + lane;
            const unsigned* ya1 = (const unsigned*)(YB + sa1 * DM) + lane; const unsigned* ya2 = (const unsigned*)(YB + sa2 * DM) + lane;
            const unsigned* yc1 = (const unsigned*)(YB + (two ? sc1 : sa1) * DM) + lane; const unsigned* yc2 = (const unsigned*)(YB + (two ? sc2 : sa2) * DM) + lane;
            f32x4 va[4], vc[4]; unsigned pa[4], ra[4], pc[4], rc[4]; u32x2 qa[4], qc[4];
#pragma unroll
            for (int q = 0; q < 4; ++q) { qa[q] = __builtin_nontemporal_load(ha + 64 * q); pa[q] = __builtin_nontemporal_load(ya1 + 64 * q); ra[q] = __builtin_nontemporal_load(ya2 + 64 * q); qc[q] = __builtin_nontemporal_load(hc + 64 * q); pc[q] = __builtin_nontemporal_load(yc1 + 64 * q); rc[q] = __builtin_nontemporal_load(yc2 + 64 * q); }
#pragma unroll
            for (int q = 0; q < 4; ++q) { va[q] = (f32x4){bf2f(qa[q].x & 0xffffu), bf2f(qa[q].x >> 16), bf2f(qa[q].y & 0xffffu), bf2f(qa[q].y >> 16)}; vc[q] = (f32x4){bf2f(qc[q].x & 0xffffu), bf2f(qc[q].x >> 16), bf2f(qc[q].y & 0xffffu), bf2f(qc[q].y >> 16)}; }
            float sa = 0.f, sc = 0.f;
#pragma unroll
            for (int q = 0; q < 4; ++q) {
                const f32x2 a0 = __builtin_amdgcn_cvt_pk_f32_fp8((int)pa[q], false), a1 = __builtin_amdgcn_cvt_pk_f32_fp8((int)pa[q], true), b0 = __builtin_amdgcn_cvt_pk_f32_fp8((int)ra[q], false), b1 = __builtin_amdgcn_cvt_pk_f32_fp8((int)ra[q], true);
                const f32x2 c0 = __builtin_amdgcn_cvt_pk_f32_fp8((int)pc[q], false), c1 = __builtin_amdgcn_cvt_pk_f32_fp8((int)pc[q], true), d0 = __builtin_amdgcn_cvt_pk_f32_fp8((int)rc[q], false), d1 = __builtin_amdgcn_cvt_pk_f32_fp8((int)rc[q], true);
                va[q].x += (a0.x + b0.x) * YUNSCALE; va[q].y += (a0.y + b0.y) * YUNSCALE; va[q].z += (a1.x + b1.x) * YUNSCALE; va[q].w += (a1.y + b1.y) * YUNSCALE;
                vc[q].x += (c0.x + d0.x) * YUNSCALE; vc[q].y += (c0.y + d0.y) * YUNSCALE; vc[q].z += (c1.x + d1.x) * YUNSCALE; vc[q].w += (c1.y + d1.y) * YUNSCALE;
                sa += (va[q].x * va[q].x + va[q].y * va[q].y) + (va[q].z * va[q].z + va[q].w * va[q].w); sc += (vc[q].x * vc[q].x + vc[q].y * vc[q].y) + (vc[q].z * vc[q].z + vc[q].w * vc[q].w); }
            const float rsa = frsq(wave_sum(sa) * (1.f / DM) + EPS), rsc = frsq(wave_sum(sc) * (1.f / DM) + EPS);
#pragma unroll
            for (int q = 0; q < 4; ++q) __builtin_nontemporal_store(va[q] * rsa * gq[q], xa + 64 * q);
            if (two) {
#pragma unroll
                for (int q = 0; q < 4; ++q) __builtin_nontemporal_store(vc[q] * rsc * gq[q], xc + 64 * q); }
        }
    }
}

__global__ void __launch_bounds__(NTHR, 2) fwd(Args args) {
    extern __shared__ __attribute__((aligned(16))) unsigned char lds_raw[];
    Frame F;
    F.lds = (LAS unsigned char*)lds_raw;
    F.tid = threadIdx.x; F.lane = F.tid & 63; F.wave = __builtin_amdgcn_readfirstlane(F.tid >> 6);
    F.G = gridDim.x; { const int bx = blockIdx.x; F.vcu = (F.G % 8 == 0) ? (bx % 8) * (F.G / 8) + bx / 8 : bx; }
    F.ws = args.ws; F.out = args.out; F.ctl = (unsigned*)(args.ws + WS_CTL); F.tp0 = 0ull; F.tpd = 0ull;
    const int lo = args.ph_lo, hi = args.ph_hi;
    if (F.tid < 32) ((LAS unsigned*)(F.lds + L_MISC))[F.tid] = 0u;
    __syncthreads();
    XcdBarrier bar; bar.bar = F.ctl + CW_BAR; bar.x = 0; bar.st = nullptr;
    if (hi - lo > 1) bar = xcd_barrier_post(F.ctl + CW_BAR, (volatile LAS unsigned*)(F.lds + L_MISC) + 8);
    unsigned long long tp_t0 = 0ull, tp_d = 0ull; TpAcc tpa{0ull, 0ull};
#define TP_BEGIN(k) do { if (TP_PHASE == (k)) tp_t0 = __builtin_amdgcn_s_memrealtime(); } while (0)
#define TP_STOP(k, body) do { if (TP_PHASE == (k) && TP_BODY == (body)) tp_d = __builtin_amdgcn_s_memrealtime() - tp_t0; } while (0)
#define SEAM(k) do { TP_STOP(k, true); if (IN(k) && IN((k) + 1)) { xcd_barrier(bar); if ((REP_MASK >> 10) & 1u) xcd_barrier(bar); } TP_STOP(k, false); TP_BEGIN((k) + 1); } while (0)
#ifndef PHMASK
#define PHMASK 0x3ff
#endif
#define IN(k) (((PHMASK >> (k)) & 1) && lo <= (k) && (k) < hi)

    TP_BEGIN(0);
    if (IN(0)) { for (int rep = 0; rep < 1 + (int)((REP_MASK >> 0) & 1u); ++rep) p0_prologue(F, args); }
    SEAM(0);
    if (IN(1)) for (int rep = 0; rep < 1 + (int)((REP_MASK >> 1) & 1u); ++rep) {
        pg8::StaticOrder S; S.init(NTOK, LDP, F.G, (int)blockIdx.x);
        pg8::EpiBf16 E{(bf16_t*)(F.ws + WS_PROJ), LDP};
        pg8::gemm_phase<pg8::EpiBf16, pg8::StaticOrder, true, false, false>(F.lds, (const bf16_t*)(F.ws + WS_HN), (const bf16_t*)(F.ws + WS_WIN), DM, S, E, tpa);
    }
    SEAM(1);
    if (IN(2)) for (int rep = 0; rep < 1 + (int)((REP_MASK >> 2) & 1u); ++rep) { for (int ck = blockIdx.x; ck < NTOK / 64; ck += F.G) mixer_chunk<false>(F, args, ck); }
    SEAM(2);
    if (IN(3)) { for (int rep = 0; rep < 1 + (int)((REP_MASK >> 3) & 1u); ++rep) m3_scan(F); }
    SEAM(3);
    if (IN(4)) for (int rep = 0; rep < 1 + (int)((REP_MASK >> 4) & 1u); ++rep) { for (int ck = blockIdx.x; ck < NTOK / 64; ck += F.G) mixer_chunk<true>(F, args, ck); }
    SEAM(4);
    if (IN(5)) for (int rep = 0; rep < 1 + (int)((REP_MASK >> 5) & 1u); ++rep) {
        pg8::StaticOrder S; S.init(NTOK, DM, F.G, (int)blockIdx.x);
        pg8::EpiResBf16 E{args.in[0], (bf16_t*)(F.ws + WS_HB), DM};
        pg8::gemm_phase<pg8::EpiResBf16, pg8::StaticOrder, false, false, false>(F.lds, (const bf16_t*)(F.ws + WS_HN), (const bf16_t*)(F.ws + WS_WOUT), DM, S, E, tpa);
    }
    SEAM(5);
    if (IN(6)) { p6_router(F, args); }
    SEAM(6);
    if (IN(7)) for (int rep = 0; rep < 1 + (int)((REP_MASK >> 7) & 1u); ++rep) {
        const int nu = moe_setup(F, 3, true, true);
        pg8::MoeOrder S{(const LAS int*)(F.lds + L_UTAB), (const LAS unsigned*)(F.lds + L_ROWT), nu, 8};
        pg8::EpiGeglu E{F.ws + WS_H};
        pg8::gemm_phase<pg8::EpiGeglu, pg8::MoeOrder, true, true, true>(F.lds, (const bf16_t*)(F.ws + WS_HN), (const bf16_t*)(F.ws + WS_WGU), DM / 2, S, E, tpa);
    }
    SEAM(7);
    if (IN(8)) for (int rep = 0; rep < 1 + (int)((REP_MASK >> 8) & 1u); ++rep) {
        const int nu = moe_setup(F, 2, true, false);
        pg8::MoeOrder S{(const LAS int*)(F.lds + L_UTAB), (const LAS unsigned*)(F.lds + L_ROWT), nu, 4};
        pg8::EpiScaleFp8 E{F.ws + WS_YB};
        pg8::gemm_phase<pg8::EpiScaleFp8, pg8::MoeOrder, true, false, true>(F.lds, (const bf16_t*)(F.ws + WS_H), (const bf16_t*)(F.ws + WS_WD), DM / 2, S, E, tpa);
    }
    SEAM(8);
    if (IN(9)) { moe_setup(F, 0, false, false); p9_final(F, args); }
    TP_STOP(9, true); TP_STOP(9, false);
    if (TP_PHASE >= 100) tp_d = F.tpd;
    if (TP_PHASE >= 200) tp_d = tpa.d;
    if (TP_PHASE >= 0) { const unsigned long long te = __builtin_amdgcn_s_memrealtime(); while (__builtin_amdgcn_s_memrealtime() - te < tp_d) __builtin_amdgcn_s_sleep(8); }
#undef IN
#undef SEAM
#undef TP_BEGIN
#undef TP_STOP
}

extern "C" void kernel_launch(void* const* d_in, const int* in_sizes, int n_in, void* d_out, int out_size, void* d_ws, size_t ws_size, hipStream_t stream) {
    static int grid = 0;
    if (grid == 0) {
        if (n_in != 24 || out_size != NTOK * DM || ws_size < WS_END) { fprintf(stderr, "kernel_launch: unexpected shapes (n_in %d, out %d, ws %zu); nothing launched\n", n_in, out_size, ws_size); grid = -1; return; }
        int dev = 0, cus = 0;
        if (hipGetDevice(&dev) != hipSuccess || hipDeviceGetAttribute(&cus, hipDeviceAttributeMultiprocessorCount, dev) != hipSuccess) { grid = -1; return; }
        if (hipFuncSetAttribute((const void*)fwd, hipFuncAttributeMaxDynamicSharedMemorySize, LDS_BYTES) != hipSuccess) { fprintf(stderr, "kernel_launch: hipFuncSetAttribute failed\n"); grid = -1; return; }
        (void)hipGetLastError();
        grid = cus;
        if ((160 * 8 + grid - 1) / grid > MAXU) { fprintf(stderr, "kernel_launch: %d workgroups cannot hold the MoE unit tables (MAXU %d); nothing launched\n", grid, MAXU); grid = -1; return; }
    }
    if (grid < 0) return;
    (void)hipMemsetAsync((char*)d_ws + WS_CTL, 0, CTL_ZERO_BYTES, stream);
    Args a{};
    for (int i = 0; i < 24; ++i) a.in[i] = (const float*)d_in[i];
    a.out = (float*)d_out; a.ws = (unsigned char*)d_ws;
#ifndef N_LAUNCHES
#define N_LAUNCHES 1
#endif
    if (N_LAUNCHES == 1) { a.ph_lo = 0; a.ph_hi = NPHASE; hipLaunchKernelGGL(fwd, dim3(grid), dim3(NTHR), LDS_BYTES, stream, a); }
    else for (int p = 0; p < NPHASE; ++p) { a.ph_lo = p; a.ph_hi = p + 1; hipLaunchKernelGGL(fwd, dim3(grid), dim3(NTHR), LDS_BYTES, stream, a); }
}
```

```cpp
#include <hip/hip_runtime.h>
#include <cstdio>
#include <cstdint>

#define LAS __attribute__((address_space(3)))
#define GAS __attribute__((address_space(1)))
typedef unsigned short bf16_t;
typedef short bf16x8 __attribute__((ext_vector_type(8)));
typedef float f32x4 __attribute__((ext_vector_type(4)));
typedef float f32x2 __attribute__((ext_vector_type(2)));
typedef unsigned u32x4 __attribute__((ext_vector_type(4)));
typedef unsigned u32x2 __attribute__((ext_vector_type(2)));
typedef int v4i __attribute__((ext_vector_type(4)));
typedef int v8i __attribute__((ext_vector_type(8)));

constexpr int NTOK = 16384, SEQ = 8192, DM = 1024;
constexpr int RGW = 512, NPROJ = 2576, LDP = 2816;
constexpr int C_XR = 0, C_YR = 512, C_Q = 1024, C_K = 1280, C_V = 1536, C_G = 2048, C_AL = 2560;
constexpr int NEXP = 32, CAP = 16384;
constexpr float EPS = 1e-6f;
constexpr int NWAVES = 8, NTHR = 512;
constexpr int NPHASE = 10;
constexpr unsigned REP_MASK = 0x000;
constexpr int TP_PHASE = -1;
constexpr bool TP_BODY = false;

constexpr size_t MiB = 1u << 20;
constexpr size_t WS_CTL = 0, CTL_ZERO_BYTES = 64 * 1024;
constexpr size_t WS_WRT = 1 * MiB;
constexpr size_t WS_RS = 1 * MiB + 512 * 1024;
constexpr size_t WS_WIN = 2 * MiB;
constexpr size_t WS_WOUT = 8 * MiB;
constexpr size_t WS_WGU = 16 * MiB;
constexpr size_t WS_WD = 80 * MiB;
constexpr float WSCALE = 32.f, WUNSCALE = 1.f / 32.f, YSCALE = 16.f, YUNSCALE = 1.f / 16.f;
constexpr size_t WS_HN = 208 * MiB;
constexpr size_t WS_PROJ = 240 * MiB;
constexpr size_t WS_SMALL = 10 * MiB;
constexpr size_t WS_KVT = 328 * MiB;
constexpr size_t WS_ST = 360 * MiB;
constexpr size_t WS_DEC = 376 * MiB, WS_RGSA = 377 * MiB, WS_RGSH = 377 * MiB + 512 * 1024, WS_RGC = 378 * MiB;
constexpr size_t WS_H = 240 * MiB;
constexpr size_t WS_YB = 320 * MiB;
constexpr size_t WS_HB = 400 * MiB;
constexpr size_t WS_HP = 432 * MiB;
constexpr size_t WS_BC = 464 * MiB;
constexpr size_t WS_STOK = 480 * MiB, WS_SW = 482 * MiB, WS_TIDX = 484 * MiB;
constexpr size_t WS_END = 512 * MiB;
constexpr int CW_BAR = 4096;
constexpr int CW_GCNT = 8192;

constexpr int RING_BYTES = 131072;
constexpr int CTRL_BASE = 143360;
constexpr int L_MISC = CTRL_BASE;
constexpr int L_CNT = CTRL_BASE + 128;
constexpr int L_TST = CTRL_BASE + 256;
constexpr int L_UTAB = CTRL_BASE + 512;
constexpr int L_FST = CTRL_BASE + 768;
constexpr int L_HST = CTRL_BASE + 896;
constexpr int MAXU = 8;
constexpr int L_ROWT = CTRL_BASE + 1024;
constexpr int L_WT = L_ROWT + MAXU * 1024;
constexpr int LDS_BYTES = L_WT + MAXU * 1024;
static_assert(LDS_BYTES <= 163840 && LDS_BYTES % 16 == 0, "LDS map");

__device__ __forceinline__ unsigned f2bf(float f) { unsigned u = __builtin_bit_cast(unsigned, f); return (u + 0x7fffu + ((u >> 16) & 1u)) >> 16; }
__device__ __forceinline__ unsigned pk2(float lo, float hi) { return f2bf(lo) | (f2bf(hi) << 16); }
__device__ __forceinline__ unsigned pk4_fp8(float a, float b, float c, float d) { int w = 0; w = __builtin_amdgcn_cvt_pk_fp8_f32(a, b, w, false); w = __builtin_amdgcn_cvt_pk_fp8_f32(c, d, w, true); return (unsigned)w; }
__device__ __forceinline__ float bf2f(unsigned b) { return __builtin_bit_cast(float, b << 16); }
__device__ __forceinline__ float wave_sum(float v) {
#pragma unroll
    for (int o = 1; o < 64; o <<= 1) v += __shfl_xor(v, o);
    return v;
}
__device__ __forceinline__ float frsq(float x) { return __builtin_amdgcn_rsqf(x); }
__device__ __forceinline__ float frcp(float x) { return __builtin_amdgcn_rcpf(x); }
__device__ __forceinline__ float sigmoidf_(float x) { return frcp(1.f + __expf(-x)); }
__device__ __forceinline__ f32x2 geglu_pk(f32x2 g, f32x2 u) {
    const f32x2 g2 = g * g, p = g2 * 0.044715f + 1.0f, z2 = (g * p) * (-1.5957691216057308f * 1.4426950408889634f);
    f32x2 e; e.x = __builtin_amdgcn_exp2f(z2.x); e.y = __builtin_amdgcn_exp2f(z2.y);
    const f32x2 d = e + 1.0f; f32x2 r; r.x = __builtin_amdgcn_rcpf(d.x); r.y = __builtin_amdgcn_rcpf(d.y);
    return (g * u) * r;
}
__device__ __forceinline__ float gelu_tanh(float x) { const float z2 = 1.5957691216057308f * (x + 0.044715f * x * x * x); return x * frcp(1.f + __expf(-z2)); }

struct TpAcc { unsigned long long t0, d; };
#define TPS2(T, id) do { if (TP_PHASE == (id)) (T).t0 = __builtin_amdgcn_s_memrealtime(); } while (0)
#define TPE2(T, id) do { if (TP_PHASE == (id)) (T).d += __builtin_amdgcn_s_memrealtime() - (T).t0; } while (0)
namespace pg8 {
constexpr int BM = 256, BK = 64, HALF = 128, HTB = HALF * BK * 2, NXCD = 8, WGM = 8;
__host__ __device__ __forceinline__ int lds_byte(int r, int c) { const int st = (r >> 4) * 2 + (c >> 5), rr = r & 15, cc = c & 31, ob = rr * 64 + cc * 2; return st * 1024 + (ob ^ (((ob >> 9) & 1) << 5)); }
__host__ __device__ __forceinline__ void stage_rc(int b, int& R, int& C) { const int st = b / 1024, sb = b % 1024, swz = sb ^ (((sb >> 9) & 1) << 5); R = (st >> 1) * 16 + swz / 64; C = (st & 1) * 32 + (swz % 64) / 2; }
__host__ __device__ __forceinline__ int perm32(int rho) { const int n = rho >> 4, i = rho & 15; return 8 * (i >> 2) + 4 * n + (i & 3); }

struct Unit { int pm, pn, bt, ui, e, rows; };

struct StaticOrder {
    int nM, nN, nwg, G, c;
    __device__ void init(int M, int N, int G_, int c_) { nM = M / BM; nN = N / BM; nwg = nM * nN; G = G_; c = c_; }
    __device__ bool next(int i, Unit& u) const {
        const long L = (long)i * G + c; if (L >= nwg) return false;
        int wgid = (int)L; { const int q = nwg / NXCD, r = nwg % NXCD, xcd = wgid % NXCD, off = wgid / NXCD; wgid = (xcd < r ? xcd * (q + 1) : r * (q + 1) + (xcd - r) * q) + off; }
        const int nig = WGM * nN, gid = wgid / nig, fm = gid * WGM, gsz = (nM - fm) < WGM ? (nM - fm) : WGM;
        u.pm = fm + ((wgid % nig) % gsz); u.pn = (wgid % nig) / gsz; u.bt = u.pn; u.ui = i; u.e = 0; u.rows = 256; return true;
    }
    __device__ __forceinline__ unsigned row_byte(const Unit&, int) const { return 0u; }
};

struct MoeOrder {
    const LAS int* utab; const LAS unsigned* rowt; int nu, ncol;
    __device__ bool next(int i, Unit& u) const {
        if (i >= nu) return false;
        u.pm = __builtin_amdgcn_readfirstlane(utab[i * 8 + 0]); u.pn = __builtin_amdgcn_readfirstlane(utab[i * 8 + 1]); u.e = __builtin_amdgcn_readfirstlane(utab[i * 8 + 2]); u.rows = __builtin_amdgcn_readfirstlane(utab[i * 8 + 3]); u.ui = i; u.bt = u.e * ncol + u.pn; return true;
    }
    __device__ __forceinline__ unsigned row_byte(const Unit& u, int r) const { return rowt[u.ui * 256 + r]; }
};

__device__ __forceinline__ unsigned cvt_pk_bf16(float lo, float hi) { unsigned r; asm volatile("v_cvt_pk_bf16_f32 %0, %1, %2" : "=v"(r) : "v"(lo), "v"(hi)); return r; }

struct EpiBf16 {
    static constexpr bool PERM = true; static constexpr int TPID = 210;
    bf16_t* O; int ldc;
    __device__ __forceinline__ void operator()(const f32x4 (&acc)[2][2][4][2], const Unit& u, int wr, int wc, int fr, int fq, const LAS unsigned char*) const {
        const int row0 = u.pm * BM + wr * 64 + fr, col0 = u.pn * BM + wc * 32 + 8 * fq;
#pragma unroll
        for (int ai = 0; ai < 2; ++ai)
#pragma unroll
            for (int m = 0; m < 4; ++m) { bf16_t* rowp = O + (size_t)(row0 + ai * HALF + m * 16) * ldc + col0;
#pragma unroll
                for (int bj = 0; bj < 2; ++bj) { const f32x4 v0 = acc[ai][bj][m][0], v1 = acc[ai][bj][m][1];
                    u32x4 w; w.x = cvt_pk_bf16(v0[0], v0[1]); w.y = cvt_pk_bf16(v0[2], v0[3]); w.z = cvt_pk_bf16(v1[0], v1[1]); w.w = cvt_pk_bf16(v1[2], v1[3]);
                    *(u32x4*)(rowp + bj * HALF) = w; } }
    }
};
struct EpiResBf16 {
    static constexpr bool PERM = true; static constexpr int TPID = 250;
    const float* base; bf16_t* out; int ldc;
    __device__ __forceinline__ void operator()(const f32x4 (&acc)[2][2][4][2], const Unit& u, int wr, int wc, int fr, int fq, const LAS unsigned char*) const {
        const int col0 = u.pn * BM + wc * 32 + 8 * fq;
#pragma unroll
        for (int ai = 0; ai < 2; ++ai) {
            f32x4 xb[4][2][2];
#pragma unroll
            for (int m = 0; m < 4; ++m) { const size_t off = (size_t)(u.pm * BM + ai * HALF + wr * 64 + m * 16 + fr) * ldc + col0;
#pragma unroll
                for (int bj = 0; bj < 2; ++bj) { xb[m][bj][0] = __builtin_nontemporal_load((const f32x4*)(base + off + bj * HALF)); xb[m][bj][1] = __builtin_nontemporal_load((const f32x4*)(base + off + bj * HALF + 4)); } }
#pragma unroll
            for (int m = 0; m < 4; ++m) { const size_t off = (size_t)(u.pm * BM + ai * HALF + wr * 64 + m * 16 + fr) * ldc + col0;
#pragma unroll
                for (int bj = 0; bj < 2; ++bj) { const f32x4 v0 = acc[ai][bj][m][0] + xb[m][bj][0], v1 = acc[ai][bj][m][1] + xb[m][bj][1];
                    u32x4 w; w.x = cvt_pk_bf16(v0[0], v0[1]); w.y = cvt_pk_bf16(v0[2], v0[3]); w.z = cvt_pk_bf16(v1[0], v1[1]); w.w = cvt_pk_bf16(v1[2], v1[3]);
                    *(u32x4*)(out + off + bj * HALF) = w; } }
        }
    }
};
struct EpiGeglu {
    static constexpr bool PERM = true; static constexpr int TPID = 270;
    unsigned char* H;
    __device__ __forceinline__ void operator()(const f32x4 (&acc)[2][2][4][2], const Unit& u, int wr, int wc, int fr, int fq, const LAS unsigned char* lds) const {
        const int col0 = u.pn * HALF + wc * 32 + 8 * fq; const LAS float* wt = (const LAS float*)(lds + L_WT) + u.ui * 256;
#pragma unroll
        for (int ai = 0; ai < 2; ++ai)
#pragma unroll
            for (int m = 0; m < 4; ++m) { const int r = ai * HALF + wr * 64 + m * 16 + fr;
                if (r < u.rows) { const float s = wt[r] * WUNSCALE;
                    const f32x4 g0 = acc[ai][0][m][0] * s, g1 = acc[ai][0][m][1] * s, u0 = acc[ai][1][m][0] * s, u1 = acc[ai][1][m][1] * s;
                    const f32x2 h0 = geglu_pk((f32x2){g0[0], g0[1]}, (f32x2){u0[0], u0[1]}), h1 = geglu_pk((f32x2){g0[2], g0[3]}, (f32x2){u0[2], u0[3]});
                    const f32x2 h2 = geglu_pk((f32x2){g1[0], g1[1]}, (f32x2){u1[0], u1[1]}), h3 = geglu_pk((f32x2){g1[2], g1[3]}, (f32x2){u1[2], u1[3]});
                    u32x2 w;
                    w.x = pk4_fp8(h0.x, h0.y, h1.x, h1.y);
                    w.y = pk4_fp8(h2.x, h2.y, h3.x, h3.y);
                    *(u32x2*)(H + (size_t)(u.pm * BM + r) * 1024 + col0) = w; } }
    }
};
struct EpiScaleFp8 {
    static constexpr bool PERM = true; static constexpr int TPID = 280;
    unsigned char* Y;
    __device__ __forceinline__ void operator()(const f32x4 (&acc)[2][2][4][2], const Unit& u, int wr, int wc, int fr, int fq, const LAS unsigned char* lds) const {
        const int col0 = u.pn * BM + wc * 32 + 8 * fq; const LAS float* wt = (const LAS float*)(lds + L_WT) + u.ui * 256;
#pragma unroll
        for (int ai = 0; ai < 2; ++ai)
#pragma unroll
            for (int m = 0; m < 4; ++m) { const int r = ai * HALF + wr * 64 + m * 16 + fr;
                if (r < u.rows) { const float s = wt[r] * (WUNSCALE * YSCALE); unsigned char* rowp = Y + (size_t)(u.pm * BM + r) * 1024 + col0;
#pragma unroll
                    for (int bj = 0; bj < 2; ++bj) { const f32x4 v0 = acc[ai][bj][m][0] * s, v1 = acc[ai][bj][m][1] * s;
                        u32x2 w; w.x = pk4_fp8(v0[0], v0[1], v0[2], v0[3]); w.y = pk4_fp8(v1[0], v1[1], v1[2], v1[3]);
                        *(u32x2*)(rowp + bj * HALF) = w; } } }
    }
};

template <class Epi, class Sched, bool ALIGN_EPI, bool GATHER, bool FP8>
__device__ __forceinline__ void gemm_phase(LAS unsigned char* lds, const bf16_t* Ab, const bf16_t* Bb, const int K, const Sched& S, const Epi& E, TpAcc& T) {
    const int tid = threadIdx.x, wid = __builtin_amdgcn_readfirstlane(tid >> 6), lane = tid & 63, wr = wid >> 2, wc = wid & 3, fr = lane & 15, fq = lane >> 4;
    const int nt = K / BK;
    int Rr[2], Cc[2]; unsigned voffB[2];
#pragma unroll
    for (int i = 0; i < 2; ++i) { int R, C; stage_rc(tid * 16 + i * 8192, R, C); Rr[i] = R; Cc[i] = C; const int Rb = Epi::PERM ? ((R & ~31) + perm32(R & 31)) : R; voffB[i] = (unsigned)(Rb * K + C) * 2u; }
    const size_t kstep = (size_t)(BK * 2);
    const size_t hstep = (size_t)HALF * K * 2;
    const size_t tstep = 2 * hstep;
    const unsigned ldsw = (unsigned)wid * 1024u;
    const int aoff = lds_byte(wr * 64 + fr, fq * 8), boff = lds_byte(wc * 32 + fr, fq * 8);
#define PG8_SA(b, h) (((b) * 2 + (h)) * HTB)
#define PG8_SB(b, h) ((4 + (b) * 2 + (h)) * HTB)
#define PG8_STAGE2X(bufoff, gbase, o0, o1, AUX) do { unsigned _o0 = (o0), _o1 = (o1); asm volatile("" : "+v"(_o0), "+v"(_o1));     \
        __builtin_amdgcn_global_load_lds((const unsigned*)((const char*)(gbase) + _o0), (LAS unsigned*)(lds + (bufoff) + ldsw), 16, 0, AUX); \
        __builtin_amdgcn_global_load_lds((const unsigned*)((const char*)(gbase) + _o1), (LAS unsigned*)(lds + (bufoff) + ldsw + 8192), 16, 0, AUX); } while (0)
#define PG8_STAGE2(bufoff, gbase, o0, o1) PG8_STAGE2X(bufoff, gbase, o0, o1, 0)
#define PG8_STAGEB(bufoff, gbase) PG8_STAGE2X(bufoff, gbase, voffB[0], voffB[1], 0)
#define PG8_AH(p) (GATHER ? (p) : (p) + hstep)
#define PG8_V1(i) (GATHER ? vC[1][i] : vC[0][i])
#define PG8_LD8(p) __builtin_shufflevector(*(const LAS v4i*)(p), *(const LAS v4i*)((p) + 1024), 0, 1, 2, 3, 4, 5, 6, 7)
#define PG8_LDA(dst, b, h) do { _Pragma("unroll") for (int m = 0; m < 4; ++m) dst[m] = PG8_LD8(lds + PG8_SA(b, h) + aoff + m * 2048); } while (0)
#define PG8_LDB(dst, b, h) do { _Pragma("unroll") for (int n = 0; n < 2; ++n) dst[n] = PG8_LD8(lds + PG8_SB(b, h) + boff + n * 2048); } while (0)
#define PG8_LO(x) __builtin_bit_cast(bf16x8, __builtin_shufflevector(x, x, 0, 1, 2, 3))
#define PG8_HI(x) __builtin_bit_cast(bf16x8, __builtin_shufflevector(x, x, 4, 5, 6, 7))
#define PG8_MMA(ai, bj, At, Bt) do { __builtin_amdgcn_s_setprio(1); _Pragma("unroll") for (int m = 0; m < 4; ++m) _Pragma("unroll") for (int n = 0; n < 2; ++n) { \
        if constexpr (FP8) acc[ai][bj][m][n] = __builtin_amdgcn_mfma_scale_f32_16x16x128_f8f6f4(Bt[n], At[m], acc[ai][bj][m][n], 0, 0, 0, 0, 0, 0); \
        else { acc[ai][bj][m][n] = __builtin_amdgcn_mfma_f32_16x16x32_bf16(PG8_LO(Bt[n]), PG8_LO(At[m]), acc[ai][bj][m][n], 0, 0, 0); \
               acc[ai][bj][m][n] = __builtin_amdgcn_mfma_f32_16x16x32_bf16(PG8_HI(Bt[n]), PG8_HI(At[m]), acc[ai][bj][m][n], 0, 0, 0); } } __builtin_amdgcn_s_setprio(0); } while (0)
#define PG8_WAIT_V(n) asm volatile("s_waitcnt vmcnt(" #n ")" ::: "memory")
#define PG8_WAIT_L(n) asm volatile("s_waitcnt lgkmcnt(" #n ")" ::: "memory")
#define PG8_BAR __builtin_amdgcn_s_barrier()
#define PG8_SCHED __builtin_amdgcn_sched_barrier(0)
#define PG8_KLOOP(FULLU) \
        _Pragma("unroll 1") \
        for (int t = 0; t < nt; t += 2) { \
            const bool last = (t == nt - 2); \
            const char* a1 = cA + (size_t)(t + 1) * kstep; \
            const char* a2 = last ? nA : cA + (size_t)(t + 2) * kstep; const char* b2 = last ? nB : cB + (size_t)(t + 2) * kstep; \
            const char* a3 = a2 + kstep; const char* b3 = b2 + kstep; \
              \
            PG8_LDB(B0, 0, 0); PG8_LDB(B1, 0, 1); PG8_SCHED; PG8_LDA(At, 0, 0); PG8_STAGE2(PG8_SA(1, 1), PG8_AH(a1), PG8_V1(0), PG8_V1(1)); \
            if constexpr (GATHER) {                                         \
                if (last && has_next) { \
                    int ln_ = (int)__builtin_amdgcn_mbcnt_hi(~0u, __builtin_amdgcn_mbcnt_lo(~0u, 0u)); asm volatile("" : "+v"(ln_)); \
                    _Pragma("unroll") \
                    for (int i = 0; i < 2; ++i) { int R, C; stage_rc((wid * 64 + ln_) * 16 + i * 8192, R, C); \
                    _Pragma("unroll") \
                        for (int h = 0; h < 2; ++h) vC[h][i] = S.row_byte(nxt, h * HALF + R) + (unsigned)C * 2u; } \
                } \
            } \
            const unsigned w00 = vC[0][0], w01 = vC[0][1], w10 = PG8_V1(0), w11 = PG8_V1(1); \
            PG8_WAIT_V(8); PG8_WAIT_L(0); PG8_BAR; PG8_MMA(0, 0, At, B0); PG8_MMA(0, 1, At, B1); PG8_BAR; PG8_SCHED; \
              \
            PG8_LDA(At, 0, 1); PG8_STAGEB(PG8_SB(0, 0), b2); PG8_STAGEB(PG8_SB(0, 1), b2 + hstep); PG8_STAGE2(PG8_SA(0, 0), a2, w00, w01); \
            PG8_WAIT_V(8); PG8_WAIT_L(0); PG8_BAR; if constexpr (FULLU) { PG8_MMA(1, 0, At, B0); PG8_MMA(1, 1, At, B1); } PG8_BAR; PG8_SCHED; \
              \
            PG8_LDB(B0, 1, 0); PG8_LDB(B1, 1, 1); PG8_SCHED; PG8_LDA(At, 1, 0); PG8_STAGE2(PG8_SA(0, 1), PG8_AH(a2), w10, w11); \
            PG8_WAIT_V(8); PG8_WAIT_L(0); PG8_BAR; PG8_MMA(0, 0, At, B0); PG8_MMA(0, 1, At, B1); PG8_BAR; PG8_SCHED; \
              \
            PG8_LDA(At, 1, 1); PG8_STAGEB(PG8_SB(1, 0), b3); PG8_STAGEB(PG8_SB(1, 1), b3 + hstep); PG8_STAGE2(PG8_SA(1, 0), a3, w00, w01); \
            PG8_WAIT_V(8); PG8_WAIT_L(0); PG8_BAR; if constexpr (FULLU) { PG8_MMA(1, 0, At, B0); PG8_MMA(1, 1, At, B1); } PG8_BAR; PG8_SCHED; \
        }
    Unit cur, nxt; int ui = 0;
    if (!S.next(0, cur)) return;
    f32x4 acc[2][2][4][2];
#pragma unroll
    for (int a = 0; a < 2; ++a)
#pragma unroll
        for (int b = 0; b < 2; ++b)
#pragma unroll
            for (int m = 0; m < 4; ++m)
#pragma unroll
                for (int n = 0; n < 2; ++n) acc[a][b][m][n] = (f32x4){0.f, 0.f, 0.f, 0.f};
    v8i At[4], B0[2], B1[2];
    unsigned vC[2][2];
#pragma unroll
    for (int h = 0; h < 2; ++h)
#pragma unroll
        for (int i = 0; i < 2; ++i) vC[h][i] = GATHER ? (S.row_byte(cur, h * HALF + Rr[i]) + (unsigned)Cc[i] * 2u) : (unsigned)(Rr[i] * K + Cc[i]) * 2u;
    const char* cA = GATHER ? (const char*)Ab : (const char*)Ab + (size_t)cur.pm * tstep; const char* cB = (const char*)Bb + (size_t)cur.bt * tstep;
    PG8_STAGEB(PG8_SB(0, 0), cB); PG8_STAGEB(PG8_SB(0, 1), cB + hstep); PG8_STAGE2(PG8_SA(0, 0), cA, vC[0][0], vC[0][1]); PG8_STAGE2(PG8_SA(0, 1), PG8_AH(cA), PG8_V1(0), PG8_V1(1));
    if (wr == 1) PG8_BAR;
    PG8_WAIT_V(2); PG8_BAR;
    PG8_STAGEB(PG8_SB(1, 0), cB + kstep); PG8_STAGE2(PG8_SA(1, 0), cA + kstep, vC[0][0], vC[0][1]); PG8_STAGEB(PG8_SB(1, 1), cB + hstep + kstep);
    PG8_WAIT_V(6); PG8_BAR;
    for (;;) {
        const bool has_next = S.next(ui + 1, nxt);
        const char* nA = has_next ? (GATHER ? (const char*)Ab : (const char*)Ab + (size_t)nxt.pm * tstep) : cA; const char* nB = has_next ? (const char*)Bb + (size_t)nxt.bt * tstep : cB;
        const bool fullu = !GATHER || cur.rows > HALF;
        TPS2(T, Epi::TPID + 1);
        if (fullu) { PG8_KLOOP(true) } else { PG8_KLOOP(false) }
        TPE2(T, Epi::TPID + 1);
        if constexpr (ALIGN_EPI) { if (wr == 0) PG8_BAR; }
        TPS2(T, Epi::TPID);
        { int ln_ = (int)__builtin_amdgcn_mbcnt_hi(~0u, __builtin_amdgcn_mbcnt_lo(~0u, 0u)); asm volatile("" : "+v"(ln_));
          E(acc, cur, wr, wc, ln_ & 15, ln_ >> 4, lds); }
        asm volatile("" ::: "memory"); TPE2(T, Epi::TPID);
        if (!has_next) break;
#pragma unroll
        for (int a = 0; a < 2; ++a)
#pragma unroll
            for (int b = 0; b < 2; ++b)
#pragma unroll
                for (int m = 0; m < 4; ++m)
#pragma unroll
                    for (int n = 0; n < 2; ++n) acc[a][b][m][n] = (f32x4){0.f, 0.f, 0.f, 0.f};
        cur = nxt; cA = nA; cB = nB; ++ui;
        if constexpr (ALIGN_EPI) { if (wr == 1) PG8_BAR; }
    }
    PG8_WAIT_V(0);
    if constexpr (!ALIGN_EPI) { if (wr == 0) PG8_BAR; }
    PG8_BAR;
#undef PG8_SA
#undef PG8_SB
#undef PG8_STAGE2
#undef PG8_STAGE2X
#undef PG8_STAGEB
#undef PG8_AH
#undef PG8_V1
#undef PG8_LDA
#undef PG8_LDB
#undef PG8_MMA
#undef PG8_LD8
#undef PG8_LO
#undef PG8_HI
#undef PG8_WAIT_V
#undef PG8_WAIT_L
#undef PG8_BAR
#undef PG8_SCHED
#undef PG8_KLOOP
}
}


#define XB_TMO      128
#define XB_XCNT(j)  (256  + 64 * (j))
#define XB_XSUB(j)  (1280 + 64 * (j))
#define XB_XGEN(j)  (2304 + 64 * (j))
#define XB_TOP      3328
#define XB_TOPGEN   3392
#define XCD_BAR_WORDS 3456
#define XB_SPIN_CAP (1u << 18)

__device__ __forceinline__ unsigned xb_ld(unsigned* p)              { return __hip_atomic_load(p, __ATOMIC_RELAXED, __HIP_MEMORY_SCOPE_AGENT); }
__device__ __forceinline__ unsigned xb_add(unsigned* p, unsigned v) { return __hip_atomic_fetch_add(p, v, __ATOMIC_RELAXED, __HIP_MEMORY_SCOPE_AGENT); }
__device__ __forceinline__ unsigned xb_xcc_id() { return (unsigned)__builtin_amdgcn_s_getreg((3 << 11) | 20) & 0xFu; }
#define XB_SPIN(cond, bar) do { unsigned _sp = 0; while (cond) { __builtin_amdgcn_s_sleep(1); \
    if ((++_sp & 255u) == 0u) { if (xb_ld(&(bar)[XB_TMO])) break; if (_sp > XB_SPIN_CAP) { atomicAdd(&(bar)[XB_TMO], 1u); break; } } } } while (0)

struct XcdBarrier {
    unsigned* bar; unsigned x;
    volatile LAS unsigned* st;
};
__device__ __forceinline__ XcdBarrier xcd_barrier_post(unsigned* bar, volatile LAS unsigned* st) {
    XcdBarrier b; b.bar = bar; b.x = xb_xcc_id(); b.st = st;
    if (threadIdx.x == 0) (void)xb_add(&bar[XB_XCNT(b.x)], 1u);
    return b;
}
__device__ __forceinline__ void xcd_barrier_complete(unsigned* bar, unsigned x, unsigned& nloc, unsigned& nx) {
    const unsigned G = gridDim.x * gridDim.y * gridDim.z;
    unsigned sum, cnt, mine, sp = 0u;
    for (;;) {
        sum = 0u; cnt = 0u; mine = 0u;
#pragma unroll
        for (unsigned j = 0; j < 16; ++j) { const unsigned c = xb_ld(&bar[XB_XCNT(j)]); sum += c; cnt += (c > 0u) ? 1u : 0u; mine = (j == x) ? c : mine; }
        if (sum == G) break;
        __builtin_amdgcn_s_sleep(1);
        if ((++sp & 255u) == 0u) { if (xb_ld(&bar[XB_TMO])) break; if (sp > XB_SPIN_CAP) { atomicAdd(&bar[XB_TMO], 1u); break; } }
    }
    nloc = mine > 0u ? mine : 1u; nx = cnt > 0u ? cnt : 1u;
}
__device__ __forceinline__ void xcd_barrier(const XcdBarrier& b) {
    asm volatile("s_waitcnt vmcnt(0)" ::: "memory");
    __syncthreads();
    if (threadIdx.x == 0) {
        unsigned* bar = b.bar;
        __builtin_amdgcn_s_waitcnt(0);
        unsigned nloc = b.st[0], nx = b.st[1];
        if (nloc == 0u) { xcd_barrier_complete(bar, b.x, nloc, nx); b.st[0] = nloc; b.st[1] = nx; }
        const unsigned old = xb_add(&bar[XB_XSUB(b.x)], 1u);
        const unsigned gen = old / nloc;
        if (old + 1u == (gen + 1u) * nloc) {
            __builtin_amdgcn_fence(__ATOMIC_RELEASE, "agent");
            asm volatile("s_waitcnt vmcnt(0)" ::: "memory");
            const unsigned og = xb_add(&bar[XB_TOP], 1u);
            const unsigned tg = og / nx;
            if (og + 1u == (tg + 1u) * nx) xb_add(&bar[XB_TOPGEN], 1u);
            else XB_SPIN(xb_ld(&bar[XB_TOPGEN]) == tg, bar);
            __builtin_amdgcn_fence(__ATOMIC_ACQUIRE, "agent");
            xb_add(&bar[XB_XGEN(b.x)], 1u);
            asm volatile("s_waitcnt vmcnt(0)" ::: "memory");
        } else {
            XB_SPIN(xb_ld(&bar[XB_XGEN(b.x)]) == gen, bar);
            __builtin_amdgcn_fence(__ATOMIC_ACQUIRE, "agent");
            asm volatile("s_waitcnt vmcnt(0)" ::: "memory");
        }
    }
    __syncthreads();
}

__device__ __forceinline__ void xcd_barrier_arrive(const XcdBarrier& b) {
    asm volatile("s_waitcnt vmcnt(0)" ::: "memory");
    __syncthreads();
    if (threadIdx.x == 0) {
        unsigned* bar = b.bar;
        __builtin_amdgcn_s_waitcnt(0);
        unsigned nloc = b.st[0], nx = b.st[1];
        if (nloc == 0u) { xcd_barrier_complete(bar, b.x, nloc, nx); b.st[0] = nloc; b.st[1] = nx; }
        const unsigned old = xb_add(&bar[XB_XSUB(b.x)], 1u);
        const unsigned gen = old / nloc;
        unsigned leader = (old + 1u == (gen + 1u) * nloc) ? 1u : 0u, tg = 0u, lastx = 0u;
        if (leader) {
            __builtin_amdgcn_fence(__ATOMIC_RELEASE, "agent");
            asm volatile("s_waitcnt vmcnt(0)" ::: "memory");
            const unsigned og = xb_add(&bar[XB_TOP], 1u);
            tg = og / nx;
            if (og + 1u == (tg + 1u) * nx) { xb_add(&bar[XB_TOPGEN], 1u); lastx = 1u; }
        }
        b.st[2] = gen; b.st[3] = leader; b.st[4] = tg; b.st[5] = lastx;
    }
}
__device__ __forceinline__ void xcd_barrier_wait(const XcdBarrier& b) {
    __syncthreads();
    if (threadIdx.x == 0) {
        unsigned* bar = b.bar; const unsigned gen = b.st[2], leader = b.st[3], tg = b.st[4], lastx = b.st[5];
        if (leader) {
            if (!lastx) XB_SPIN(xb_ld(&bar[XB_TOPGEN]) == tg, bar);
            __builtin_amdgcn_fence(__ATOMIC_ACQUIRE, "agent");
            xb_add(&bar[XB_XGEN(b.x)], 1u);
            asm volatile("s_waitcnt vmcnt(0)" ::: "memory");
        } else {
            XB_SPIN(xb_ld(&bar[XB_XGEN(b.x)]) == gen, bar);
            __builtin_amdgcn_fence(__ATOMIC_ACQUIRE, "agent");
            asm volatile("s_waitcnt vmcnt(0)" ::: "memory");
        }
    }
    __syncthreads();
}

struct Args { const float* in[24]; float* out; unsigned char* ws; int ph_lo, ph_hi; };

struct Frame {
    LAS unsigned char* lds;
    unsigned* ctl;
    int tid, lane, wave, vcu, G;
    unsigned char* ws; float* out;
    unsigned long long tp0, tpd;
};
#define TPS(F, id) do { if (TP_PHASE == (id)) (F).tp0 = __builtin_amdgcn_s_memrealtime(); } while (0)
#define TPE(F, id) do { if (TP_PHASE == (id)) (F).tpd += __builtin_amdgcn_s_memrealtime() - (F).tp0; } while (0)

struct TTile { const float* src; unsigned char* dst; int Nsrc, k0, n0, orow0, fp8; };
template <bool MIX> __device__ __forceinline__ TTile p0_tile(const Args& a, unsigned char* ws, int it) {
    constexpr int I_IN = 16 * 44, I_E = 16 * 16;
    TTile t;
    if (MIX) { const bool in = it < I_IN; const int j = in ? it : it - I_IN; const int kb = in ? j / 44 : (j >> 4), nb = in ? j % 44 : (j & 15);
        t.fp8 = 0; t.src = in ? a.in[2] : a.in[14]; t.dst = ws + (in ? WS_WIN : WS_WOUT); t.Nsrc = in ? NPROJ : DM; t.k0 = 64 * kb; t.n0 = 64 * nb; t.orow0 = 64 * nb; return t; }
    const bool dn = it >= NEXP * 2 * I_E; const int e = dn ? (it - NEXP * 2 * I_E) / I_E : it / (2 * I_E), w = dn ? 2 : (it / I_E) % 2, q = it % I_E,     kb = q & 15, nb = q >> 4, n0 = 64 * nb;
    t.Nsrc = DM; t.k0 = 64 * kb; t.n0 = n0; t.fp8 = 1;
    const float* src = w == 0 ? a.in[20] : (w == 1 ? a.in[21] : a.in[22]);
    t.src = src + (size_t)e * DM * DM;
    t.dst = w == 2 ? ws + WS_WD + (size_t)e * DM * DM : ws + WS_WGU + (size_t)e * 2048 * DM;
    t.orow0 = w == 2 ? n0 : ((n0 >> 7) * 256 + (w == 1 ? 128 : 0) + (n0 & 127));
    return t;
}
__device__ __forceinline__ void p0_load(f32x4 (&v)[16], const TTile& t, int lane) {
    int n = t.n0 + 4 * (lane & 15); n = n < t.Nsrc ? n : t.Nsrc - 4; const float* p = t.src + (size_t)(t.k0 + (lane >> 4)) * t.Nsrc + n;
#pragma unroll
    for (int i = 0; i < 16; ++i) v[i] = __builtin_nontemporal_load((const f32x4*)(p + (size_t)(4 * i) * t.Nsrc));
}
__device__ __forceinline__ void p0_store(const f32x4 (&v)[16], const TTile& t, LAS float* scr, int lane) {
    const float keep = (t.n0 + 4 * (lane & 15)) < t.Nsrc ? 1.f : 0.f;
#pragma unroll
    for (int i = 0; i < 16; ++i) { LAS float* d = scr + ((lane >> 4) + 4 * i) * 65 + 4 * (lane & 15); d[0] = v[i].x * keep; d[1] = v[i].y * keep; d[2] = v[i].z * keep; d[3] = v[i].w * keep; }
    asm volatile("s_waitcnt lgkmcnt(0)" ::: "memory");
    const int c = lane & 7;
#pragma unroll
    for (int j = 0; j < 8; ++j) { const int n = (lane >> 3) + 8 * j; const LAS float* sp = scr + (8 * c) * 65 + n;
        if (t.fp8) { u32x2 o; o.x = pk4_fp8(sp[0 * 65] * WSCALE, sp[1 * 65] * WSCALE, sp[2 * 65] * WSCALE, sp[3 * 65] * WSCALE); o.y = pk4_fp8(sp[4 * 65] * WSCALE, sp[5 * 65] * WSCALE, sp[6 * 65] * WSCALE, sp[7 * 65] * WSCALE);
            *(u32x2*)(t.dst + (size_t)(t.orow0 + n) * DM + t.k0 + 8 * c) = o; }
        else { u32x4 o; o.x = pk2(sp[0 * 65], sp[1 * 65]); o.y = pk2(sp[2 * 65], sp[3 * 65]); o.z = pk2(sp[4 * 65], sp[5 * 65]); o.w = pk2(sp[6 * 65], sp[7 * 65]);
            *(u32x4*)(t.dst + ((size_t)(t.orow0 + n) * DM + t.k0 + 8 * c) * 2) = o; } }
    asm volatile("s_waitcnt lgkmcnt(0)" ::: "memory");
}
__device__ __forceinline__ void rms_row_to_bf16(const float* xrow, const float* gain, bf16_t* orow, int lane) {
    const f32x4* xr = (const f32x4*)xrow + lane; const f32x4* gr = (const f32x4*)gain + lane;
    f32x4 v[4]; float s = 0.f;
#pragma unroll
    for (int j = 0; j < 4; ++j) { v[j] = xr[64 * j]; s += (v[j].x * v[j].x + v[j].y * v[j].y) + (v[j].z * v[j].z + v[j].w * v[j].w); }
    const float rs = frsq(wave_sum(s) * (1.f / DM) + EPS);
    unsigned long long* o8 = (unsigned long long*)orow + lane;
#pragma unroll
    for (int j = 0; j < 4; ++j) { const f32x4 g = gr[64 * j]; o8[64 * j] = (unsigned long long)pk2(v[j].x * rs * g.x, v[j].y * rs * g.y) | ((unsigned long long)pk2(v[j].z * rs * g.z, v[j].w * rs * g.w) << 32); }
}

__device__ __forceinline__ void rms_row2_to_bf16(const float* x0, const float* x1, const float* gain, bf16_t* o0, bf16_t* o1, int lane) {
    const f32x4* xa = (const f32x4*)x0 + lane; const f32x4* xb = (const f32x4*)x1 + lane; const f32x4* gr = (const f32x4*)gain + lane;
    f32x4 va[4], vb[4]; float sa = 0.f, sb = 0.f;
#pragma unroll
    for (int j = 0; j < 4; ++j) { va[j] = __builtin_nontemporal_load(xa + 64 * j); vb[j] = __builtin_nontemporal_load(xb + 64 * j); }
#pragma unroll
    for (int j = 0; j < 4; ++j) { sa += (va[j].x * va[j].x + va[j].y * va[j].y) + (va[j].z * va[j].z + va[j].w * va[j].w); sb += (vb[j].x * vb[j].x + vb[j].y * vb[j].y) + (vb[j].z * vb[j].z + vb[j].w * vb[j].w); }
    const float ra = frsq(wave_sum(sa) * (1.f / DM) + EPS), rb = frsq(wave_sum(sb) * (1.f / DM) + EPS);
    unsigned long long* pa = (unsigned long long*)o0 + lane; unsigned long long* pb = (unsigned long long*)o1 + lane;
#pragma unroll
    for (int j = 0; j < 4; ++j) { const f32x4 g = gr[64 * j];
        pa[64 * j] = (unsigned long long)pk2(va[j].x * ra * g.x, va[j].y * ra * g.y) | ((unsigned long long)pk2(va[j].z * ra * g.z, va[j].w * ra * g.w) << 32);
        pb[64 * j] = (unsigned long long)pk2(vb[j].x * rb * g.x, vb[j].y * rb * g.y) | ((unsigned long long)pk2(vb[j].z * rb * g.z, vb[j].w * rb * g.w) << 32); }
}
constexpr int NT_MIX = 16 * 44 + 16 * 16, NT_EXP = NEXP * 3 * 256;
constexpr int M3_PER_WAVE = 2;
template <bool MIX, int t_lo, int t_hi> __device__ __forceinline__ void p0_tiles(Frame& F, const Args& a) {
    LAS float* scr = (LAS float*)(F.lds + F.wave * 16640);
    const int gw = F.vcu * NWAVES + F.wave, NGW = F.G * NWAVES;
    f32x4 va[16], vb[16];
    int it = t_lo + gw;
    TTile ta = p0_tile<MIX>(a, F.ws, it < t_hi ? it : t_hi - 1), tb = p0_tile<MIX>(a, F.ws, it < t_hi ? it : t_hi - 1);
    p0_load(va, ta, F.lane);
    while (it < t_hi) {
        int it2 = it + NGW;
        tb = p0_tile<MIX>(a, F.ws, it2 < t_hi ? it2 : t_hi - 1); p0_load(vb, tb, F.lane);
        p0_store(va, ta, scr, F.lane);
        it = it2; if (it >= t_hi) break;
        it2 = it + NGW;
        ta = p0_tile<MIX>(a, F.ws, it2 < t_hi ? it2 : t_hi - 1); p0_load(va, ta, F.lane);
        p0_store(vb, tb, scr, F.lane);
        it = it2;
    }
}
template <bool MIX> __device__ __forceinline__ void p0_tiles_rt(Frame& F, const Args& a, int it, const int stride, const int t_hi) {
    LAS float* scr = (LAS float*)(F.lds + F.wave * 16640);
    int lane = F.lane; asm volatile("" : "+v"(lane));
    f32x4 va[16], vb[16];
    TTile ta = p0_tile<MIX>(a, F.ws, it < t_hi ? it : t_hi - 1), tb = p0_tile<MIX>(a, F.ws, it < t_hi ? it : t_hi - 1);
    p0_load(va, ta, lane);
    while (it < t_hi) {
        int it2 = it + stride;
        tb = p0_tile<MIX>(a, F.ws, it2 < t_hi ? it2 : t_hi - 1); p0_load(vb, tb, lane);
        p0_store(va, ta, scr, lane);
        it = it2; if (it >= t_hi) break;
        it2 = it + stride;
        ta = p0_tile<MIX>(a, F.ws, it2 < t_hi ? it2 : t_hi - 1); p0_load(va, ta, lane);
        p0_store(vb, tb, scr, lane);
        it = it2;
    }
}
__device__ __forceinline__ void p0_prologue(Frame& F, const Args& a) {
    const int gw = F.vcu * NWAVES + F.wave, NGW = F.G * NWAVES;
    p0_tiles<true, 0, NT_MIX>(F, a);
    bf16_t* WRH = (bf16_t*)(F.ws + WS_WRT);
    for (int idx = blockIdx.x * NTHR + F.tid; idx < 48 * DM; idx += F.G * NTHR) { const int j = idx / DM, k = idx % DM; const float wv = j < 4 ? a.in[16][k * 4 + j] : (j < 36 ? a.in[18][k * 32 + (j - 4)] : 0.f); WRH[idx] = (bf16_t)f2bf(wv); }
    {
        bf16_t* WAT = (bf16_t*)(F.ws + WS_SMALL); bf16_t* WXT = WAT + 8 * 64 * 64; bf16_t* WUPT = WXT + 8 * 64 * 64;
        for (int idx = blockIdx.x * NTHR + F.tid; idx < 8 * 64 * 64; idx += F.G * NTHR) { const int h = idx >> 12, j = (idx >> 6) & 63, i = idx & 63;
            WAT[idx] = (bf16_t)f2bf(a.in[5][(h * 64 + i) * 64 + j]); WXT[idx] = (bf16_t)f2bf(a.in[7][(h * 64 + i) * 64 + j]); }
        for (int idx = blockIdx.x * NTHR + F.tid; idx < 256 * 32; idx += F.G * NTHR) { const int n = idx >> 5, k = idx & 31; WUPT[idx] = k < 16 ? (bf16_t)f2bf(a.in[11][k * 256 + n]) : (bf16_t)0; }
    }
    bf16_t* HN = (bf16_t*)(F.ws + WS_HN);
    for (int m = gw; m < NTOK; m += 2 * NGW) rms_row2_to_bf16(a.in[0] + (size_t)m * DM, a.in[0] + (size_t)(m + NGW) * DM, a.in[1], HN + (size_t)m * DM, HN + (size_t)(m + NGW) * DM, F.lane);
}

template <int KS> __device__ __forceinline__ f32x4 mma_ll(f32x4 acc, const LAS unsigned char* A, int lda, const LAS unsigned char* Bt, int ldb, int lane) {
    const LAS unsigned char* ap = A + (lane & 15) * lda + (lane >> 4) * 16; const LAS unsigned char* bp = Bt + (lane & 15) * ldb + (lane >> 4) * 16;
#pragma unroll
    for (int ks = 0; ks < KS; ++ks) acc = __builtin_amdgcn_mfma_f32_16x16x32_bf16(*(const LAS bf16x8*)(ap + ks * 64), *(const LAS bf16x8*)(bp + ks * 64), acc, 0, 0, 0);
    return acc;
}
template <int KS> __device__ __forceinline__ f32x4 mma_lg(f32x4 acc, const LAS unsigned char* A, int lda, const bf16_t* Bt, int ldb_elems, int lane) {
    const LAS unsigned char* ap = A + (lane & 15) * lda + (lane >> 4) * 16; const bf16_t* bp = Bt + (size_t)(lane & 15) * ldb_elems + (lane >> 4) * 8;
#pragma unroll
    for (int ks = 0; ks < KS; ++ks) acc = __builtin_amdgcn_mfma_f32_16x16x32_bf16(*(const LAS bf16x8*)(ap + ks * 64), *(const bf16x8*)(bp + ks * 32), acc, 0, 0, 0);
    return acc;
}
#define WAVE_LDS_FENCE() asm volatile("s_waitcnt lgkmcnt(0)" ::: "memory")
__device__ __forceinline__ float logsigmoidf_(float g) { return fminf(g, 0.f) - __logf(1.f + __expf(-fabsf(g))); }
__device__ __forceinline__ void unpack8(const u32x4 w, float (&f)[8]) { f[0] = bf2f(w.x & 0xffffu); f[1] = bf2f(w.x >> 16); f[2] = bf2f(w.y & 0xffffu); f[3] = bf2f(w.y >> 16); f[4] = bf2f(w.z & 0xffffu); f[5] = bf2f(w.z >> 16); f[6] = bf2f(w.w & 0xffffu); f[7] = bf2f(w.w >> 16); }
__device__ __forceinline__ u32x4 pack8(const float (&f)[8]) { u32x4 w; w.x = pk2(f[0], f[1]); w.y = pk2(f[2], f[3]); w.z = pk2(f[4], f[5]); w.w = pk2(f[6], f[7]); return w; }

constexpr int XS = 144;
constexpr int RG_AU = 8 * 64 * XS;
constexpr int GL_AL = 0, GL_BT = 5120, GL_T1 = 21504, GL_T2 = 30720, GL_T3 = 39936, GL_VT4 = 49152, GL_REGION = 67584;
static_assert(RG_AU + 8 * 8192 <= 143360 && 2 * GL_REGION <= 143360, "mixer LDS");

struct RgPre { bf16x8 ba0, ba1, bx0, bx1; float bias_a, bias_x, lamv, rgc; };
struct GlaPre { u32x4 al, v[4], k[2], q[2]; bf16x8 wup[4]; float bal[4]; f32x4 bq[2][2]; };
template <bool FIN> __device__ __forceinline__ RgPre rg_pre(const unsigned char* ws, const Args& a, int chunk, int w, int nt, int c16, int g4) {
    const bf16_t* WAT = (const bf16_t*)(ws + WS_SMALL); const bf16_t* WXT = WAT + 8 * 64 * 64; const int ch = 64 * w + 16 * nt + c16;
    const bf16_t* wa = WAT + (size_t)ch * 64 + g4 * 8; const bf16_t* wx = WXT + (size_t)ch * 64 + g4 * 8;
    RgPre p; p.ba0 = *(const bf16x8*)wa; p.ba1 = *(const bf16x8*)(wa + 32); p.bx0 = *(const bf16x8*)wx; p.bx1 = *(const bf16x8*)(wx + 32);
    p.bias_a = a.in[6][ch]; p.bias_x = a.in[8][ch]; p.lamv = a.in[9][ch]; p.rgc = FIN ? ((const float*)(ws + WS_RGC))[(size_t)chunk * RGW + ch] : 0.f; return p;
}
template <bool FIN> __device__ __forceinline__ GlaPre gla_pre(const unsigned char* ws, const Args& a, int t0, int hh, int ht, int c16, int g4) {
    const int chunk = t0 >> 6;
    const bf16_t* PROJ = (const bf16_t*)(ws + WS_PROJ); const bf16_t* WUPT = (const bf16_t*)(ws + WS_SMALL) + 2 * 8 * 64 * 64;
    GlaPre p; asm volatile("" : "+v"(ht), "+v"(c16));
    if (!FIN) { const int tok = (ht & 127) >> 1, half = ht & 1; p.al = *(const u32x4*)(PROJ + (size_t)(t0 + tok) * LDP + C_AL + 8 * half); }
#pragma unroll
    for (int i = 0; i < 2; ++i) { const int idx = ht + 256 * i, ec = idx >> 5, tp = idx & 31;
        p.v[2 * i] = *(const u32x4*)(PROJ + (size_t)(t0 + 2 * tp) * LDP + C_V + hh * 128 + 8 * ec); p.v[2 * i + 1] = *(const u32x4*)(PROJ + (size_t)(t0 + 2 * tp + 1) * LDP + C_V + hh * 128 + 8 * ec); }
    if (FIN) {
#pragma unroll
        for (int i = 0; i < 2; ++i) { const int idx = ht + 256 * i, tok = idx >> 3, dc = idx & 7;
            p.k[i] = *(const u32x4*)(PROJ + (size_t)(t0 + tok) * LDP + C_K + hh * 64 + 8 * dc); p.q[i] = *(const u32x4*)(PROJ + (size_t)(t0 + tok) * LDP + C_Q + hh * 64 + 8 * dc);
            const float* bc = (const float*)(ws + WS_BC) + ((size_t)(chunk * 4 + hh) * 64 + tok) * 64 + 8 * dc; p.bq[i][0] = *(const f32x4*)bc; p.bq[i][1] = *(const f32x4*)(bc + 4); }
    } else { const int dc = ht >> 5, tp = ht & 31;
        p.k[0] = *(const u32x4*)(PROJ + (size_t)(t0 + 2 * tp) * LDP + C_K + hh * 64 + 8 * dc); p.k[1] = *(const u32x4*)(PROJ + (size_t)(t0 + 2 * tp + 1) * LDP + C_K + hh * 64 + 8 * dc);
        p.q[0] = (u32x4){0u, 0u, 0u, 0u}; p.q[1] = p.q[0]; }
    if (!FIN) {
#pragma unroll
        for (int nt = 0; nt < 4; ++nt) { p.wup[nt] = *(const bf16x8*)(WUPT + (size_t)(hh * 64 + 16 * nt + c16) * 32 + g4 * 8); p.bal[nt] = a.in[12][hh * 64 + 16 * nt + c16]; } }
    return p;
}
__device__ __forceinline__ void ld8f(const LAS float* p, float (&f)[8]) { const f32x4 x = *(const LAS f32x4*)p, y = *(const LAS f32x4*)(p + 4); f[0] = x.x; f[1] = x.y; f[2] = x.z; f[3] = x.w; f[4] = y.x; f[5] = y.y; f[6] = y.z; f[7] = y.w; }

template <bool FIN> __device__ __forceinline__ void mixer_chunk(Frame& F, const Args& a, const int chunk) {
    const bf16_t* PROJ = (const bf16_t*)(F.ws + WS_PROJ); bf16_t* Y = (bf16_t*)(F.ws + WS_HN);
    const int t0 = chunk * 64, nloc = chunk & 127, lane = F.lane, w = F.wave, c16 = lane & 15, g4 = lane >> 4;
    LAS unsigned char* L = F.lds;
    const int s = w >> 2, q4 = w & 3, ht = F.tid & 255;
    GlaPre gp;
    if (FIN) { TPS(F, 100); TPS(F, 110); } else { TPS(F, 120); TPS(F, 130); }
    if constexpr (FIN) {
        const unsigned* HP = (const unsigned*)(F.ws + WS_HP);
        gp = gla_pre<FIN>(F.ws, a, t0, s, ht, c16, g4);
        const f32x4 cy0 = *(const f32x4*)((const float*)(F.ws + WS_RGC) + (size_t)chunk * RGW + 8 * lane), cy1 = *(const f32x4*)((const float*)(F.ws + WS_RGC) + (size_t)chunk * RGW + 8 * lane + 4);
        const f32x4 gn0 = *(const f32x4*)(a.in[10] + 8 * lane), gn1 = *(const f32x4*)(a.in[10] + 8 * lane + 4);
        const float cy[8] = {cy0.x, cy0.y, cy0.z, cy0.w, cy1.x, cy1.y, cy1.z, cy1.w}, gn[8] = {gn0.x, gn0.y, gn0.z, gn0.w, gn1.x, gn1.y, gn1.z, gn1.w};
#pragma unroll
        for (int ib = 0; ib < 8; ib += 4) {
            int lane = F.lane; asm volatile("" : "+v"(lane));
            u32x4 hp0[4], hp1[4], yr4[4];
#pragma unroll
            for (int i = 0; i < 4; ++i) { const size_t row = (size_t)(t0 + 8 * w + ib + i); hp0[i] = *(const u32x4*)(HP + row * RGW + 8 * lane); hp1[i] = *(const u32x4*)(HP + row * RGW + 8 * lane + 4); yr4[i] = *(const u32x4*)(PROJ + row * LDP + C_YR + 8 * lane); }
#pragma unroll
            for (int i = 0; i < 4; ++i) { const size_t row = (size_t)(t0 + 8 * w + ib + i);
                const unsigned hw[8] = {hp0[i].x, hp0[i].y, hp0[i].z, hp0[i].w, hp1[i].x, hp1[i].y, hp1[i].z, hp1[i].w};
                float hv[8], yv[8]; unpack8(yr4[i], yv); float ss = 0.f;
#pragma unroll
                for (int j = 0; j < 8; ++j) { hv[j] = (bf2f(hw[j] & 0xffffu) + bf2f(hw[j] >> 16) * cy[j]) * gelu_tanh(yv[j]); ss += hv[j] * hv[j]; }
                const float rs = frsq(wave_sum(ss) * (1.f / 512.f) + EPS);
#pragma unroll
                for (int j = 0; j < 8; ++j) hv[j] *= rs * gn[j];
                __builtin_nontemporal_store(pack8(hv), (u32x4*)(Y + row * DM + 8 * lane)); }
        }
    } else {
        LAS unsigned char* slab = L + w * (64 * XS);
        LAS float* au_a = (LAS float*)(L + RG_AU + w * 8192); LAS float* au_u = au_a + 1024;
        const int cg = lane & 7, gq = lane >> 3, ch0 = 64 * w + 8 * cg;
        u32x4 xrow[11];
#pragma unroll
        for (int r = 0; r < 11; ++r) { const int tl = nloc * 64 + 8 * gq - 3 + r; xrow[r] = (tl >= 0) ? *(const u32x4*)(PROJ + (size_t)(t0 + 8 * gq - 3 + r) * LDP + C_XR + ch0) : (u32x4){0u, 0u, 0u, 0u}; }
        f32x4 cwv[4][2], cbv[2];
#pragma unroll
        for (int j = 0; j < 4; ++j) { cwv[j][0] = *(const f32x4*)(a.in[3] + j * RGW + ch0); cwv[j][1] = *(const f32x4*)(a.in[3] + j * RGW + ch0 + 4); }
        cbv[0] = *(const f32x4*)(a.in[4] + ch0); cbv[1] = *(const f32x4*)(a.in[4] + ch0 + 4);
        RgPre cur = rg_pre<FIN>(F.ws, a, chunk, w, 0, c16, g4);
#pragma unroll
        for (int it = 0; it < 8; ++it) {
            float xc[8] = {cbv[0].x, cbv[0].y, cbv[0].z, cbv[0].w, cbv[1].x, cbv[1].y, cbv[1].z, cbv[1].w};
#pragma unroll
            for (int j = 0; j < 4; ++j) { float xv[8]; unpack8(xrow[it + j], xv);
                xc[0] += cwv[j][0].x * xv[0]; xc[1] += cwv[j][0].y * xv[1]; xc[2] += cwv[j][0].z * xv[2]; xc[3] += cwv[j][0].w * xv[3];
                xc[4] += cwv[j][1].x * xv[4]; xc[5] += cwv[j][1].y * xv[5]; xc[6] += cwv[j][1].z * xv[6]; xc[7] += cwv[j][1].w * xv[7]; }
            *(LAS u32x4*)(slab + (8 * gq + it) * XS + cg * 16) = pack8(xc);
        }
        WAVE_LDS_FENCE();
        bf16x8 af[4][2];
#pragma unroll
        for (int mt = 0; mt < 4; ++mt)
#pragma unroll
            for (int ks = 0; ks < 2; ++ks) af[mt][ks] = *(const LAS bf16x8*)(slab + (16 * mt + c16) * XS + ks * 64 + g4 * 16);
        float* RGSA = (float*)(F.ws + WS_RGSA); float* RGSH = (float*)(F.ws + WS_RGSH); unsigned* HP = (unsigned*)(F.ws + WS_HP);
        TPE(F, 120); TPS(F, 121);
#pragma unroll 1
        for (int nt = 0; nt < 4; ++nt) {
            const RgPre nxt = rg_pre<FIN>(F.ws, a, chunk, w, nt < 3 ? nt + 1 : 3, c16, g4);
            const int ch = 64 * w + 16 * nt + c16;
            const float sp8 = 8.f * log1pf(__expf(-cur.lamv));
            float xcq[4][4];
#pragma unroll
            for (int mt = 0; mt < 4; ++mt)
#pragma unroll
                for (int r = 0; r < 4; ++r) xcq[mt][r] = bf2f(*(const LAS unsigned short*)(slab + (16 * mt + 4 * g4 + r) * XS + (16 * nt + c16) * 2));
#pragma unroll
            for (int mt = 0; mt < 4; ++mt) {
                f32x4 R = {0.f, 0.f, 0.f, 0.f}, I = {0.f, 0.f, 0.f, 0.f};
                R = __builtin_amdgcn_mfma_f32_16x16x32_bf16(af[mt][0], cur.ba0, R, 0, 0, 0); R = __builtin_amdgcn_mfma_f32_16x16x32_bf16(af[mt][1], cur.ba1, R, 0, 0, 0);
                I = __builtin_amdgcn_mfma_f32_16x16x32_bf16(af[mt][0], cur.bx0, I, 0, 0, 0); I = __builtin_amdgcn_mfma_f32_16x16x32_bf16(af[mt][1], cur.bx1, I, 0, 0, 0);
#pragma unroll
                for (int r = 0; r < 4; ++r) { const int tok = 16 * mt + 4 * g4 + r;
                    const float rr = sigmoidf_(R[r] + cur.bias_a), ii = sigmoidf_(I[r] + cur.bias_x);
                    const float x2 = -2.f * sp8 * rr;
                    const float av = __expf(0.5f * x2);
                    const float om = (x2 > -0.1f) ? -x2 * (1.f + x2 * (0.5f + x2 * (0.16666667f + x2 * 0.041666668f))) : 1.f - __expf(x2);
                    au_a[tok * 16 + c16] = av; au_u[tok * 16 + c16] = __builtin_amdgcn_sqrtf(om) * (ii * xcq[mt][r]); }
            }
            WAVE_LDS_FENCE();
            {
                float av[16], uv[16]; float P = 1.f, H = 0.f;
#pragma unroll
                for (int i = 0; i < 16; ++i) { av[i] = au_a[(16 * g4 + i) * 16 + c16]; uv[i] = au_u[(16 * g4 + i) * 16 + c16]; }
#pragma unroll
                for (int i = 0; i < 16; ++i) { H = av[i] * H + uv[i]; P *= av[i]; }
                float hin = 0.f, pin = 1.f, Pall = 1.f;
#pragma unroll
                for (int j = 0; j < 4; ++j) { const float Pj = __shfl(P, c16 + 16 * j), Hj = __shfl(H, c16 + 16 * j); if (j < g4) { hin = Pj * hin + Hj; pin *= Pj; } Pall *= Pj; }
                if (g4 == 3) { RGSA[(size_t)chunk * RGW + ch] = Pall; RGSH[(size_t)chunk * RGW + ch] = P * hin + H; }
                LAS unsigned* hp = (LAS unsigned*)au_a; float h = hin, p = pin;
#pragma unroll
                for (int i = 0; i < 16; ++i) { h = av[i] * h + uv[i]; p *= av[i]; hp[(16 * g4 + i) * 16 + c16] = f2bf(h) | (f2bf(p) << 16); }
                WAVE_LDS_FENCE();
                u32x4 rr[4];
#pragma unroll
                for (int k = 0; k < 4; ++k) rr[k] = *(const LAS u32x4*)(hp + (16 * k + (lane >> 2)) * 16 + (lane & 3) * 4);
#pragma unroll
                for (int k = 0; k < 4; ++k) __builtin_nontemporal_store(rr[k], (u32x4*)(HP + (size_t)(t0 + 16 * k + (lane >> 2)) * RGW + 64 * w + 16 * nt + (lane & 3) * 4));
            }
            WAVE_LDS_FENCE();
            cur = nxt;
        }
        TPE(F, 121);
        gp = gla_pre<FIN>(F.ws, a, t0, s, ht, c16, g4);
        __syncthreads();
    }
    if (FIN) { TPE(F, 102); TPE(F, 110); TPS(F, 103); } else { TPE(F, 130); TPS(F, 123); }
    bf16_t* KVT = (bf16_t*)(F.ws + WS_KVT); float* DEC = (float*)(F.ws + WS_DEC); const bf16_t* ST = (const bf16_t*)(F.ws + WS_ST);
#pragma unroll
    for (int pass = 0; pass < 2; ++pass) {
        const int hh = 2 * pass + s;
        LAS unsigned char* R = L + s * GL_REGION;
        LAS float* BT = (LAS float*)(R + GL_BT);
        LAS unsigned char* VT = R + (FIN ? GL_VT4 : GL_T2);
        if (FIN) TPS(F, 140);
        if (!FIN) { if (ht < 128) { const int tok = ht >> 1, half = ht & 1; *(LAS u32x4*)(R + GL_AL + tok * 80 + half * 16) = gp.al; *(LAS u32x4*)(R + GL_AL + tok * 80 + 32 + half * 16) = (u32x4){0u, 0u, 0u, 0u}; } }
#pragma unroll
        for (int i = 0; i < 2; ++i) { const int idx = ht + 256 * i, ec = idx >> 5, tp = idx & 31; const u32x4 v0 = gp.v[2 * i], v1 = gp.v[2 * i + 1];
            LAS unsigned* vt = (LAS unsigned*)(VT + (8 * ec) * XS + tp * 4);
            vt[0 * (XS / 4)] = (v0.x & 0xffffu) | (v1.x << 16); vt[1 * (XS / 4)] = (v0.x >> 16) | (v1.x & 0xffff0000u); vt[2 * (XS / 4)] = (v0.y & 0xffffu) | (v1.y << 16); vt[3 * (XS / 4)] = (v0.y >> 16) | (v1.y & 0xffff0000u);
            vt[4 * (XS / 4)] = (v0.z & 0xffffu) | (v1.z << 16); vt[5 * (XS / 4)] = (v0.z >> 16) | (v1.z & 0xffff0000u); vt[6 * (XS / 4)] = (v0.w & 0xffffu) | (v1.w << 16); vt[7 * (XS / 4)] = (v0.w >> 16) | (v1.w & 0xffff0000u); }
        bf16x8 stf[8][2]; u32x4 gv4[4]; float gnl[8];
        if constexpr (!FIN) {
            __syncthreads();
            { const bf16x8 afr = *(const LAS bf16x8*)(R + GL_AL + (16 * q4 + c16) * 80 + g4 * 16);
#pragma unroll
              for (int nt = 0; nt < 4; ++nt) { f32x4 acc = {0.f, 0.f, 0.f, 0.f}; acc = __builtin_amdgcn_mfma_f32_16x16x32_bf16(afr, gp.wup[nt], acc, 0, 0, 0);
#pragma unroll
                for (int r = 0; r < 4; ++r) BT[(16 * q4 + 4 * g4 + r) * 64 + 16 * nt + c16] = logsigmoidf_(acc[r] + gp.bal[nt]) * (1.f / 16.f); } }
            __syncthreads();
            if (q4 == 0) { float cv[64];
#pragma unroll
                for (int tok = 0; tok < 64; ++tok) cv[tok] = BT[tok * 64 + lane];
#pragma unroll
                for (int tok = 1; tok < 64; ++tok) cv[tok] += cv[tok - 1];
#pragma unroll
                for (int tok = 0; tok < 64; ++tok) BT[tok * 64 + lane] = cv[tok]; }
            __syncthreads();
            { f32x4* bc = (f32x4*)((float*)(F.ws + WS_BC) + (size_t)(chunk * 4 + hh) * 4096);
#pragma unroll
              for (int i = 0; i < 4; ++i) __builtin_nontemporal_store(((const LAS f32x4*)BT)[ht + 256 * i], bc + ht + 256 * i); }
        } else {
            int htq = ht, c16q = c16; asm volatile("" : "+v"(htq), "+v"(c16q));
            const bf16_t* st = ST + (size_t)(chunk * 4 + hh) * 128 * 64;
#pragma unroll
            for (int nt = 0; nt < 8; ++nt) { stf[nt][0] = *(const bf16x8*)(st + (size_t)(16 * nt + c16q) * 64 + g4 * 8); stf[nt][1] = *(const bf16x8*)(st + (size_t)(16 * nt + c16q) * 64 + g4 * 8 + 32); gnl[nt] = a.in[13][16 * nt + c16q]; }
#pragma unroll
            for (int i = 0; i < 4; ++i) { const int idx = htq + 256 * i, tok = idx >> 4, ec = idx & 15; gv4[i] = *(const u32x4*)(PROJ + (size_t)(t0 + tok) * LDP + C_G + hh * 128 + 8 * ec); }
        }
        if (!FIN) { const int dc = ht >> 5, tp = ht & 31;
            float b0[8], b1[8], bl[8], k0[8], k1[8]; ld8f(BT + (2 * tp) * 64 + 8 * dc, b0); ld8f(BT + (2 * tp + 1) * 64 + 8 * dc, b1); ld8f(BT + 63 * 64 + 8 * dc, bl); unpack8(gp.k[0], k0); unpack8(gp.k[1], k1);
            LAS unsigned* ke = (LAS unsigned*)(R + GL_T1 + (8 * dc) * XS + tp * 4);
#pragma unroll
            for (int j = 0; j < 8; ++j) ke[j * (XS / 4)] = pk2(k0[j] * __expf(bl[j] - b0[j]), k1[j] * __expf(bl[j] - b1[j]));
            if (ht < 64) DEC[(size_t)(chunk * 4 + hh) * 64 + ht] = __expf(BT[63 * 64 + ht]);
        } else {
#pragma unroll
            for (int i = 0; i < 2; ++i) { const int idx = ht + 256 * i, tok = idx >> 3, dc = idx & 7;
                const float bv[8] = {gp.bq[i][0].x, gp.bq[i][0].y, gp.bq[i][0].z, gp.bq[i][0].w, gp.bq[i][1].x, gp.bq[i][1].y, gp.bq[i][1].z, gp.bq[i][1].w}; float kv[8], qv[8]; unpack8(gp.k[i], kv); unpack8(gp.q[i], qv);
#pragma unroll
                for (int j = 0; j < 8; ++j) { const float eb = __expf(bv[j]); qv[j] *= 0.125f * eb; kv[j] *= __expf(-bv[j]); }
                *(LAS u32x4*)(R + GL_T1 + tok * XS + dc * 16) = pack8(qv); *(LAS u32x4*)(R + GL_T2 + tok * XS + dc * 16) = pack8(kv); }
        }
        if (pass == 0) gp = gla_pre<FIN>(F.ws, a, t0, 2 + s, ht, c16, g4);
        __syncthreads();
        if (FIN) { TPE(F, 143); TPS(F, 144); }
        if (FIN) TPS(F, 105);
        if (!FIN) {
#pragma unroll
            for (int mi = 0; mi < 2; ++mi) { const int mt = 2 * q4 + mi;
#pragma unroll
                for (int nt = 0; nt < 4; ++nt) { f32x4 acc = {0.f, 0.f, 0.f, 0.f}; acc = mma_ll<2>(acc, VT + (16 * mt) * XS, XS, R + GL_T1 + (16 * nt) * XS, XS, lane);
#pragma unroll
                    for (int r = 0; r < 4; ++r) KVT[((size_t)(chunk * 4 + hh) * 128 + 16 * mt + 4 * g4 + r) * 64 + 16 * nt + c16] = (bf16_t)f2bf(acc[r]); } }
        } else {
#pragma unroll
            for (int nt = 0; nt < 4; ++nt) { f32x4 acc = {0.f, 0.f, 0.f, 0.f}; acc = mma_ll<2>(acc, R + GL_T2 + (16 * q4) * XS, XS, R + GL_T1 + (16 * nt) * XS, XS, lane);
                const int i = 16 * nt + c16, j0 = 16 * q4 + 4 * g4;
                u32x2 pw; pw.x = pk2(j0 <= i ? acc[0] : 0.f, j0 + 1 <= i ? acc[1] : 0.f); pw.y = pk2(j0 + 2 <= i ? acc[2] : 0.f, j0 + 3 <= i ? acc[3] : 0.f);
                *(LAS u32x2*)(R + GL_T3 + i * XS + j0 * 2) = pw; }
            __syncthreads();
            if (FIN) { TPE(F, 144); TPS(F, 145); }
            f32x4 o[8];
            { const bf16x8 qa0 = *(const LAS bf16x8*)(R + GL_T1 + (16 * q4 + c16) * XS + g4 * 16), qa1 = *(const LAS bf16x8*)(R + GL_T1 + (16 * q4 + c16) * XS + 64 + g4 * 16);
#pragma unroll
              for (int nt = 0; nt < 8; ++nt) { f32x4 acc = {0.f, 0.f, 0.f, 0.f};
                acc = mma_ll<2>(acc, R + GL_T3 + (16 * q4) * XS, XS, VT + (16 * nt) * XS, XS, lane);
                acc = __builtin_amdgcn_mfma_f32_16x16x32_bf16(qa0, stf[nt][0], acc, 0, 0, 0); acc = __builtin_amdgcn_mfma_f32_16x16x32_bf16(qa1, stf[nt][1], acc, 0, 0, 0);
                o[nt] = acc; } }
            float rs[4];
#pragma unroll
            for (int r = 0; r < 4; ++r) { float ss = 0.f;
#pragma unroll
                for (int nt = 0; nt < 8; ++nt) ss += o[nt][r] * o[nt][r];
                ss += __shfl_xor(ss, 1); ss += __shfl_xor(ss, 2); ss += __shfl_xor(ss, 4); ss += __shfl_xor(ss, 8);
                rs[r] = frsq(ss * (1.f / 128.f) + EPS); }
            LAS unsigned short* OY = (LAS unsigned short*)(R + GL_BT);
#pragma unroll
            for (int nt = 0; nt < 8; ++nt)
#pragma unroll
                for (int r = 0; r < 4; ++r) OY[(16 * q4 + 4 * g4 + r) * 128 + 16 * nt + c16] = (unsigned short)f2bf(o[nt][r] * rs[r] * gnl[nt]);
            __syncthreads();
            if (FIN) { TPE(F, 145); TPS(F, 146); }
            int hts = ht; asm volatile("" : "+v"(hts));
#pragma unroll
            for (int i = 0; i < 4; ++i) { const int idx = hts + 256 * i, tok = idx >> 4, ec = idx & 15;
                float ov[8], gv[8]; unpack8(*(const LAS u32x4*)(OY + tok * 128 + 8 * ec), ov); unpack8(gv4[i], gv);
#pragma unroll
                for (int j = 0; j < 8; ++j) ov[j] *= gv[j] * sigmoidf_(gv[j]);
                __builtin_nontemporal_store(pack8(ov), (u32x4*)(Y + (size_t)(t0 + tok) * DM + 512 + hh * 128 + 8 * ec)); }
        }
        __syncthreads();
        if (FIN) TPE(F, 146);
        if (FIN) TPE(F, 105);
    }
    if (FIN) TPE(F, 103); else TPE(F, 123);
}

__device__ __forceinline__ void m3_scan(Frame& F, const Args& a, const int nt_main) {
    const bf16_t* KVT = (const bf16_t*)(F.ws + WS_KVT); const float* DEC = (const float*)(F.ws + WS_DEC); bf16_t* ST = (bf16_t*)(F.ws + WS_ST);
    const float* RGSA = (const float*)(F.ws + WS_RGSA); const float* RGSH = (const float*)(F.ws + WS_RGSH); float* RGC = (float*)(F.ws + WS_RGC);
    const int bx = blockIdx.x;
    if (F.tid < 256) {
        for (int id = bx * 256 + F.tid; id < 65536; id += F.G * 256) {
            const int d = id & 63, e = (id >> 6) & 127, bh = id >> 13, b = bh >> 2, hh = bh & 3;
            float sv = 0.f;
#define M3_LD(kv, dc, n0) _Pragma("unroll") for (int q = 0; q < 16; ++q) { const size_t ch = (size_t)((b * 128 + (n0) + q) * 4 + hh); kv[q] = bf2f(__builtin_nontemporal_load(KVT + (ch * 128 + e) * 64 + d)); dc[q] = DEC[ch * 64 + d]; }
#define M3_USE(kv, dc, n0) _Pragma("unroll") for (int q = 0; q < 16; ++q) { const size_t ch = (size_t)((b * 128 + (n0) + q) * 4 + hh); ST[(ch * 128 + e) * 64 + d] = (bf16_t)f2bf(sv); sv = dc[q] * sv + kv[q]; }
            float kva[16], dca[16], kvb[16], dcb[16];
            M3_LD(kva, dca, 0)
#pragma unroll 1
            for (int n = 0; n < 128; n += 32) {
                M3_LD(kvb, dcb, n + 16)
                M3_USE(kva, dca, n)
                const int n2 = (n + 32 < 128) ? n + 32 : n + 16;
                M3_LD(kva, dca, n2)
                M3_USE(kvb, dcb, n + 16)
            }
#undef M3_LD
#undef M3_USE
        }
    } else if (bx < 4) {
        const int id = bx * 256 + (F.tid - 256), b = id >> 9, ch = id & 511;
        float h = 0.f;
#define M3_LD(av, hv, n0) _Pragma("unroll") for (int q = 0; q < 16; ++q) { const size_t o = (size_t)(b * 128 + (n0) + q) * RGW + ch; av[q] = RGSA[o]; hv[q] = RGSH[o]; }
#define M3_USE(av, hv, n0) _Pragma("unroll") for (int q = 0; q < 16; ++q) { const size_t o = (size_t)(b * 128 + (n0) + q) * RGW + ch; RGC[o] = h; h = av[q] * h + hv[q]; }
        float ava[16], hva[16], avb[16], hvb[16];
        M3_LD(ava, hva, 0)
#pragma unroll 1
        for (int n = 0; n < 128; n += 32) {
            M3_LD(avb, hvb, n + 16)
            M3_USE(ava, hva, n)
            const int n2 = (n + 32 < 128) ? n + 32 : n + 16;
            M3_LD(ava, hva, n2)
            M3_USE(avb, hvb, n + 16)
        }
#undef M3_LD
#undef M3_USE
    } else {
        p0_tiles_rt<false>(F, a, nt_main + (bx - 4) * 4 + (F.wave - 4), (F.G - 4) * 4, NT_EXP);
    }
}

__device__ __forceinline__ void p6_router(Frame& F, const Args& a) {
    const bf16_t* Hb = (const bf16_t*)(F.ws + WS_HB); unsigned char* HN8 = F.ws + WS_HN; const bf16_t* WRH = (const bf16_t*)(F.ws + WS_WRT);
    const float* gain = a.in[15]; const float* bg = a.in[17]; const float* be = a.in[19];
    int* STOK = (int*)(F.ws + WS_STOK); float* SW = (float*)(F.ws + WS_SW); int* TIDX = (int*)(F.ws + WS_TIDX); float* RS = (float*)(F.ws + WS_RS);
    unsigned* gcnt = F.ctl + CW_GCNT;
    LAS float* part = (LAS float*)F.lds;
    LAS float* ssp = part + 8 * 64 * 48;
    LAS int* lcnt = (LAS int*)(ssp + 512); LAS int* lbase = lcnt + 32; LAS int* rec_e = lbase + 32; LAS int* rec_l = rec_e + 128; LAS float* rec_w = (LAS float*)(rec_l + 128); LAS float* bias = rec_w + 128;
    const int lane = F.lane, c16 = lane & 15, g4 = lane >> 4, kq = F.wave;
    for (int grp = blockIdx.x; grp < NTOK / 64; grp += F.G) {
        if (F.tid < 32) lcnt[F.tid] = 0;
        if (F.tid >= 64 && F.tid < 100) { const int o = F.tid - 64; bias[o] = o < 4 ? bg[o] : be[o - 4]; }
        TPS(F, 160);
        for (int rep = 0; rep < 1 + (int)((REP_MASK >> 6) & 1u); ++rep) {
            if (rep) __syncthreads();
            bf16x8 wh[4][3]; f32x4 gk[4][2]; u32x4 hq[4][4];
#pragma unroll
            for (int ks = 0; ks < 4; ++ks) hq[0][ks] = *(const u32x4*)(Hb + (size_t)(grp * 64 + c16) * DM + 128 * kq + 32 * ks + 8 * g4);
#pragma unroll
            for (int ks = 0; ks < 4; ++ks) { const int k0 = 128 * kq + 32 * ks + 8 * g4; gk[ks][0] = *(const f32x4*)(gain + k0); gk[ks][1] = *(const f32x4*)(gain + k0 + 4);
#pragma unroll
                for (int nt = 0; nt < 3; ++nt) wh[ks][nt] = *(const bf16x8*)(WRH + (size_t)(16 * nt + c16) * DM + k0); }
#pragma unroll
            for (int mt = 1; mt < 4; ++mt)
#pragma unroll
                for (int ks = 0; ks < 4; ++ks) hq[mt][ks] = *(const u32x4*)(Hb + (size_t)(grp * 64 + 16 * mt + c16) * DM + 128 * kq + 32 * ks + 8 * g4);
#pragma unroll
            for (int mt = 0; mt < 4; ++mt) {
                int c16 = lane & 15, g4 = lane >> 4; asm volatile("" : "+v"(c16), "+v"(g4));
                const int t = grp * 64 + 16 * mt + c16;
                f32x4 acc[3] = {{0.f, 0.f, 0.f, 0.f}, {0.f, 0.f, 0.f, 0.f}, {0.f, 0.f, 0.f, 0.f}}; float ss = 0.f;
#pragma unroll
                for (int ks = 0; ks < 4; ++ks) {
                    const int k0 = 128 * kq + 32 * ks + 8 * g4; const f32x4 g0 = gk[ks][0], g1 = gk[ks][1]; float hf[8]; unpack8(hq[mt][ks], hf);
                    ss += (hf[0] * hf[0] + hf[1] * hf[1]) + (hf[2] * hf[2] + hf[3] * hf[3]) + (hf[4] * hf[4] + hf[5] * hf[5]) + (hf[6] * hf[6] + hf[7] * hf[7]);
                    float v[8] = {hf[0] * g0.x, hf[1] * g0.y, hf[2] * g0.z, hf[3] * g0.w, hf[4] * g1.x, hf[5] * g1.y, hf[6] * g1.z, hf[7] * g1.w};
                    bf16x8 ahi, alo;
#pragma unroll
                    for (int j = 0; j < 8; ++j) { const unsigned hi = f2bf(v[j]); ahi[j] = (short)hi; alo[j] = (short)f2bf(v[j] - bf2f(hi)); }
                    { u32x2 p8; p8.x = pk4_fp8(v[0], v[1], v[2], v[3]); p8.y = pk4_fp8(v[4], v[5], v[6], v[7]); *(u32x2*)(HN8 + (size_t)t * DM + k0) = p8; }
#pragma unroll
                    for (int nt = 0; nt < 3; ++nt) {
                        acc[nt] = __builtin_amdgcn_mfma_f32_16x16x32_bf16(ahi, wh[ks][nt], acc[nt], 0, 0, 0); acc[nt] = __builtin_amdgcn_mfma_f32_16x16x32_bf16(alo, wh[ks][nt], acc[nt], 0, 0, 0); }
                }
                ss += __shfl_xor(ss, 16); ss += __shfl_xor(ss, 32);
                if (g4 == 0) ssp[kq * 64 + 16 * mt + c16] = ss;
#pragma unroll
                for (int nt = 0; nt < 3; ++nt)
#pragma unroll
                    for (int r = 0; r < 4; ++r) part[(kq * 64 + 16 * mt + 4 * g4 + r) * 48 + 16 * nt + c16] = acc[nt][r];
            }
        }
        __syncthreads();
        TPE(F, 160); TPS(F, 161);
        if (F.tid < 64) {
            const int tl = F.tid, t = grp * 64 + tl;
            float ssq = 0.f;
#pragma unroll
            for (int q = 0; q < 8; ++q) ssq += ssp[q * 64 + tl];
            const float rs = frsq(ssq * (1.f / DM) + EPS);
            RS[t] = rs;
            float lg[36];
#pragma unroll
            for (int o = 0; o < 36; ++o) lg[o] = 0.f;
#pragma unroll 1
            for (int q = 0; q < 8; ++q) { const LAS float* pp = part + (q * 64 + tl) * 48;
#pragma unroll
                for (int o = 0; o < 36; ++o) lg[o] += pp[o]; }
#pragma unroll
            for (int o = 0; o < 36; ++o) lg[o] *= rs;
            float gl[4];
#pragma unroll
            for (int q = 0; q < 4; ++q) gl[q] = lg[q] + bias[q];
            int gi = 0; float gm = gl[0];
#pragma unroll
            for (int q = 1; q < 4; ++q) if (gl[q] > gm) { gm = gl[q]; gi = q; }
            float gs = 0.f;
#pragma unroll
            for (int q = 0; q < 4; ++q) gs += __expf(gl[q] - gm);
            const float gwt = frcp(gs);
            float le[8];
#pragma unroll
            for (int q = 0; q < 8; ++q) { float x = lg[4 + q] + bias[4 + q];
#pragma unroll
                for (int g2 = 1; g2 < 4; ++g2) x = (gi == g2) ? (lg[4 + g2 * 8 + q] + bias[4 + g2 * 8 + q]) : x;
                le[q] = x; }
            int i1 = 0; float m1 = le[0];
#pragma unroll
            for (int q = 1; q < 8; ++q) if (le[q] > m1) { m1 = le[q]; i1 = q; }
            int i2 = -1; float m2 = -3.0e38f;
#pragma unroll
            for (int q = 0; q < 8; ++q) if (q != i1 && le[q] > m2) { m2 = le[q]; i2 = q; }
            const float e2 = __expf(m2 - m1), inv = frcp(1.f + e2);
            const int ea = gi * 8 + i1, eb = gi * 8 + i2;
            const int la_ = __hip_atomic_fetch_add(lcnt + ea, 1, __ATOMIC_RELAXED, __HIP_MEMORY_SCOPE_WORKGROUP), lb_ = __hip_atomic_fetch_add(lcnt + eb, 1, __ATOMIC_RELAXED, __HIP_MEMORY_SCOPE_WORKGROUP);
            rec_e[tl * 2] = ea; rec_l[tl * 2] = la_; rec_w[tl * 2] = gwt * inv; rec_e[tl * 2 + 1] = eb; rec_l[tl * 2 + 1] = lb_; rec_w[tl * 2 + 1] = gwt * e2 * inv;
        }
        __syncthreads();
        TPE(F, 161); TPS(F, 162);
        if (F.tid < 32) { const int cnum = lcnt[F.tid]; lbase[F.tid] = cnum ? (int)__hip_atomic_fetch_add(gcnt + F.tid, (unsigned)cnum, __ATOMIC_RELAXED, __HIP_MEMORY_SCOPE_AGENT) : 0; }
        __syncthreads();
        if (F.tid < 128) { const int e = rec_e[F.tid], idx = e * CAP + lbase[e] + rec_l[F.tid], t = grp * 64 + (F.tid >> 1);
            STOK[idx] = t; SW[idx] = rec_w[F.tid]; TIDX[t * 2 + (F.tid & 1)] = idx; }
        __syncthreads();
        TPE(F, 162);
    }
}

__device__ __forceinline__ int moe_setup(Frame& F, int ncol_log2, bool tables, bool scale_is_rs) {
    const unsigned* gcnt = F.ctl + CW_GCNT;
    LAS int* lcnt = (LAS int*)(F.lds + L_CNT); LAS int* tst = (LAS int*)(F.lds + L_TST); LAS int* utab = (LAS int*)(F.lds + L_UTAB);
    LAS unsigned* rowt = (LAS unsigned*)(F.lds + L_ROWT); LAS float* wt = (LAS float*)(F.lds + L_WT);
    const int* STOK = (const int*)(F.ws + WS_STOK); const float* SW = (const float*)(F.ws + WS_SW); const float* RS = (const float*)(F.ws + WS_RS);
    if (F.tid < 32) lcnt[F.tid] = (int)__hip_atomic_load(gcnt + F.tid, __ATOMIC_RELAXED, __HIP_MEMORY_SCOPE_AGENT);
    __syncthreads();
    LAS int* fst = (LAS int*)(F.lds + L_FST); LAS int* hst = (LAS int*)(F.lds + L_HST);
    if (F.tid == 0) { int s = 0, f = 0, h = 0;
        for (int e = 0; e < 32; ++e) { const int c = lcnt[e], nt = (c + 255) >> 8, hf = (nt > 0 && c - (nt - 1) * 256 <= 128) ? 1 : 0;
            tst[e] = s; fst[e] = f; hst[e] = h; s += nt; f += nt - hf; h += hf; }
        tst[32] = s; tst[33] = f; tst[34] = h; }
    __syncthreads();
    if (!tables) return 0;
    const int total = tst[32] << ncol_log2;
    int nu = 0;
    for (int ui = 0; ui < MAXU; ++ui) if (ui * F.G + F.vcu < total) ++nu;
    if (F.tid < nu) { const int ui = F.tid, Lq = ui * F.G + F.vcu, P = Lq >> ncol_log2, pn = Lq & ((1 << ncol_log2) - 1);
        const int NF = tst[33]; const bool isf = P < NF; const int q = isf ? P : P - NF; const LAS int* pre = isf ? fst : hst;
        int e = 0;
        for (int j = 1; j < 32; ++j) e += (pre[j] <= q) ? 1 : 0;
        const int lt = isf ? q - fst[e] : tst[e + 1] - tst[e] - 1, rb = tst[e] + lt;
        const int r0 = lt * 256; int rows = lcnt[e] - r0; rows = rows > 256 ? 256 : rows;
        utab[ui * 8 + 0] = rb; utab[ui * 8 + 1] = pn; utab[ui * 8 + 2] = e; utab[ui * 8 + 3] = rows; utab[ui * 8 + 4] = r0; }
    __syncthreads();
    constexpr int NE = MAXU / 2;
    int tok[NE], idx[NE]; bool ok[NE]; float sc[NE];
#pragma unroll
    for (int j = 0; j < NE; ++j) { const int ent = F.tid + 512 * j, ui = ent >> 8, r = ent & 255; ok[j] = false; tok[j] = 0; idx[j] = 0;
        if (ui < nu) { const int e = utab[ui * 8 + 2], rows = utab[ui * 8 + 3], r0 = utab[ui * 8 + 4]; ok[j] = r < rows; idx[j] = e * CAP + r0 + r; } }
#pragma unroll
    for (int j = 0; j < NE; ++j) { tok[j] = ok[j] ? STOK[idx[j]] : 0; sc[j] = (ok[j] && !scale_is_rs) ? SW[idx[j]] : 0.f; }
    if (scale_is_rs) {
#pragma unroll
        for (int j = 0; j < NE; ++j) sc[j] = ok[j] ? RS[tok[j]] : 0.f;
    }
#pragma unroll
    for (int j = 0; j < NE; ++j) { const int ent = F.tid + 512 * j; if ((ent >> 8) < nu) { rowt[ent] = (unsigned)tok[j] * (unsigned)DM;     wt[ent] = sc[j]; } }
    __syncthreads();
    return nu;
}

struct P9Pre { u32x2 h[8][4]; int mys; };
__device__ __forceinline__ void p9_pre(Frame& F, const int tb, P9Pre& p) {
    const LAS int* tst = (const LAS int*)(F.lds + L_TST);
    const int* TIDX = (const int*)(F.ws + WS_TIDX); const bf16_t* HB = (const bf16_t*)(F.ws + WS_HB);
    const int NGW = F.G * NWAVES, lane = F.lane;
    int myidx = 0; { const int t = tb + NGW * (lane >> 1); if (lane < 16 && t < NTOK) myidx = TIDX[t * 2 + (lane & 1)]; }
#pragma unroll
    for (int j = 0; j < 8; ++j) { int t = tb + NGW * j; t = t < NTOK ? t : tb; const u32x2* hp = (const u32x2*)(HB + (size_t)t * DM) + lane;
#pragma unroll
        for (int q = 0; q < 4; ++q) p.h[j][q] = __builtin_nontemporal_load(hp + 64 * q); }
    p.mys = tst[myidx >> 14] * 256 + (myidx & (CAP - 1));
}
__device__ __forceinline__ void p9_post(Frame& F, const Args& a, const int tb, const P9Pre& p) {
    const unsigned char* YB = F.ws + WS_YB; const float* gain = a.in[23];
    const int NGW = F.G * NWAVES, lane = F.lane;
    unsigned y1[8][4], y2[8][4];
#pragma unroll
    for (int j = 0; j < 8; ++j) { const size_t s1 = (size_t)__shfl(p.mys, 2 * j), s2 = (size_t)__shfl(p.mys, 2 * j + 1);
        const unsigned* p1 = (const unsigned*)(YB + s1 * DM) + lane; const unsigned* p2 = (const unsigned*)(YB + s2 * DM) + lane;
#pragma unroll
        for (int q = 0; q < 4; ++q) { y1[j][q] = __builtin_nontemporal_load(p1 + 64 * q); y2[j][q] = __builtin_nontemporal_load(p2 + 64 * q); } }
    const f32x4* gr = (const f32x4*)gain + lane;
    f32x4 gq[4];
#pragma unroll
    for (int q = 0; q < 4; ++q) gq[q] = gr[64 * q];
#pragma unroll
    for (int j = 0; j < 8; ++j) {
        const int t = tb + NGW * j;
        f32x4 v[4]; float ss = 0.f;
#pragma unroll
        for (int q = 0; q < 4; ++q) {
            const u32x2 hq = p.h[j][q];
            const f32x2 a0 = __builtin_amdgcn_cvt_pk_f32_fp8((int)y1[j][q], false), a1 = __builtin_amdgcn_cvt_pk_f32_fp8((int)y1[j][q], true), b0 = __builtin_amdgcn_cvt_pk_f32_fp8((int)y2[j][q], false), b1 = __builtin_amdgcn_cvt_pk_f32_fp8((int)y2[j][q], true);
            v[q].x = bf2f(hq.x & 0xffffu) + (a0.x + b0.x) * YUNSCALE; v[q].y = bf2f(hq.x >> 16) + (a0.y + b0.y) * YUNSCALE; v[q].z = bf2f(hq.y & 0xffffu) + (a1.x + b1.x) * YUNSCALE; v[q].w = bf2f(hq.y >> 16) + (a1.y + b1.y) * YUNSCALE;
            ss += (v[q].x * v[q].x + v[q].y * v[q].y) + (v[q].z * v[q].z + v[q].w * v[q].w); }
        const float rs = frsq(wave_sum(ss) * (1.f / DM) + EPS);
        if (t < NTOK) { f32x4* xo = (f32x4*)(F.out + (size_t)t * DM) + lane;
#pragma unroll
            for (int q = 0; q < 4; ++q) __builtin_nontemporal_store(v[q] * rs * gq[q], xo + 64 * q); }
    }
}

__global__ void __launch_bounds__(NTHR, 2) fwd(Args args) {
    extern __shared__ __attribute__((aligned(16))) unsigned char lds_raw[];
    Frame F;
    F.lds = (LAS unsigned char*)lds_raw;
    F.tid = threadIdx.x; F.lane = F.tid & 63; F.wave = __builtin_amdgcn_readfirstlane(F.tid >> 6);
    F.G = gridDim.x; { const int bx = blockIdx.x; F.vcu = (F.G % 8 == 0) ? (bx % 8) * (F.G / 8) + bx / 8 : bx; }
    F.ws = args.ws; F.out = args.out; F.ctl = (unsigned*)(args.ws + WS_CTL); F.tp0 = 0ull; F.tpd = 0ull;
    const int lo = args.ph_lo, hi = args.ph_hi;
    if (F.tid < 32) ((LAS unsigned*)(F.lds + L_MISC))[F.tid] = 0u;
    __syncthreads();
    XcdBarrier bar; bar.bar = F.ctl + CW_BAR; bar.x = 0; bar.st = nullptr;
    if (hi - lo > 1) bar = xcd_barrier_post(F.ctl + CW_BAR, (volatile LAS unsigned*)(F.lds + L_MISC) + 8);
    unsigned long long tp_t0 = 0ull, tp_d = 0ull; TpAcc tpa{0ull, 0ull};
#define TP_BEGIN(k) do { if (TP_PHASE == (k)) tp_t0 = __builtin_amdgcn_s_memrealtime(); } while (0)
#define TP_STOP(k, body) do { if (TP_PHASE == (k) && TP_BODY == (body)) tp_d = __builtin_amdgcn_s_memrealtime() - tp_t0; } while (0)
#define SEAM(k) do { TP_STOP(k, true); if (IN(k) && IN((k) + 1)) { xcd_barrier(bar); if ((REP_MASK >> 10) & 1u) xcd_barrier(bar); } TP_STOP(k, false); TP_BEGIN((k) + 1); } while (0)
#ifndef PHMASK
#define PHMASK 0x3ff
#endif
#define IN(k) (((PHMASK >> (k)) & 1) && lo <= (k) && (k) < hi)

    const int nt_main = NT_EXP - (F.G > 4 ? (F.G - 4) * 4 * M3_PER_WAVE : 0);
    TP_BEGIN(0);
    if (IN(0)) { for (int rep = 0; rep < 1 + (int)((REP_MASK >> 0) & 1u); ++rep) p0_prologue(F, args); }
    SEAM(0);
    if (IN(1)) for (int rep = 0; rep < 1 + (int)((REP_MASK >> 1) & 1u); ++rep) {
        pg8::StaticOrder S; S.init(NTOK, LDP, F.G, (int)blockIdx.x);
        pg8::EpiBf16 E{(bf16_t*)(F.ws + WS_PROJ), LDP};
        pg8::gemm_phase<pg8::EpiBf16, pg8::StaticOrder, true, false, false>(F.lds, (const bf16_t*)(F.ws + WS_HN), (const bf16_t*)(F.ws + WS_WIN), DM, S, E, tpa);
    }
    SEAM(1);
    if (IN(2)) for (int rep = 0; rep < 1 + (int)((REP_MASK >> 2) & 1u); ++rep) { for (int ck = blockIdx.x; ck < NTOK / 64; ck += F.G) mixer_chunk<false>(F, args, ck); }
    SEAM(2);
    if (IN(3)) { for (int rep = 0; rep < 1 + (int)((REP_MASK >> 3) & 1u); ++rep) m3_scan(F, args, nt_main); }
    SEAM(3);
    if (IN(4)) for (int rep = 0; rep < 1 + (int)((REP_MASK >> 4) & 1u); ++rep) { for (int ck = blockIdx.x; ck < NTOK / 64; ck += F.G) mixer_chunk<true>(F, args, ck); }
    SEAM(4);
    if (IN(5)) for (int rep = 0; rep < 1 + (int)((REP_MASK >> 5) & 1u); ++rep) {
        pg8::StaticOrder S; S.init(NTOK, DM, F.G, (int)blockIdx.x);
        pg8::EpiResBf16 E{args.in[0], (bf16_t*)(F.ws + WS_HB), DM};
        pg8::gemm_phase<pg8::EpiResBf16, pg8::StaticOrder, false, false, false>(F.lds, (const bf16_t*)(F.ws + WS_HN), (const bf16_t*)(F.ws + WS_WOUT), DM, S, E, tpa);
    }
    TP_STOP(5, true);
    const bool split5 = IN(5) && IN(6);
    if (split5) xcd_barrier_arrive(bar);
    TP_STOP(5, false); TP_BEGIN(6);
    constexpr int NT_A = NEXP * 2 * 256;
    if (IN(6)) { p0_tiles<false, 0, NT_A>(F, args); if (split5) xcd_barrier_wait(bar); else __syncthreads(); p6_router(F, args); }
    TP_STOP(6, true);
    const bool split6 = IN(6) && IN(7);
    if (split6) xcd_barrier_arrive(bar);
    TP_STOP(6, false); TP_BEGIN(7);
    if (IN(6)) { p0_tiles_rt<false>(F, args, NT_A + F.vcu * NWAVES + F.wave, F.G * NWAVES, nt_main); }
    if (split6) xcd_barrier_wait(bar); else __syncthreads();
    if (IN(7)) for (int rep = 0; rep < 1 + (int)((REP_MASK >> 7) & 1u); ++rep) {
        const int nu = moe_setup(F, 3, true, true);
        pg8::MoeOrder S{(const LAS int*)(F.lds + L_UTAB), (const LAS unsigned*)(F.lds + L_ROWT), nu, 8};
        pg8::EpiGeglu E{F.ws + WS_H};
        pg8::gemm_phase<pg8::EpiGeglu, pg8::MoeOrder, true, true, true>(F.lds, (const bf16_t*)(F.ws + WS_HN), (const bf16_t*)(F.ws + WS_WGU), DM / 2, S, E, tpa);
    }
    TP_STOP(7, true);
    const bool split7 = IN(7) && IN(8);
    if (split7) xcd_barrier_arrive(bar);
    TP_STOP(7, false); TP_BEGIN(8);
    if (IN(8)) {
        const int nu = moe_setup(F, 2, true, false);
        if (split7) xcd_barrier_wait(bar);
        pg8::MoeOrder S{(const LAS int*)(F.lds + L_UTAB), (const LAS unsigned*)(F.lds + L_ROWT), nu, 4};
        pg8::EpiScaleFp8 E{F.ws + WS_YB};
        pg8::gemm_phase<pg8::EpiScaleFp8, pg8::MoeOrder, true, false, true>(F.lds, (const bf16_t*)(F.ws + WS_H), (const bf16_t*)(F.ws + WS_WD), DM / 2, S, E, tpa);
    }
    TP_STOP(8, true);
    const bool split8 = IN(8) && IN(9);
    if (split8) xcd_barrier_arrive(bar);
    TP_STOP(8, false); TP_BEGIN(9);
    if (IN(9)) { moe_setup(F, 0, false, false);
        const int NGW = F.G * NWAVES; int tb = F.vcu * NWAVES + F.wave; P9Pre pre; p9_pre(F, tb, pre);
        if (split8) xcd_barrier_wait(bar);
        for (;;) { p9_post(F, args, tb, pre); tb += 8 * NGW; if (tb >= NTOK) break; p9_pre(F, tb, pre); } }
    TP_STOP(9, true); TP_STOP(9, false);
    if (TP_PHASE >= 100) tp_d = F.tpd;
    if (TP_PHASE >= 200) tp_d = tpa.d;
    if (TP_PHASE >= 0) { const unsigned long long te = __builtin_amdgcn_s_memrealtime(); while (__builtin_amdgcn_s_memrealtime() - te < tp_d) __builtin_amdgcn_s_sleep(8); }
#undef IN
#undef SEAM
#undef TP_BEGIN
#undef TP_STOP
}

extern "C" void kernel_launch(void* const* d_in, const int* in_sizes, int n_in, void* d_out, int out_size, void* d_ws, size_t ws_size, hipStream_t stream) {
    static int grid = 0;
    if (grid == 0) {
        if (n_in != 24 || out_size != NTOK * DM || ws_size < WS_END) { fprintf(stderr, "kernel_launch: unexpected shapes (n_in %d, out %d, ws %zu); nothing launched\n", n_in, out_size, ws_size); grid = -1; return; }
        int dev = 0, cus = 0;
        if (hipGetDevice(&dev) != hipSuccess || hipDeviceGetAttribute(&cus, hipDeviceAttributeMultiprocessorCount, dev) != hipSuccess) { grid = -1; return; }
        if (hipFuncSetAttribute((const void*)fwd, hipFuncAttributeMaxDynamicSharedMemorySize, LDS_BYTES) != hipSuccess) { fprintf(stderr, "kernel_launch: hipFuncSetAttribute failed\n"); grid = -1; return; }
        (void)hipGetLastError();
        grid = cus;
        if ((160 * 8 + grid - 1) / grid > MAXU) { fprintf(stderr, "kernel_launch: %d workgroups cannot hold the MoE unit tables (MAXU %d); nothing launched\n", grid, MAXU); grid = -1; return; }
    }
    if (grid < 0) return;
    (void)hipMemsetAsync((char*)d_ws + WS_CTL, 0, CTL_ZERO_BYTES, stream);
    Args a{};
    for (int i = 0; i < 24; ++i) a.in[i] = (const float*)d_in[i];
    a.out = (float*)d_out; a.ws = (unsigned char*)d_ws;
#ifndef N_LAUNCHES
#define N_LAUNCHES 1
#endif
    if (N_LAUNCHES == 1) { a.ph_lo = 0; a.ph_hi = NPHASE; hipLaunchKernelGGL(fwd, dim3(grid), dim3(NTHR), LDS_BYTES, stream, a); }
    else for (int p = 0; p < NPHASE; ++p) { a.ph_lo = p; a.ph_hi = p + 1; hipLaunchKernelGGL(fwd, dim3(grid), dim3(NTHR), LDS_BYTES, stream, a); }
}
```
